# Optimizing an MI355X kernel written in HIP

```python
import jax, jax.numpy as jnp
from jax import lax
import numpy as np

D_MODEL = 1024
BATCH = 4
SEQ = 4096
DEPTH = 4

GRID_W = 64
CTX_LEN = 256
EPS = 1e-6
N_MOD = 6
N_BRANCH = 3
GLA_HEADS = 4
GLA_DK = 64
GLA_DV = 128
GLA_RANK = 16
GLA_TAU = 16.0
GLA_CHUNK = 64
GLA_SCALE = GLA_DK ** -0.5
FNET_GROUPS = 4
FNET_GROUP_W = 128
SWA_HEADS = 8
SWA_KV_HEADS = 2
SWA_HEAD_DIM = 64
SWA_GROUP = SWA_HEADS // SWA_KV_HEADS
WINDOW = 128
ROPE_BASE = 10000.0
AXIS_DIM = SWA_HEAD_DIM // 2
MOE_GROUPS = 4
MOE_EXPERTS_PER_GROUP = 4
MOE_EXPERTS = MOE_GROUPS * MOE_EXPERTS_PER_GROUP
MOE_TOPK = 2
D_EXPERT = 512

GLA_QK_W = GLA_HEADS * GLA_DK
GLA_V_W = GLA_HEADS * GLA_DV
FNET_W = FNET_GROUPS * FNET_GROUP_W
SWA_Q_W = SWA_HEADS * SWA_HEAD_DIM
SWA_KV_W = SWA_KV_HEADS * SWA_HEAD_DIM
IN_SIZES = [GLA_QK_W, GLA_V_W, SWA_KV_W, SWA_KV_W, GLA_QK_W, GLA_V_W, FNET_W, SWA_Q_W, N_BRANCH * D_MODEL]
IN_COLS = sum(IN_SIZES)

kernel_name = "hybrid_gla_fourier_swa_hmoe_dit"


def rms_norm(x, g):
    xf = x.astype(jnp.float32)
    y = xf * lax.rsqrt(jnp.mean(xf * xf, axis=-1, keepdims=True) + EPS)
    return (y * g.astype(jnp.float32)).astype(x.dtype)


def modulate(x, shift, scale):
    return x * (1 + scale[..., None, :]) + shift[..., None, :]


def split_by(t, sizes):
    return jnp.split(t, [int(i) for i in np.cumsum(sizes)[:-1]], axis=-1)


def heads(t, n):
    return t.reshape(t.shape[0], t.shape[1], n, -1)


def flip_seq(t):
    return jnp.flip(t, axis=1)


def gla_log_decay(h, w_down, w_up, b):
    z = (h @ w_down) @ w_up + b
    la = jax.nn.log_sigmoid(z.astype(jnp.float32)) / GLA_TAU
    return la.reshape(h.shape[0], h.shape[1], GLA_HEADS, GLA_DK)


def gla_chunked(q, k, v, log_a, s0):
    b_, l_, h_, _ = q.shape
    n = l_ // GLA_CHUNK

    def to_chunks(t):
        t = t.astype(jnp.float32)
        return jnp.moveaxis(t.reshape(b_, n, GLA_CHUNK, *t.shape[2:]), 1, 0)

    lower = jnp.tril(jnp.ones((GLA_CHUNK, GLA_CHUNK), dtype=bool))[None, :, :, None, None]

    def step(state, inp):
        qc, kc, vc, ac = inp
        cum = jnp.cumsum(ac, axis=1)
        inter = jnp.einsum('bchk,bhkv->bchv', qc * jnp.exp(cum), state)
        diff = cum[:, :, None] - cum[:, None, :]
        decay = jnp.exp(jnp.where(lower, diff, -jnp.inf))
        scores = jnp.einsum('bthk,bshk,btshk->btsh', qc, kc, decay)
        intra = jnp.einsum('btsh,bshv->bthv', scores, vc)
        last = cum[:, -1]
        new_state = jnp.exp(last)[..., None] * state + jnp.einsum(
            'bshk,bshv->bhkv', kc * jnp.exp(last[:, None] - cum), vc)
        return new_state, inter + intra

    state, out = lax.scan(step, s0, (to_chunks(q), to_chunks(k), to_chunks(v), to_chunks(log_a)))
    out = jnp.moveaxis(out, 0, 1).reshape(b_, l_, h_, v.shape[-1])
    return out, state


def gla_final_state(k, v, log_a):
    cum = jnp.cumsum(log_a.astype(jnp.float32), axis=1)
    return jnp.einsum('bshk,bshv->bhkv', k.astype(jnp.float32) * jnp.exp(cum[:, -1:] - cum),
                      v.astype(jnp.float32))


def gla_bidirectional(q, k, v, la_f, la_b, s0_f, s0_b):
    o_f, s_f = gla_chunked(q, k, v, la_f, s0_f)
    o_b, s_b = gla_chunked(flip_seq(q), flip_seq(k), flip_seq(v), flip_seq(la_b), s0_b)
    return o_f + flip_seq(o_b), s_f, s_b


def gla_output(o, r, g_gla):
    o = rms_norm(o, g_gla).reshape(o.shape[0], o.shape[1], GLA_V_W)
    return (o * jax.nn.silu(r.astype(jnp.float32))).astype(r.dtype)


def fourier_mix(u):
    b_, l_, _ = u.shape
    ug = u.astype(jnp.float32).reshape(b_, l_, FNET_GROUPS, FNET_GROUP_W)
    f = jnp.fft.fftn(ug, axes=(1, 3), norm='ortho').real
    return f.reshape(b_, l_, FNET_W).astype(u.dtype)


def axial_angles(n_tokens):
    rows = n_tokens // GRID_W
    row = jnp.repeat(jnp.arange(rows, dtype=jnp.float32), GRID_W)
    col = jnp.tile(jnp.arange(GRID_W, dtype=jnp.float32), rows)
    inv_freq = ROPE_BASE ** (-jnp.arange(0, AXIS_DIM, 2, dtype=jnp.float32) / AXIS_DIM)
    return row[:, None] * inv_freq, col[:, None] * inv_freq


def rope_1d(x, ang):
    x1, x2 = jnp.split(x.astype(jnp.float32), 2, axis=-1)
    cos = jnp.cos(ang)[None, :, None, :]
    sin = jnp.sin(ang)[None, :, None, :]
    return jnp.concatenate([x1 * cos - x2 * sin, x1 * sin + x2 * cos], axis=-1)


def rope_2d(x, ang_row, ang_col):
    xr, xc = jnp.split(x, 2, axis=-1)
    return jnp.concatenate([rope_1d(xr, ang_row), rope_1d(xc, ang_col)], axis=-1).astype(x.dtype)


def windowed_gqa_with_context(q, k, v, kc, vc, sink):
    b_, l_, _, d = q.shape
    nb = l_ // WINDOW
    scale = d ** -0.5
    qb = q.reshape(b_, nb, WINDOW, SWA_KV_HEADS, SWA_GROUP, d)
    pad = ((0, 0), (WINDOW, WINDOW), (0, 0), (0, 0))
    kb = jnp.pad(k, pad).reshape(b_, nb + 2, WINDOW, SWA_KV_HEADS, d)
    vb = jnp.pad(v, pad).reshape(b_, nb + 2, WINDOW, SWA_KV_HEADS, d)
    kw = jnp.concatenate([kb[:, :-2], kb[:, 1:-1], kb[:, 2:]], axis=2)
    vw = jnp.concatenate([vb[:, :-2], vb[:, 1:-1], vb[:, 2:]], axis=2)
    a = jnp.arange(WINDOW)[:, None]
    j = jnp.arange(3 * WINDOW)[None, :]
    band = (j - a >= 0) & (j - a <= 2 * WINDOW)
    key_pos = (jnp.arange(nb)[:, None, None] - 1) * WINDOW + j[None]
    valid = band[None] & (key_pos >= 0) & (key_pos < l_)
    s_win = jnp.einsum('bnqhgd,bnkhd->bnhgqk', qb, kw).astype(jnp.float32) * scale
    s_win = jnp.where(valid[None, :, None, None], s_win, -jnp.inf)
    s_ctx = jnp.einsum('bnqhgd,bkhd->bnhgqk', qb, kc).astype(jnp.float32) * scale
    s_sink = jnp.broadcast_to(
        sink.astype(jnp.float32).reshape(SWA_KV_HEADS, SWA_GROUP)[None, None, :, :, None, None],
        s_win.shape[:-1] + (1,))
    probs = jax.nn.softmax(jnp.concatenate([s_win, s_ctx, s_sink], axis=-1), axis=-1)
    n_win = 3 * WINDOW
    p_win = probs[..., :n_win].astype(v.dtype)
    p_ctx = probs[..., n_win:n_win + kc.shape[1]].astype(v.dtype)
    out = (jnp.einsum('bnhgqk,bnkhd->bnqhgd', p_win, vw)
           + jnp.einsum('bnhgqk,bkhd->bnqhgd', p_ctx, vc))
    return out.reshape(b_, l_, SWA_Q_W)


def context_gqa(qc, kc, vc, sink):
    b_, n_, _, d = qc.shape
    q = qc.reshape(b_, n_, SWA_KV_HEADS, SWA_GROUP, d)
    s = jnp.einsum('bqhgd,bkhd->bhgqk', q, kc).astype(jnp.float32) * d ** -0.5
    s_sink = jnp.broadcast_to(
        sink.astype(jnp.float32).reshape(SWA_KV_HEADS, SWA_GROUP)[None, :, :, None, None],
        s.shape[:-1] + (1,))
    p = jax.nn.softmax(jnp.concatenate([s, s_sink], axis=-1), axis=-1)[..., :-1].astype(vc.dtype)
    return jnp.einsum('bhgqk,bkhd->bqhgd', p, vc).reshape(b_, n_, SWA_Q_W)


def merge_branches(y_a, y_b, y_c, gate_logits, w_pa, w_pb, w_pc, w_out):
    g_a, g_b, g_c = jnp.split(jax.nn.sigmoid(gate_logits), N_BRANCH, axis=-1)
    return (g_a * (y_a @ w_pa) + g_b * (y_b @ w_pb) + g_c * (y_c @ w_pc)) @ w_out


def hybrid_mixer(h, hc, w_in, w_decay_down, w_decay_up, b_decay, g_gla, sink, w_pa, w_pb, w_pc, w_out, last):
    b_, l_, _ = h.shape
    k_a, v_a, k_c, v_c, q_a, r_a, u_b, q_c, gate_logits = split_by(h @ w_in, IN_SIZES)
    n_parts = 4 if last else len(IN_SIZES)
    ctx_sizes = IN_SIZES[:n_parts]
    cparts = split_by(hc @ w_in[:, :sum(ctx_sizes)], ctx_sizes)
    ck_a, cv_a = heads(cparts[0], GLA_HEADS), heads(cparts[1], GLA_HEADS)
    ck_c, cv_c = heads(cparts[2], SWA_KV_HEADS), heads(cparts[3], SWA_KV_HEADS)

    la_f = gla_log_decay(h, w_decay_down[0], w_decay_up[0], b_decay[0])
    la_b = gla_log_decay(h, w_decay_down[1], w_decay_up[1], b_decay[1])
    cla_f = gla_log_decay(hc, w_decay_down[0], w_decay_up[0], b_decay[0])
    cla_b = gla_log_decay(hc, w_decay_down[1], w_decay_up[1], b_decay[1])
    if last:
        s_f = gla_final_state(ck_a, cv_a, cla_f)
        s_b = gla_final_state(flip_seq(ck_a), flip_seq(cv_a), flip_seq(cla_b))
    else:
        s0 = jnp.zeros((b_, GLA_HEADS, GLA_DK, GLA_DV), jnp.float32)
        co_a, s_f, s_b = gla_bidirectional(heads(cparts[4], GLA_HEADS) * GLA_SCALE, ck_a, cv_a,
                                           cla_f, cla_b, s0, s0)
    o_a, _, _ = gla_bidirectional(heads(q_a, GLA_HEADS) * GLA_SCALE, heads(k_a, GLA_HEADS),
                                  heads(v_a, GLA_HEADS), la_f, la_b, s_f, s_b)
    y_a = gla_output(o_a, r_a, g_gla)

    y_b = fourier_mix(u_b)

    ang_row, ang_col = axial_angles(l_)
    q_rot = rope_2d(heads(q_c, SWA_HEADS), ang_row, ang_col)
    k_rot = rope_2d(heads(k_c, SWA_KV_HEADS), ang_row, ang_col)
    y_c = windowed_gqa_with_context(q_rot, k_rot, heads(v_c, SWA_KV_HEADS), ck_c, cv_c, sink)

    y = merge_branches(y_a, y_b, y_c, gate_logits, w_pa, w_pb, w_pc, w_out)
    if last:
        return y, None
    yc_a = gla_output(co_a, cparts[5], g_gla)
    yc_b = fourier_mix(cparts[6])
    yc_c = context_gqa(heads(cparts[7], SWA_HEADS), ck_c, cv_c, sink)
    yc = merge_branches(yc_a, yc_b, yc_c, cparts[8], w_pa, w_pb, w_pc, w_out)
    return y, yc


def hierarchical_moe(h, w_router_group, w_router_expert, w1, w3, w2):
    g_logits = (h @ w_router_group).astype(jnp.float32)
    g_sel = jnp.argmax(g_logits, axis=-1)
    g_gate = jnp.take_along_axis(jax.nn.softmax(g_logits, axis=-1), g_sel[:, None], axis=-1)
    e_logits = (h @ w_router_expert).astype(jnp.float32).reshape(-1, MOE_GROUPS, MOE_EXPERTS_PER_GROUP)
    e_in_group = jnp.take_along_axis(e_logits, g_sel[:, None, None], axis=1)[:, 0]
    top_vals, top_idx = lax.top_k(e_in_group, MOE_TOPK)
    top_w = jax.nn.softmax(top_vals, axis=-1) * g_gate
    expert_id = g_sel[:, None] * MOE_EXPERTS_PER_GROUP + top_idx
    gates = jnp.sum(jax.nn.one_hot(expert_id, MOE_EXPERTS, dtype=jnp.float32) * top_w[..., None], axis=1)
    gates = gates.astype(h.dtype)
    out = jnp.zeros(h.shape, h.dtype)
    for e in range(MOE_EXPERTS):
        hid = jax.nn.silu(h @ w1[e]) * (h @ w3[e])
        out = out + (hid @ w2[e]) * gates[:, e:e + 1]
    return out


def trunk_layer(x, xc, c_act, cc_act, w_ada, b_ada, g_mix, g_ffn, w_in, w_decay_down, w_decay_up, b_decay,
                g_gla, sink, w_pa, w_pb, w_pc, w_out, w_router_group, w_router_expert, w1, w3, w2, last):
    shift1, scale1, gate1, shift2, scale2, gate2 = jnp.split(c_act @ w_ada + b_ada, N_MOD, axis=-1)
    n_ctx_mod = 2 if last else N_MOD
    mods_c = jnp.split(cc_act @ w_ada[:, :n_ctx_mod * D_MODEL] + b_ada[:n_ctx_mod * D_MODEL], n_ctx_mod, axis=-1)
    h = modulate(rms_norm(x, g_mix), shift1, scale1)
    hc = modulate(rms_norm(xc, g_mix), mods_c[0], mods_c[1])
    y, yc = hybrid_mixer(h, hc, w_in, w_decay_down, w_decay_up, b_decay, g_gla, sink,
                         w_pa, w_pb, w_pc, w_out, last)
    x = x + gate1[:, None, :] * y
    h2 = modulate(rms_norm(x, g_ffn), shift2, scale2)
    x = x + gate2[:, None, :] * hierarchical_moe(h2.reshape(-1, D_MODEL), w_router_group, w_router_expert,
                                                 w1, w3, w2).reshape(x.shape)
    if last:
        return x, None
    xc = xc + mods_c[2] * yc
    hc2 = modulate(rms_norm(xc, g_ffn), mods_c[3], mods_c[4])
    xc = xc + mods_c[5] * hierarchical_moe(hc2.reshape(-1, D_MODEL), w_router_group, w_router_expert,
                                           w1, w3, w2).reshape(xc.shape)
    return x, xc


def setup_inputs(seed: int = 0) -> dict:
    key = jax.random.key(seed)
    ks = jax.random.split(key, 24)
    D = D_MODEL

    def nrm(k, shape, s):
        return jax.random.normal(k, shape, jnp.float32) * s

    return {
        'x': nrm(ks[0], (BATCH, SEQ, D), 1.0),
        'c': nrm(ks[1], (BATCH, D), 1.0),
        'ctx': nrm(ks[2], (BATCH, CTX_LEN, D), 1.0),
        'c_ctx': nrm(ks[3], (D,), 1.0),
        'w_ada': nrm(ks[4], (DEPTH, D, N_MOD * D), 0.5 * D ** -0.5),
        'b_ada': nrm(ks[5], (DEPTH, N_MOD * D), 0.02),
        'g_mix': 1.0 + nrm(ks[6], (DEPTH, D), 0.05),
        'g_ffn': 1.0 + nrm(ks[7], (DEPTH, D), 0.05),
        'w_in': nrm(ks[8], (DEPTH, D, IN_COLS), D ** -0.5),
        'w_decay_down': nrm(ks[9], (DEPTH, 2, D, GLA_RANK), D ** -0.5),
        'w_decay_up': nrm(ks[10], (DEPTH, 2, GLA_RANK, GLA_QK_W), GLA_RANK ** -0.5),
        'b_decay': nrm(ks[11], (DEPTH, 2, GLA_QK_W), 0.5),
        'g_gla': 1.0 + nrm(ks[12], (DEPTH, GLA_DV), 0.05),
        'sink': nrm(ks[13], (DEPTH, SWA_HEADS), 0.5),
        'w_pa': nrm(ks[14], (DEPTH, GLA_V_W, D), GLA_V_W ** -0.5),
        'w_pb': nrm(ks[15], (DEPTH, FNET_W, D), FNET_W ** -0.5),
        'w_pc': nrm(ks[16], (DEPTH, SWA_Q_W, D), SWA_Q_W ** -0.5),
        'w_out': nrm(ks[17], (DEPTH, D, D), D ** -0.5),
        'w_router_group': nrm(ks[18], (DEPTH, D, MOE_GROUPS), D ** -0.5),
        'w_router_expert': nrm(ks[19], (DEPTH, D, MOE_EXPERTS), D ** -0.5),
        'w1': nrm(ks[20], (DEPTH, MOE_EXPERTS, D, D_EXPERT), D ** -0.5),
        'w3': nrm(ks[21], (DEPTH, MOE_EXPERTS, D, D_EXPERT), D ** -0.5),
        'w2': nrm(ks[22], (DEPTH, MOE_EXPERTS, D_EXPERT, D), D_EXPERT ** -0.5),
        'g_final': 1.0 + nrm(ks[23], (D,), 0.05),
    }


def reference(x, c, ctx, c_ctx, w_ada, b_ada, g_mix, g_ffn, w_in, w_decay_down, w_decay_up, b_decay, g_gla,
              sink, w_pa, w_pb, w_pc, w_out, w_router_group, w_router_expert, w1, w3, w2, g_final):
    c_act = jax.nn.silu(c)
    cc_act = jax.nn.silu(c_ctx)
    xc = ctx
    for l in range(DEPTH):
        x, xc = trunk_layer(x, xc, c_act, cc_act, w_ada[l], b_ada[l], g_mix[l], g_ffn[l], w_in[l],
                            w_decay_down[l], w_decay_up[l], b_decay[l], g_gla[l], sink[l], w_pa[l], w_pb[l],
                            w_pc[l], w_out[l], w_router_group[l], w_router_expert[l], w1[l], w3[l], w2[l],
                            l == DEPTH - 1)
    return rms_norm(x, g_final)
```

```cpp
#include <hip/hip_runtime.h>
#include <cstdio>
#include <cstdint>
#include <cstring>
#ifdef CPU_EMU
#include <cmath>
#include <cstdint>
#include <cstring>
#define DEVFN static inline
#else
#define DEVFN __device__ __forceinline__
#endif

typedef unsigned short bf16;
DEVFN float bf2f(bf16 v) { unsigned u = ((unsigned)v) << 16; float f; memcpy(&f, &u, 4); return f; }
DEVFN bf16 f2bf(float f) { unsigned u; memcpy(&u, &f, 4); u += 0x7fffu + ((u >> 16) & 1u); return (bf16)(u >> 16); }
DEVFN float sigmoidf_(float x) { return 1.0f / (1.0f + expf(-x)); }
DEVFN float siluf_(float x) { return x / (1.0f + expf(-x)); }
DEVFN float logsigmoidf_(float x) { return fminf(x, 0.0f) - log1pf(expf(-fabsf(x))); }

struct CfgFull { static constexpr int D = 1024, B = 4, SEQ = 4096, DEPTH = 4, GW = 64, CTX = 256, GH = 4, DK = 64, DV = 128, RANK = 16, FG = 4, FGW = 128,
                 SH = 8, SKV = 2, HD = 64, WIN = 128, MG = 4, MEG = 4, DE = 512; };
#ifndef SMALL_SEQ
#define SMALL_SEQ 256
#endif
struct CfgSmall { static constexpr int D = 64, B = 2, SEQ = SMALL_SEQ, DEPTH = 2, GW = 16, CTX = 64, GH = 2, DK = 8, DV = 16, RANK = 4, FG = 2, FGW = 16,
                  SH = 4, SKV = 2, HD = 8, WIN = 32, MG = 2, MEG = 4, DE = 32; };

template <class C> struct Sh : C {
    static constexpr int NLAT = C::B * C::SEQ, NCTX = C::B * C::CTX, NTOK = NLAT + NCTX;
    static constexpr int QKW = C::GH * C::DK, VW = C::GH * C::DV, FW = C::FG * C::FGW, SQW = C::SH * C::HD, SKW = C::SKV * C::HD, NE = C::MG * C::MEG, SG = C::SH / C::SKV;
    static constexpr int NMOD = 6 * C::D;
    static constexpr int L_KA = 0, L_VA = L_KA + QKW, L_KC = L_VA + VW, L_VC = L_KC + SKW, L_QA = L_VC + SKW, L_RA = L_QA + QKW, L_UB = L_RA + VW, L_QC = L_UB + FW, L_G = L_QC + SQW, INCOLS = L_G + 3 * C::D;
    static constexpr int P_KA = 0, P_VA = P_KA + QKW, P_KC = P_VA + VW, P_VC = P_KC + SKW, P_QA = P_VC + SKW, P_RA = P_QA + QKW, P_QC = P_RA + VW, P_G = P_QC + SQW, PCOLS = P_G + 3 * C::D;
    static constexpr int YCOLS = VW + FW + SQW;
    static constexpr int Y_A = 0, Y_B = VW, Y_C = VW + FW;
    static constexpr int NFREQ = C::HD / 4;
    static constexpr int NPOS = (C::GW > C::SEQ / C::GW) ? C::GW : C::SEQ / C::GW;
    static constexpr float EPS = 1e-6f;
};

template <class S> DEVFN int row_batch(int row) { return row < S::NLAT ? row / S::SEQ : (row - S::NLAT) / S::CTX; }
template <class S> DEVFN int row_modrow(int row) { return row < S::NLAT ? row / S::SEQ : S::B; }

struct Params {
    const float *x, *c, *ctx, *c_ctx, *w_ada, *b_ada, *g_mix, *g_ffn, *w_in, *w_dd, *w_du, *b_dec, *g_gla, *sink, *w_pa, *w_pb, *w_pc, *w_out, *w_rg, *w_re, *w1, *w3, *w2, *g_final;
    float* out;
    unsigned* ctl;
    float* X;
    float* MODS;
    float* TABL;
    float* TABX;
    float* TABC;
    float* ROPE;
    bf16* H;
    bf16* PROJ;
    float* LA;
    float* UB;
    float* D16;
    bf16* PQT;
    bf16* PQTC;
    bf16* Y;
    float* OG;
    bf16* MERGED;
    int* TOPE;
    float* TOPW;
    bf16* HIDN;
    bf16* C2;
};

template <class S> DEVFN void nv_tables(const Params& p, long gt, long gs) {
    const float TWO_PI = 6.283185307179586f;
    for (long i = gt; i < S::SEQ; i += gs) { double a = 6.283185307179586 * (double)i / S::SEQ; p.TABL[2 * i] = (float)cos(a); p.TABL[2 * i + 1] = (float)sin(a); }
    for (long i = gt; i < S::CTX; i += gs) { double a = 6.283185307179586 * (double)i / S::CTX; p.TABX[2 * i] = (float)cos(a); p.TABX[2 * i + 1] = (float)sin(a); }
    for (long i = gt; i < S::FGW; i += gs) { double a = 6.283185307179586 * (double)i / S::FGW; p.TABC[2 * i] = (float)cos(a); p.TABC[2 * i + 1] = (float)sin(a); }
    for (long i = gt; i < S::NPOS * S::NFREQ; i += gs) {
        int pos = (int)(i / S::NFREQ), f = (int)(i % S::NFREQ);
        float inv = powf(10000.0f, -(float)(2 * f) / (float)(S::HD / 2));
        float a = (float)pos * inv; p.ROPE[2 * i] = cosf(a); p.ROPE[2 * i + 1] = sinf(a);
    }
    (void)TWO_PI;
}

template <class S> DEVFN void nv_mods(const Params& p, long gt, long gs) {
    const long total = (long)S::DEPTH * (S::B + 1) * S::NMOD;
    for (long i = gt; i < total; i += gs) {
        int n = (int)(i % S::NMOD); int r = (int)((i / S::NMOD) % (S::B + 1)); int l = (int)(i / ((long)S::NMOD * (S::B + 1)));
        const float* cv = r < S::B ? p.c + (long)r * S::D : p.c_ctx;
        const float* w = p.w_ada + (long)l * S::D * S::NMOD + n;
        float acc = 0.f;
        for (int k = 0; k < S::D; ++k) acc += siluf_(cv[k]) * w[(long)k * S::NMOD];
        p.MODS[i] = acc + p.b_ada[(long)l * S::NMOD + n];
    }
}

template <class S> DEVFN void nv_resnorm(const Params& p, int l, int mode, long gt, long gs) {
    for (long row = gt; row < S::NTOK; row += gs) {
        const int mr = row_modrow<S>((int)row);
        float* xr = p.X + row * S::D;
        const float* src = nullptr;
        if (mode == 0) src = row < S::NLAT ? p.x + row * S::D : p.ctx + (row - S::NLAT) * S::D;
        const float* gate2 = (mode != 0) ? p.MODS + ((long)(l - 1) * (S::B + 1) + mr) * S::NMOD + 5 * S::D : nullptr;
        float ss = 0.f;
        for (int c = 0; c < S::D; ++c) {
            float v;
            if (mode == 0) v = src[c];
            else v = xr[c] + gate2[c] * (bf2f(p.C2[(row * 2) * S::D + c]) + bf2f(p.C2[(row * 2 + 1) * S::D + c]));
            xr[c] = v; ss += v * v;
        }
        const float rstd = 1.0f / sqrtf(ss / S::D + S::EPS);
        if (mode == 2) {
            if (row < S::NLAT) for (int c = 0; c < S::D; ++c) p.out[row * S::D + c] = xr[c] * rstd * p.g_final[c];
        } else {
            const float* md = p.MODS + ((long)l * (S::B + 1) + mr) * S::NMOD;
            const float* g = p.g_mix + (long)l * S::D;
            for (int c = 0; c < S::D; ++c) p.H[row * S::D + c] = f2bf(xr[c] * rstd * g[c] * (1.0f + md[S::D + c]) + md[c]);
        }
    }
}

template <class S> DEVFN float rope_apply(const Params& p, int s, int d, float own, float partner) {
    const int half = d / (S::HD / 2), i = d % (S::HD / 2), f = i % S::NFREQ; const bool second = i >= S::NFREQ;
    const int pos = half == 0 ? s / S::GW : s % S::GW;
    const float cs = p.ROPE[2 * (pos * S::NFREQ + f)], sn = p.ROPE[2 * (pos * S::NFREQ + f) + 1];
    return second ? partner * sn + own * cs : own * cs - partner * sn;
}

template <class S> DEVFN void nv_inproj(const Params& p, int l, long gt, long gs) {
    const long total = (long)S::NTOK * S::INCOLS;
    const float* W = p.w_in + (long)l * S::D * S::INCOLS;
    for (long i = gt; i < total; i += gs) {
        const int col = (int)(i % S::INCOLS); const long row = i / S::INCOLS;
        const bf16* h = p.H + row * S::D;
        const bool is_kc = col >= S::L_KC && col < S::L_VC, is_qc = col >= S::L_QC && col < S::L_G;
        int pcol = col;
        if (is_kc || is_qc) { const int base = is_kc ? S::L_KC : S::L_QC; const int d = (col - base) % S::HD; const int ii = d % (S::HD / 2);
            pcol = ii < S::NFREQ ? col + S::NFREQ : col - S::NFREQ; }
        float acc = 0.f, acc2 = 0.f;
        if (is_kc || is_qc) { for (int k = 0; k < S::D; ++k) { const float hv = bf2f(h[k]); acc += hv * W[(long)k * S::INCOLS + col]; acc2 += hv * W[(long)k * S::INCOLS + pcol]; } }
        else { for (int k = 0; k < S::D; ++k) acc += bf2f(h[k]) * W[(long)k * S::INCOLS + col]; }
        bf16* pr = p.PROJ + row * S::PCOLS;
        if (col < S::L_VA) pr[S::P_KA + col - S::L_KA] = f2bf(acc);
        else if (col < S::L_KC) pr[S::P_VA + col - S::L_VA] = f2bf(acc);
        else if (col < S::L_VC) { float v = acc; if (row < S::NLAT) v = rope_apply<S>(p, (int)(row % S::SEQ), (col - S::L_KC) % S::HD, acc, acc2); pr[S::P_KC + col - S::L_KC] = f2bf(v); }
        else if (col < S::L_QA) pr[S::P_VC + col - S::L_VC] = f2bf(acc);
        else if (col < S::L_RA) pr[S::P_QA + col - S::L_QA] = f2bf(acc * (1.0f / sqrtf((float)S::DK)));
        else if (col < S::L_UB) pr[S::P_RA + col - S::L_RA] = f2bf(acc);
        else if (col < S::L_QC) p.UB[row * S::FW + col - S::L_UB] = acc;
        else if (col < S::L_G) { float v = acc; if (row < S::NLAT) v = rope_apply<S>(p, (int)(row % S::SEQ), (col - S::L_QC) % S::HD, acc, acc2); pr[S::P_QC + col - S::L_QC] = f2bf(v); }
        else pr[S::P_G + col - S::L_G] = f2bf(sigmoidf_(acc));
    }
}

template <class S> DEVFN void nv_decay1(const Params& p, int l, long gt, long gs) {
    const long total = (long)S::NTOK * 2 * S::RANK;
    for (long i = gt; i < total; i += gs) {
        const int r = (int)(i % S::RANK), dir = (int)((i / S::RANK) % 2); const long row = i / (2 * S::RANK);
        const float* w = p.w_dd + ((long)(l * 2 + dir) * S::D) * S::RANK + r; const bf16* h = p.H + row * S::D;
        float acc = 0.f; for (int k = 0; k < S::D; ++k) acc += bf2f(h[k]) * w[(long)k * S::RANK];
        p.D16[i] = acc;
    }
}
template <class S> DEVFN void nv_decay2(const Params& p, int l, long gt, long gs) {
    const long total = (long)S::NTOK * 2 * S::QKW;
    for (long i = gt; i < total; i += gs) {
        const int n = (int)(i % S::QKW), dir = (int)((i / S::QKW) % 2); const long row = i / (2 * S::QKW);
        const float* w = p.w_du + ((long)(l * 2 + dir) * S::RANK) * S::QKW + n; const float* d = p.D16 + (row * 2 + dir) * S::RANK;
        float z = p.b_dec[(long)(l * 2 + dir) * S::QKW + n]; for (int r = 0; r < S::RANK; ++r) z += d[r] * w[(long)r * S::QKW];
        p.LA[i] = logsigmoidf_(z) * (1.0f / 16.0f);
    }
}

template <class S> DEVFN void nv_chdft(const Params& p, long gt, long gs) {
    const long total = (long)S::NTOK * S::FG * S::FGW * 2;
    const float sc = 1.0f / sqrtf((float)S::FGW);
    for (long i = gt; i < total; i += gs) {
        const int pq = (int)(i % 2), cp = (int)((i / 2) % S::FGW), g = (int)((i / (2 * S::FGW)) % S::FG); const long row = i / (2 * S::FGW * S::FG);
        const float* u = p.UB + row * S::FW + g * S::FGW; float acc = 0.f;
        for (int c = 0; c < S::FGW; ++c) acc += u[c] * p.TABC[2 * ((c * cp) % S::FGW) + pq];
        acc *= sc;
        if (row < S::NLAT) { const int b = (int)(row / S::SEQ), s = (int)(row % S::SEQ); p.PQT[((((long)b * S::FG + g) * S::FGW + cp) * 2 + pq) * S::SEQ + s] = f2bf(acc); }
        else { const int b = (int)((row - S::NLAT) / S::CTX), j = (int)((row - S::NLAT) % S::CTX); p.PQTC[((((long)b * S::FG + g) * S::FGW + cp) * 2 + pq) * S::CTX + j] = f2bf(acc); }
    }
}
template <class S> DEVFN void nv_seqdft(const Params& p, long gt, long gs) {
    { const long total = (long)S::B * S::FG * S::FGW * S::SEQ; const float sc = 1.0f / sqrtf((float)S::SEQ);
      for (long i = gt; i < total; i += gs) {
        const int lp = (int)(i % S::SEQ); const long bgc = i / S::SEQ; const int cp = (int)(bgc % S::FGW), g = (int)((bgc / S::FGW) % S::FG), b = (int)(bgc / ((long)S::FGW * S::FG));
        const bf16* P = p.PQT + (bgc * 2) * S::SEQ; const bf16* Q = P + S::SEQ; float acc = 0.f;
        for (int l = 0; l < S::SEQ; ++l) { const int m = (int)(((long)l * lp) % S::SEQ); acc += p.TABL[2 * m] * bf2f(P[l]) - p.TABL[2 * m + 1] * bf2f(Q[l]); }
        p.Y[((long)b * S::SEQ + lp) * S::YCOLS + S::Y_B + g * S::FGW + cp] = f2bf(acc * sc); } }
    { const long total = (long)S::B * S::FG * S::FGW * S::CTX; const float sc = 1.0f / sqrtf((float)S::CTX);
      for (long i = gt; i < total; i += gs) {
        const int lp = (int)(i % S::CTX); const long bgc = i / S::CTX; const int cp = (int)(bgc % S::FGW), g = (int)((bgc / S::FGW) % S::FG), b = (int)(bgc / ((long)S::FGW * S::FG));
        const bf16* P = p.PQTC + (bgc * 2) * S::CTX; const bf16* Q = P + S::CTX; float acc = 0.f;
        for (int l = 0; l < S::CTX; ++l) { const int m = (l * lp) % S::CTX; acc += p.TABX[2 * m] * bf2f(P[l]) - p.TABX[2 * m + 1] * bf2f(Q[l]); }
        p.Y[((long)S::NLAT + (long)b * S::CTX + lp) * S::YCOLS + S::Y_B + g * S::FGW + cp] = f2bf(acc * sc); } }
}

template <class S> DEVFN void nv_attn(const Params& p, int l, long gt, long gs) {
    const float scale = 1.0f / sqrtf((float)S::HD);
    const long total = (long)S::NTOK * S::SH;
    for (long i = gt; i < total; i += gs) {
        const int hq = (int)(i % S::SH); const long row = i / S::SH; const int hk = hq / S::SG; const int b = row_batch<S>((int)row);
        float q[S::HD], o[S::HD];
        _Pragma("unroll") for (int d = 0; d < S::HD; ++d) { q[d] = bf2f(p.PROJ[row * S::PCOLS + S::P_QC + hq * S::HD + d]) * scale; o[d] = 0.f; }
        float m = p.sink[l * S::SH + hq], lsum = 1.0f;
        const bool lat = row < S::NLAT; const int s = (int)(row % S::SEQ);
        const int nwin = lat ? 2 * S::WIN + 1 : 0;
        for (int t = 0; t < nwin + S::CTX; ++t) {
            long krow;
            if (t < nwin) { const int kp = s - S::WIN + t; if (kp < 0 || kp >= S::SEQ) continue; krow = (long)b * S::SEQ + kp; }
            else krow = (long)S::NLAT + (long)b * S::CTX + (t - nwin);
            const bf16* kr = p.PROJ + krow * S::PCOLS + S::P_KC + hk * S::HD; const bf16* vr = p.PROJ + krow * S::PCOLS + S::P_VC + hk * S::HD;
            float sc = 0.f; _Pragma("unroll") for (int d = 0; d < S::HD; ++d) sc += q[d] * bf2f(kr[d]);
            if (sc > m) { const float r = expf(m - sc); lsum *= r; _Pragma("unroll") for (int d = 0; d < S::HD; ++d) o[d] *= r; m = sc; }
            const float pe = expf(sc - m); lsum += pe;
            _Pragma("unroll") for (int d = 0; d < S::HD; ++d) o[d] += pe * bf2f(vr[d]);
        }
        const float inv = 1.0f / lsum;
        _Pragma("unroll") for (int d = 0; d < S::HD; ++d) p.Y[row * S::YCOLS + S::Y_C + hq * S::HD + d] = f2bf(o[d] * inv);
    }
}

template <class S> DEVFN void nv_gla_rec(const Params& p, long gt, long gs) {
    const long total = (long)S::B * S::GH * 2 * S::DV;
    for (long i = gt; i < total; i += gs) {
        const int v = (int)(i % S::DV), dir = (int)((i / S::DV) % 2), h = (int)((i / (2 * S::DV)) % S::GH), b = (int)(i / (2 * S::DV * S::GH));
        float St[S::DK]; _Pragma("unroll") for (int k = 0; k < S::DK; ++k) St[k] = 0.f;
        for (int t = 0; t < S::CTX + S::SEQ; ++t) {
            long row;
            if (t < S::CTX) row = (long)S::NLAT + (long)b * S::CTX + (dir == 0 ? t : S::CTX - 1 - t);
            else { const int u = t - S::CTX; row = (long)b * S::SEQ + (dir == 0 ? u : S::SEQ - 1 - u); }
            const bf16* pr = p.PROJ + row * S::PCOLS; const float* la = p.LA + row * 2 * S::QKW + dir * S::QKW + h * S::DK;
            const float vv = bf2f(pr[S::P_VA + h * S::DV + v]); float o = 0.f;
            _Pragma("unroll") for (int k = 0; k < S::DK; ++k) { St[k] = expf(la[k]) * St[k] + bf2f(pr[S::P_KA + h * S::DK + k]) * vv; o += bf2f(pr[S::P_QA + h * S::DK + k]) * St[k]; }
            p.OG[((long)dir * S::NTOK + row) * S::VW + h * S::DV + v] = o;
        }
    }
}
template <class S> DEVFN void nv_gla_out(const Params& p, int l, long gt, long gs) {
    const long total = (long)S::NTOK * S::GH;
    for (long i = gt; i < total; i += gs) {
        const int h = (int)(i % S::GH); const long row = i / S::GH;
        const float* o0 = p.OG + row * S::VW + h * S::DV; const float* o1 = o0 + (long)S::NTOK * S::VW;
        float ss = 0.f; for (int v = 0; v < S::DV; ++v) { const float o = o0[v] + o1[v]; ss += o * o; }
        const float rstd = 1.0f / sqrtf(ss / S::DV + S::EPS);
        for (int v = 0; v < S::DV; ++v) { const float o = (o0[v] + o1[v]) * rstd * p.g_gla[l * S::DV + v]; const float r = bf2f(p.PROJ[row * S::PCOLS + S::P_RA + h * S::DV + v]);
            p.Y[row * S::YCOLS + S::Y_A + h * S::DV + v] = f2bf(o * siluf_(r)); }
    }
}

template <class S> DEVFN void nv_merge(const Params& p, int l, long gt, long gs) {
    const long total = (long)S::NTOK * S::D;
    for (long i = gt; i < total; i += gs) {
        const int col = (int)(i % S::D); const long row = i / S::D; const bf16* y = p.Y + row * S::YCOLS; const bf16* g = p.PROJ + row * S::PCOLS + S::P_G;
        float a = 0.f, b = 0.f, c = 0.f;
        const float* wa = p.w_pa + (long)l * S::VW * S::D + col; const float* wb = p.w_pb + (long)l * S::FW * S::D + col; const float* wc = p.w_pc + (long)l * S::SQW * S::D + col;
        for (int k = 0; k < S::VW; ++k) a += bf2f(y[S::Y_A + k]) * wa[(long)k * S::D];
        for (int k = 0; k < S::FW; ++k) b += bf2f(y[S::Y_B + k]) * wb[(long)k * S::D];
        for (int k = 0; k < S::SQW; ++k) c += bf2f(y[S::Y_C + k]) * wc[(long)k * S::D];
        p.MERGED[i] = f2bf(bf2f(g[col]) * a + bf2f(g[S::D + col]) * b + bf2f(g[2 * S::D + col]) * c);
    }
}
template <class S> DEVFN void nv_out(const Params& p, int l, long gt, long gs) {
    const long total = (long)S::NTOK * S::D;
    for (long i = gt; i < total; i += gs) {
        const int col = (int)(i % S::D); const long row = i / S::D; const bf16* m = p.MERGED + row * S::D; const float* w = p.w_out + (long)l * S::D * S::D + col;
        float acc = 0.f; for (int k = 0; k < S::D; ++k) acc += bf2f(m[k]) * w[(long)k * S::D];
        const float g1 = p.MODS[((long)l * (S::B + 1) + row_modrow<S>((int)row)) * S::NMOD + 2 * S::D + col];
        p.X[i] += g1 * acc;
    }
}
template <class S> DEVFN void nv_norm2(const Params& p, int l, long gt, long gs) {
    for (long row = gt; row < S::NTOK; row += gs) {
        const float* xr = p.X + row * S::D; const float* md = p.MODS + ((long)l * (S::B + 1) + row_modrow<S>((int)row)) * S::NMOD; const float* g = p.g_ffn + (long)l * S::D;
        float ss = 0.f; for (int c = 0; c < S::D; ++c) ss += xr[c] * xr[c];
        const float rstd = 1.0f / sqrtf(ss / S::D + S::EPS);
        float gl[S::MG], el[S::NE]; _Pragma("unroll") for (int n = 0; n < S::MG; ++n) gl[n] = 0.f; _Pragma("unroll") for (int n = 0; n < S::NE; ++n) el[n] = 0.f;
        const float* wg = p.w_rg + (long)l * S::D * S::MG; const float* we = p.w_re + (long)l * S::D * S::NE;
        for (int c = 0; c < S::D; ++c) { const float h2 = xr[c] * rstd * g[c] * (1.0f + md[4 * S::D + c]) + md[3 * S::D + c]; p.H[row * S::D + c] = f2bf(h2);
            _Pragma("unroll") for (int n = 0; n < S::MG; ++n) gl[n] += h2 * wg[c * S::MG + n]; _Pragma("unroll") for (int n = 0; n < S::NE; ++n) el[n] += h2 * we[c * S::NE + n]; }
        int gsel = 0; float gmax = gl[0];
        _Pragma("unroll") for (int n = 1; n < S::MG; ++n) if (gl[n] > gmax) { gmax = gl[n]; gsel = n; }
        float gsum = 0.f; _Pragma("unroll") for (int n = 0; n < S::MG; ++n) gsum += expf(gl[n] - gmax);
        const float ggate = 1.0f / gsum;
        float ev[S::MEG];
        _Pragma("unroll") for (int n = 0; n < S::MEG; ++n) { ev[n] = el[n]; _Pragma("unroll") for (int g2 = 1; g2 < S::MG; ++g2) if (g2 == gsel) ev[n] = el[g2 * S::MEG + n]; }
        int i1 = 0; float v1 = ev[0];
        _Pragma("unroll") for (int n = 1; n < S::MEG; ++n) if (ev[n] > v1) { v1 = ev[n]; i1 = n; }
        int i2 = -1; float v2 = 0.f;
        _Pragma("unroll") for (int n = 0; n < S::MEG; ++n) if (n != i1 && (i2 < 0 || ev[n] > v2)) { v2 = ev[n]; i2 = n; }
        const float e2 = expf(v2 - v1);
        p.TOPE[row * 2] = gsel * S::MEG + i1; p.TOPE[row * 2 + 1] = gsel * S::MEG + i2;
        p.TOPW[row * 2] = ggate / (1.0f + e2); p.TOPW[row * 2 + 1] = ggate * e2 / (1.0f + e2);
    }
}
template <class S> DEVFN void nv_moe_up(const Params& p, int l, long gt, long gs) {
    const long total = (long)S::NTOK * 2 * S::DE;
    for (long i = gt; i < total; i += gs) {
        const int j = (int)(i % S::DE); const long rk = i / S::DE; const long row = rk / 2; const int e = p.TOPE[rk];
        const float* a = p.w1 + ((long)(l * S::NE + e) * S::D) * S::DE + j; const float* b = p.w3 + ((long)(l * S::NE + e) * S::D) * S::DE + j; const bf16* h = p.H + row * S::D;
        float u = 0.f, v = 0.f; for (int k = 0; k < S::D; ++k) { const float hv = bf2f(h[k]); u += hv * a[(long)k * S::DE]; v += hv * b[(long)k * S::DE]; }
        p.HIDN[i] = f2bf(siluf_(u) * v);
    }
}
template <class S> DEVFN void nv_moe_down(const Params& p, int l, long gt, long gs) {
    const long total = (long)S::NTOK * 2 * S::D;
    for (long i = gt; i < total; i += gs) {
        const int col = (int)(i % S::D); const long rk = i / S::D; const int e = p.TOPE[rk];
        const float* w = p.w2 + ((long)(l * S::NE + e) * S::DE) * S::D + col; const bf16* hd = p.HIDN + rk * S::DE;
        float acc = 0.f; for (int j = 0; j < S::DE; ++j) acc += bf2f(hd[j]) * w[(long)j * S::D];
        p.C2[i] = f2bf(acc * p.TOPW[rk]);
    }
}

#define XB_TMO      128
#define XB_XCNT(j)  (256  + 64 * (j))
#define XB_XSUB(j)  (1280 + 64 * (j))
#define XB_XGEN(j)  (2304 + 64 * (j))
#define XB_TOP      3328
#define XB_TOPGEN   3392
#define XCD_BAR_WORDS 3456
#define XB_SPIN_CAP (1u << 18)
#define LAS __attribute__((address_space(3)))

__device__ __forceinline__ unsigned xb_ld(unsigned* p)              { return __hip_atomic_load(p, __ATOMIC_RELAXED, __HIP_MEMORY_SCOPE_AGENT); }
__device__ __forceinline__ unsigned xb_add(unsigned* p, unsigned v) { return __hip_atomic_fetch_add(p, v, __ATOMIC_RELAXED, __HIP_MEMORY_SCOPE_AGENT); }
__device__ __forceinline__ unsigned xb_xcc_id() { return (unsigned)__builtin_amdgcn_s_getreg((3 << 11) | 20) & 0xFu; }
#define XB_SPIN(cond, bar) do { unsigned _sp = 0; while (cond) { __builtin_amdgcn_s_sleep(1); \
    if ((++_sp & 255u) == 0u) { if (xb_ld(&(bar)[XB_TMO])) break; if (_sp > XB_SPIN_CAP) { atomicAdd(&(bar)[XB_TMO], 1u); break; } } } } while (0)

struct XcdBarrier {
    unsigned* bar; unsigned x;
    volatile LAS unsigned* st;
};

__device__ __forceinline__ XcdBarrier xcd_barrier_post(unsigned* bar, volatile LAS unsigned* st) {
    XcdBarrier b; b.bar = bar; b.x = xb_xcc_id(); b.st = st;
    if (threadIdx.x == 0) (void)xb_add(&bar[XB_XCNT(b.x)], 1u);
    return b;
}
__device__ __forceinline__ void xcd_barrier_complete(unsigned* bar, unsigned x, unsigned& nloc, unsigned& nx) {
    const unsigned G = gridDim.x * gridDim.y * gridDim.z;
    unsigned sum, cnt, mine, sp = 0u;
    for (;;) {
        sum = 0u; cnt = 0u; mine = 0u;
#pragma unroll
        for (unsigned j = 0; j < 16; ++j) { const unsigned c = xb_ld(&bar[XB_XCNT(j)]); sum += c; cnt += (c > 0u) ? 1u : 0u; mine = (j == x) ? c : mine; }
        if (sum == G) break;
        __builtin_amdgcn_s_sleep(1);
        if ((++sp & 255u) == 0u) { if (xb_ld(&bar[XB_TMO])) break; if (sp > XB_SPIN_CAP) { atomicAdd(&bar[XB_TMO], 1u); break; } }
    }
    nloc = mine > 0u ? mine : 1u; nx = cnt > 0u ? cnt : 1u;
}

__device__ __forceinline__ void xcd_barrier(const XcdBarrier& b) {
    asm volatile("s_waitcnt vmcnt(0)" ::: "memory");
    __syncthreads();
    if (threadIdx.x == 0) {
        unsigned* bar = b.bar;
        __builtin_amdgcn_s_waitcnt(0);
        unsigned nloc = b.st[0], nx = b.st[1];
        if (nloc == 0u) { xcd_barrier_complete(bar, b.x, nloc, nx); b.st[0] = nloc; b.st[1] = nx; }
        const unsigned old = xb_add(&bar[XB_XSUB(b.x)], 1u);
        const unsigned gen = old / nloc;
        if (old + 1u == (gen + 1u) * nloc) {
            __builtin_amdgcn_fence(__ATOMIC_RELEASE, "agent");
            asm volatile("s_waitcnt vmcnt(0)" ::: "memory");
            const unsigned og = xb_add(&bar[XB_TOP], 1u);
            const unsigned tg = og / nx;
            if (og + 1u == (tg + 1u) * nx) xb_add(&bar[XB_TOPGEN], 1u);
            else XB_SPIN(xb_ld(&bar[XB_TOPGEN]) == tg, bar);
            __builtin_amdgcn_fence(__ATOMIC_ACQUIRE, "agent");
            xb_add(&bar[XB_XGEN(b.x)], 1u);
            asm volatile("s_waitcnt vmcnt(0)" ::: "memory");
        } else {
            XB_SPIN(xb_ld(&bar[XB_XGEN(b.x)]) == gen, bar);
            __builtin_amdgcn_fence(__ATOMIC_ACQUIRE, "agent");
            asm volatile("s_waitcnt vmcnt(0)" ::: "memory");
        }
    }
    __syncthreads();
}


typedef Sh<CfgFull> SF;
constexpr int NTHREADS = 512;
constexpr int LDS_BYTES = 132 * 1024;
constexpr int LDS_BARW = LDS_BYTES - 16;
#ifndef MK_PER_PHASE
#define MK_PER_PHASE 0
#endif

struct KArgs { Params p; int lo, hi; };

__global__ void __launch_bounds__(NTHREADS, 2) mega(KArgs a) {
    extern __shared__ __attribute__((aligned(16))) unsigned char lds[];
    const Params& p = a.p;
    const int tid = threadIdx.x;
    const long gt = (long)blockIdx.x * NTHREADS + tid, gs = (long)gridDim.x * NTHREADS;
    const int lo = a.lo, hi = a.hi;
    if (tid < 4) ((LAS unsigned*)(lds + LDS_BARW))[tid] = 0u;
    __syncthreads();
    XcdBarrier bar; bar.bar = p.ctl; bar.x = 0; bar.st = (volatile LAS unsigned*)(lds + LDS_BARW);
    if (hi - lo > 1) bar = xcd_barrier_post(p.ctl, (volatile LAS unsigned*)(lds + LDS_BARW));
    int ph = 0;
#define PHASE(body) do { if (ph >= lo && ph < hi) { body; if (ph + 1 < hi) xcd_barrier(bar); } ++ph; } while (0)
    PHASE(nv_tables<SF>(p, gt, gs));
    PHASE(nv_mods<SF>(p, gt, gs));
    PHASE(nv_resnorm<SF>(p, 0, 0, gt, gs));
    for (int l = 0; l < SF::DEPTH; ++l) {
        PHASE(nv_inproj<SF>(p, l, gt, gs));
        PHASE(nv_decay1<SF>(p, l, gt, gs));
        PHASE(nv_decay2<SF>(p, l, gt, gs));
        PHASE(nv_chdft<SF>(p, gt, gs));
        PHASE(nv_seqdft<SF>(p, gt, gs));
        PHASE(nv_attn<SF>(p, l, gt, gs));
        PHASE(nv_gla_rec<SF>(p, gt, gs));
        PHASE(nv_gla_out<SF>(p, l, gt, gs));
        PHASE(nv_merge<SF>(p, l, gt, gs));
        PHASE(nv_out<SF>(p, l, gt, gs));
        PHASE(nv_norm2<SF>(p, l, gt, gs));
        PHASE(nv_moe_up<SF>(p, l, gt, gs));
        PHASE(nv_moe_down<SF>(p, l, gt, gs));
        PHASE(nv_resnorm<SF>(p, l + 1, (l + 1 < SF::DEPTH) ? 1 : 2, gt, gs));
    }
#undef PHASE
}
constexpr int N_PHASES = 3 + SF::DEPTH * 14;

extern "C" void kernel_launch(void* const* d_in, const int* in_sizes, int n_in, void* d_out, int out_size, void* d_ws, size_t ws_size, hipStream_t stream) {
    static int grid = 0;
    if (grid == 0) {
        int dev = 0, cus = 0;
        if (hipGetDevice(&dev) != hipSuccess || hipDeviceGetAttribute(&cus, hipDeviceAttributeMultiprocessorCount, dev) != hipSuccess) { fprintf(stderr, "kernel_launch: device query failed\n"); grid = -1; return; }
        if (hipFuncSetAttribute((const void*)mega, hipFuncAttributeMaxDynamicSharedMemorySize, LDS_BYTES) != hipSuccess) { fprintf(stderr, "kernel_launch: hipFuncSetAttribute failed\n"); grid = -1; return; }
        int per_cu = 0;
        if (hipOccupancyMaxActiveBlocksPerMultiprocessor(&per_cu, (const void*)mega, NTHREADS, LDS_BYTES) != hipSuccess || per_cu < 1) { fprintf(stderr, "kernel_launch: occupancy query says %d\n", per_cu); }
        (void)hipGetLastError();
        grid = cus;
    }
    if (grid < 0) return;
    if (n_in != 24 || out_size != SF::NLAT * SF::D) { fprintf(stderr, "kernel_launch: unexpected shapes (n_in %d, out %d)\n", n_in, out_size); return; }
    KArgs a; memset(&a, 0, sizeof(a));
    Params& p = a.p;
    const float* const* in = (const float* const*)d_in;
    p.x = in[0]; p.c = in[1]; p.ctx = in[2]; p.c_ctx = in[3]; p.w_ada = in[4]; p.b_ada = in[5]; p.g_mix = in[6]; p.g_ffn = in[7]; p.w_in = in[8]; p.w_dd = in[9]; p.w_du = in[10];
    p.b_dec = in[11]; p.g_gla = in[12]; p.sink = in[13]; p.w_pa = in[14]; p.w_pb = in[15]; p.w_pc = in[16]; p.w_out = in[17]; p.w_rg = in[18]; p.w_re = in[19]; p.w1 = in[20];
    p.w3 = in[21]; p.w2 = in[22]; p.g_final = in[23];
    p.out = (float*)d_out;
    size_t off = 0; unsigned char* ws = (unsigned char*)d_ws;
    auto take = [&](size_t bytes) { void* q = ws + off; off += (bytes + 255) & ~(size_t)255; return q; };
    const size_t NT = SF::NTOK, D = SF::D;
    constexpr size_t CTL_BYTES = 64 * 1024;
    p.ctl = (unsigned*)take(CTL_BYTES);
    p.X = (float*)take(NT * D * 4); p.MODS = (float*)take((size_t)SF::DEPTH * (SF::B + 1) * SF::NMOD * 4);
    p.TABL = (float*)take(2 * SF::SEQ * 4); p.TABX = (float*)take(2 * SF::CTX * 4); p.TABC = (float*)take(2 * SF::FGW * 4); p.ROPE = (float*)take(2 * SF::NPOS * SF::NFREQ * 4);
    p.H = (bf16*)take(NT * D * 2); p.PROJ = (bf16*)take(NT * SF::PCOLS * 2); p.LA = (float*)take(NT * 2 * SF::QKW * 4); p.UB = (float*)take(NT * SF::FW * 4);
    p.D16 = (float*)take(NT * 2 * SF::RANK * 4); p.PQT = (bf16*)take((size_t)SF::B * SF::FG * SF::FGW * 2 * SF::SEQ * 2); p.PQTC = (bf16*)take((size_t)SF::B * SF::FG * SF::FGW * 2 * SF::CTX * 2);
    p.Y = (bf16*)take(NT * SF::YCOLS * 2); p.OG = (float*)take(2 * NT * SF::VW * 4);
    p.MERGED = (bf16*)p.UB;
    p.TOPE = (int*)take(NT * 2 * 4); p.TOPW = (float*)take(NT * 2 * 4);
    p.HIDN = (bf16*)p.PROJ;
    p.C2 = (bf16*)((unsigned char*)p.PROJ + ((NT * 2 * SF::DE * 2 + 255) & ~(size_t)255));
    if (off > ws_size) { fprintf(stderr, "kernel_launch: workspace too small: need %zu, have %zu\n", off, ws_size); return; }
    if (hipMemsetAsync(d_ws, 0, CTL_BYTES, stream) != hipSuccess) { fprintf(stderr, "kernel_launch: memset failed\n"); return; }
#if MK_PER_PHASE
    for (int i = 0; i < N_PHASES; ++i) { a.lo = i; a.hi = i + 1; hipLaunchKernelGGL(mega, dim3(grid), dim3(NTHREADS), LDS_BYTES, stream, a); }
#else
    a.lo = 0; a.hi = N_PHASES; hipLaunchKernelGGL(mega, dim3(grid), dim3(NTHREADS), LDS_BYTES, stream, a);
#endif
    const hipError_t le = hipPeekAtLastError();
    if (le != hipSuccess) fprintf(stderr, "kernel_launch: launch failed: %s\n", hipGetErrorName(le));
}
```

```cpp
#include <hip/hip_runtime.h>
#include <cstdio>
#include <cstdint>
#include <cstring>
#ifdef CPU_EMU
#include <cmath>
#include <cstdint>
#include <cstring>
#define DEVFN static inline
#else
#define DEVFN __device__ __forceinline__
#endif

typedef unsigned short bf16;
DEVFN float bf2f(bf16 v) { unsigned u = ((unsigned)v) << 16; float f; memcpy(&f, &u, 4); return f; }
DEVFN bf16 f2bf(float f) { unsigned u; memcpy(&u, &f, 4); u += 0x7fffu + ((u >> 16) & 1u); return (bf16)(u >> 16); }
DEVFN float sigmoidf_(float x) { return 1.0f / (1.0f + expf(-x)); }
DEVFN float siluf_(float x) { return x / (1.0f + expf(-x)); }
DEVFN float logsigmoidf_(float x) { return fminf(x, 0.0f) - log1pf(expf(-fabsf(x))); }

struct CfgFull { static constexpr int D = 1024, B = 4, SEQ = 4096, DEPTH = 4, GW = 64, CTX = 256, GH = 4, DK = 64, DV = 128, RANK = 16, FG = 4, FGW = 128,
                 SH = 8, SKV = 2, HD = 64, WIN = 128, MG = 4, MEG = 4, DE = 512; };
#ifndef SMALL_SEQ
#define SMALL_SEQ 256
#endif
struct CfgSmall { static constexpr int D = 64, B = 2, SEQ = SMALL_SEQ, DEPTH = 2, GW = 16, CTX = 64, GH = 2, DK = 8, DV = 16, RANK = 4, FG = 2, FGW = 16,
                  SH = 4, SKV = 2, HD = 8, WIN = 32, MG = 2, MEG = 4, DE = 32; };

template <class C> struct Sh : C {
    static constexpr int NLAT = C::B * C::SEQ, NCTX = C::B * C::CTX, NTOK = NLAT + NCTX;
    static constexpr int QKW = C::GH * C::DK, VW = C::GH * C::DV, FW = C::FG * C::FGW, SQW = C::SH * C::HD, SKW = C::SKV * C::HD, NE = C::MG * C::MEG, SG = C::SH / C::SKV;
    static constexpr int NMOD = 6 * C::D;
    static constexpr int L_KA = 0, L_VA = L_KA + QKW, L_KC = L_VA + VW, L_VC = L_KC + SKW, L_QA = L_VC + SKW, L_RA = L_QA + QKW, L_UB = L_RA + VW, L_QC = L_UB + FW, L_G = L_QC + SQW, INCOLS = L_G + 3 * C::D;
    static constexpr int P_KA = 0, P_VA = P_KA + QKW, P_KC = P_VA + VW, P_VC = P_KC + SKW, P_QA = P_VC + SKW, P_RA = P_QA + QKW, P_QC = P_RA + VW, P_G = P_QC + SQW, PCOLS = P_G + 3 * C::D;
    static constexpr int YCOLS = VW + FW + SQW;
    static constexpr int Y_A = 0, Y_B = VW, Y_C = VW + FW;
    static constexpr int NFREQ = C::HD / 4;
    static constexpr int NPOS = (C::GW > C::SEQ / C::GW) ? C::GW : C::SEQ / C::GW;
    static constexpr float EPS = 1e-6f;
};

template <class S> DEVFN int row_batch(int row) { return row < S::NLAT ? row / S::SEQ : (row - S::NLAT) / S::CTX; }
template <class S> DEVFN int row_modrow(int row) { return row < S::NLAT ? row / S::SEQ : S::B; }

struct Params {
    const float *x, *c, *ctx, *c_ctx, *w_ada, *b_ada, *g_mix, *g_ffn, *w_in, *w_dd, *w_du, *b_dec, *g_gla, *sink, *w_pa, *w_pb, *w_pc, *w_out, *w_rg, *w_re, *w1, *w3, *w2, *g_final;
    float* out;
    unsigned* ctl;
    float* X;
    float* MODS;
    float* TABL;
    float* TABX;
    float* TABC;
    float* ROPE;
    bf16* H;
    bf16* PROJ;
    float* LA;
    float* UB;
    float* D16;
    bf16* PQT;
    bf16* PQTC;
    bf16* Y;
    float* OG;
    bf16* MERGED;
    int* TOPE;
    float* TOPW;
    bf16* HIDN;
    bf16* C2;
};

template <class S> DEVFN void nv_tables(const Params& p, long gt, long gs) {
    const float TWO_PI = 6.283185307179586f;
    for (long i = gt; i < S::SEQ; i += gs) { double a = 6.283185307179586 * (double)i / S::SEQ; p.TABL[2 * i] = (float)cos(a); p.TABL[2 * i + 1] = (float)sin(a); }
    for (long i = gt; i < S::CTX; i += gs) { double a = 6.283185307179586 * (double)i / S::CTX; p.TABX[2 * i] = (float)cos(a); p.TABX[2 * i + 1] = (float)sin(a); }
    for (long i = gt; i < S::FGW; i += gs) { double a = 6.283185307179586 * (double)i / S::FGW; p.TABC[2 * i] = (float)cos(a); p.TABC[2 * i + 1] = (float)sin(a); }
    for (long i = gt; i < S::NPOS * S::NFREQ; i += gs) {
        int pos = (int)(i / S::NFREQ), f = (int)(i % S::NFREQ);
        float inv = powf(10000.0f, -(float)(2 * f) / (float)(S::HD / 2));
        float a = (float)pos * inv; p.ROPE[2 * i] = cosf(a); p.ROPE[2 * i + 1] = sinf(a);
    }
    (void)TWO_PI;
}

template <class S> DEVFN void nv_mods(const Params& p, long gt, long gs) {
    const long total = (long)S::DEPTH * (S::B + 1) * S::NMOD;
    for (long i = gt; i < total; i += gs) {
        int n = (int)(i % S::NMOD); int r = (int)((i / S::NMOD) % (S::B + 1)); int l = (int)(i / ((long)S::NMOD * (S::B + 1)));
        const float* cv = r < S::B ? p.c + (long)r * S::D : p.c_ctx;
        const float* w = p.w_ada + (long)l * S::D * S::NMOD + n;
        float acc = 0.f;
        for (int k = 0; k < S::D; ++k) acc += siluf_(cv[k]) * w[(long)k * S::NMOD];
        p.MODS[i] = acc + p.b_ada[(long)l * S::NMOD + n];
    }
}

template <class S> DEVFN void nv_resnorm(const Params& p, int l, int mode, long gt, long gs) {
    for (long row = gt; row < S::NTOK; row += gs) {
        const int mr = row_modrow<S>((int)row);
        float* xr = p.X + row * S::D;
        const float* src = nullptr;
        if (mode == 0) src = row < S::NLAT ? p.x + row * S::D : p.ctx + (row - S::NLAT) * S::D;
        const float* gate2 = (mode != 0) ? p.MODS + ((long)(l - 1) * (S::B + 1) + mr) * S::NMOD + 5 * S::D : nullptr;
        float ss = 0.f;
        for (int c = 0; c < S::D; ++c) {
            float v;
            if (mode == 0) v = src[c];
            else v = xr[c] + gate2[c] * (bf2f(p.C2[(row * 2) * S::D + c]) + bf2f(p.C2[(row * 2 + 1) * S::D + c]));
            xr[c] = v; ss += v * v;
        }
        const float rstd = 1.0f / sqrtf(ss / S::D + S::EPS);
        if (mode == 2) {
            if (row < S::NLAT) for (int c = 0; c < S::D; ++c) p.out[row * S::D + c] = xr[c] * rstd * p.g_final[c];
        } else {
            const float* md = p.MODS + ((long)l * (S::B + 1) + mr) * S::NMOD;
            const float* g = p.g_mix + (long)l * S::D;
            for (int c = 0; c < S::D; ++c) p.H[row * S::D + c] = f2bf(xr[c] * rstd * g[c] * (1.0f + md[S::D + c]) + md[c]);
        }
    }
}

template <class S> DEVFN float rope_apply(const Params& p, int s, int d, float own, float partner) {
    const int half = d / (S::HD / 2), i = d % (S::HD / 2), f = i % S::NFREQ; const bool second = i >= S::NFREQ;
    const int pos = half == 0 ? s / S::GW : s % S::GW;
    const float cs = p.ROPE[2 * (pos * S::NFREQ + f)], sn = p.ROPE[2 * (pos * S::NFREQ + f) + 1];
    return second ? partner * sn + own * cs : own * cs - partner * sn;
}

template <class S> DEVFN void nv_inproj(const Params& p, int l, long gt, long gs) {
    const long total = (long)S::NTOK * S::INCOLS;
    const float* W = p.w_in + (long)l * S::D * S::INCOLS;
    for (long i = gt; i < total; i += gs) {
        const int col = (int)(i % S::INCOLS); const long row = i / S::INCOLS;
        const bf16* h = p.H + row * S::D;
        const bool is_kc = col >= S::L_KC && col < S::L_VC, is_qc = col >= S::L_QC && col < S::L_G;
        int pcol = col;
        if (is_kc || is_qc) { const int base = is_kc ? S::L_KC : S::L_QC; const int d = (col - base) % S::HD; const int ii = d % (S::HD / 2);
            pcol = ii < S::NFREQ ? col + S::NFREQ : col - S::NFREQ; }
        float acc = 0.f, acc2 = 0.f;
        if (is_kc || is_qc) { for (int k = 0; k < S::D; ++k) { const float hv = bf2f(h[k]); acc += hv * W[(long)k * S::INCOLS + col]; acc2 += hv * W[(long)k * S::INCOLS + pcol]; } }
        else { for (int k = 0; k < S::D; ++k) acc += bf2f(h[k]) * W[(long)k * S::INCOLS + col]; }
        bf16* pr = p.PROJ + row * S::PCOLS;
        if (col < S::L_VA) pr[S::P_KA + col - S::L_KA] = f2bf(acc);
        else if (col < S::L_KC) pr[S::P_VA + col - S::L_VA] = f2bf(acc);
        else if (col < S::L_VC) { float v = acc; if (row < S::NLAT) v = rope_apply<S>(p, (int)(row % S::SEQ), (col - S::L_KC) % S::HD, acc, acc2); pr[S::P_KC + col - S::L_KC] = f2bf(v); }
        else if (col < S::L_QA) pr[S::P_VC + col - S::L_VC] = f2bf(acc);
        else if (col < S::L_RA) pr[S::P_QA + col - S::L_QA] = f2bf(acc * (1.0f / sqrtf((float)S::DK)));
        else if (col < S::L_UB) pr[S::P_RA + col - S::L_RA] = f2bf(acc);
        else if (col < S::L_QC) p.UB[row * S::FW + col - S::L_UB] = acc;
        else if (col < S::L_G) { float v = acc; if (row < S::NLAT) v = rope_apply<S>(p, (int)(row % S::SEQ), (col - S::L_QC) % S::HD, acc, acc2); pr[S::P_QC + col - S::L_QC] = f2bf(v); }
        else pr[S::P_G + col - S::L_G] = f2bf(sigmoidf_(acc));
    }
}

template <class S> DEVFN void nv_decay1(const Params& p, int l, long gt, long gs) {
    const long total = (long)S::NTOK * 2 * S::RANK;
    for (long i = gt; i < total; i += gs) {
        const int r = (int)(i % S::RANK), dir = (int)((i / S::RANK) % 2); const long row = i / (2 * S::RANK);
        const float* w = p.w_dd + ((long)(l * 2 + dir) * S::D) * S::RANK + r; const bf16* h = p.H + row * S::D;
        float acc = 0.f; for (int k = 0; k < S::D; ++k) acc += bf2f(h[k]) * w[(long)k * S::RANK];
        p.D16[i] = acc;
    }
}
template <class S> DEVFN void nv_decay2(const Params& p, int l, long gt, long gs) {
    const long total = (long)S::NTOK * 2 * S::QKW;
    for (long i = gt; i < total; i += gs) {
        const int n = (int)(i % S::QKW), dir = (int)((i / S::QKW) % 2); const long row = i / (2 * S::QKW);
        const float* w = p.w_du + ((long)(l * 2 + dir) * S::RANK) * S::QKW + n; const float* d = p.D16 + (row * 2 + dir) * S::RANK;
        float z = p.b_dec[(long)(l * 2 + dir) * S::QKW + n]; for (int r = 0; r < S::RANK; ++r) z += d[r] * w[(long)r * S::QKW];
        p.LA[i] = logsigmoidf_(z) * (1.0f / 16.0f);
    }
}

template <class S> DEVFN void nv_chdft(const Params& p, long gt, long gs) {
    const long total = (long)S::NTOK * S::FG * S::FGW * 2;
    const float sc = 1.0f / sqrtf((float)S::FGW);
    for (long i = gt; i < total; i += gs) {
        const int pq = (int)(i % 2), cp = (int)((i / 2) % S::FGW), g = (int)((i / (2 * S::FGW)) % S::FG); const long row = i / (2 * S::FGW * S::FG);
        const float* u = p.UB + row * S::FW + g * S::FGW; float acc = 0.f;
        for (int c = 0; c < S::FGW; ++c) acc += u[c] * p.TABC[2 * ((c * cp) % S::FGW) + pq];
        acc *= sc;
        if (row < S::NLAT) { const int b = (int)(row / S::SEQ), s = (int)(row % S::SEQ); p.PQT[((((long)b * S::FG + g) * S::FGW + cp) * 2 + pq) * S::SEQ + s] = f2bf(acc); }
        else { const int b = (int)((row - S::NLAT) / S::CTX), j = (int)((row - S::NLAT) % S::CTX); p.PQTC[((((long)b * S::FG + g) * S::FGW + cp) * 2 + pq) * S::CTX + j] = f2bf(acc); }
    }
}
template <class S> DEVFN void nv_seqdft(const Params& p, long gt, long gs) {
    { const long total = (long)S::B * S::FG * S::FGW * S::SEQ; const float sc = 1.0f / sqrtf((float)S::SEQ);
      for (long i = gt; i < total; i += gs) {
        const int lp = (int)(i % S::SEQ); const long bgc = i / S::SEQ; const int cp = (int)(bgc % S::FGW), g = (int)((bgc / S::FGW) % S::FG), b = (int)(bgc / ((long)S::FGW * S::FG));
        const bf16* P = p.PQT + (bgc * 2) * S::SEQ; const bf16* Q = P + S::SEQ; float acc = 0.f;
        for (int l = 0; l < S::SEQ; ++l) { const int m = (int)(((long)l * lp) % S::SEQ); acc += p.TABL[2 * m] * bf2f(P[l]) - p.TABL[2 * m + 1] * bf2f(Q[l]); }
        p.Y[((long)b * S::SEQ + lp) * S::YCOLS + S::Y_B + g * S::FGW + cp] = f2bf(acc * sc); } }
    { const long total = (long)S::B * S::FG * S::FGW * S::CTX; const float sc = 1.0f / sqrtf((float)S::CTX);
      for (long i = gt; i < total; i += gs) {
        const int lp = (int)(i % S::CTX); const long bgc = i / S::CTX; const int cp = (int)(bgc % S::FGW), g = (int)((bgc / S::FGW) % S::FG), b = (int)(bgc / ((long)S::FGW * S::FG));
        const bf16* P = p.PQTC + (bgc * 2) * S::CTX; const bf16* Q = P + S::CTX; float acc = 0.f;
        for (int l = 0; l < S::CTX; ++l) { const int m = (l * lp) % S::CTX; acc += p.TABX[2 * m] * bf2f(P[l]) - p.TABX[2 * m + 1] * bf2f(Q[l]); }
        p.Y[((long)S::NLAT + (long)b * S::CTX + lp) * S::YCOLS + S::Y_B + g * S::FGW + cp] = f2bf(acc * sc); } }
}

template <class S> DEVFN void nv_attn(const Params& p, int l, long gt, long gs) {
    const float scale = 1.0f / sqrtf((float)S::HD);
    const long total = (long)S::NTOK * S::SH;
    for (long i = gt; i < total; i += gs) {
        const int hq = (int)(i % S::SH); const long row = i / S::SH; const int hk = hq / S::SG; const int b = row_batch<S>((int)row);
        float q[S::HD], o[S::HD];
        _Pragma("unroll") for (int d = 0; d < S::HD; ++d) { q[d] = bf2f(p.PROJ[row * S::PCOLS + S::P_QC + hq * S::HD + d]) * scale; o[d] = 0.f; }
        float m = p.sink[l * S::SH + hq], lsum = 1.0f;
        const bool lat = row < S::NLAT; const int s = (int)(row % S::SEQ);
        const int nwin = lat ? 2 * S::WIN + 1 : 0;
        for (int t = 0; t < nwin + S::CTX; ++t) {
            long krow;
            if (t < nwin) { const int kp = s - S::WIN + t; if (kp < 0 || kp >= S::SEQ) continue; krow = (long)b * S::SEQ + kp; }
            else krow = (long)S::NLAT + (long)b * S::CTX + (t - nwin);
            const bf16* kr = p.PROJ + krow * S::PCOLS + S::P_KC + hk * S::HD; const bf16* vr = p.PROJ + krow * S::PCOLS + S::P_VC + hk * S::HD;
            float sc = 0.f; _Pragma("unroll") for (int d = 0; d < S::HD; ++d) sc += q[d] * bf2f(kr[d]);
            if (sc > m) { const float r = expf(m - sc); lsum *= r; _Pragma("unroll") for (int d = 0; d < S::HD; ++d) o[d] *= r; m = sc; }
            const float pe = expf(sc - m); lsum += pe;
            _Pragma("unroll") for (int d = 0; d < S::HD; ++d) o[d] += pe * bf2f(vr[d]);
        }
        const float inv = 1.0f / lsum;
        _Pragma("unroll") for (int d = 0; d < S::HD; ++d) p.Y[row * S::YCOLS + S::Y_C + hq * S::HD + d] = f2bf(o[d] * inv);
    }
}

template <class S> DEVFN void nv_gla_rec(const Params& p, long gt, long gs) {
    const long total = (long)S::B * S::GH * 2 * S::DV;
    for (long i = gt; i < total; i += gs) {
        const int v = (int)(i % S::DV), dir = (int)((i / S::DV) % 2), h = (int)((i / (2 * S::DV)) % S::GH), b = (int)(i / (2 * S::DV * S::GH));
        float St[S::DK]; _Pragma("unroll") for (int k = 0; k < S::DK; ++k) St[k] = 0.f;
        for (int t = 0; t < S::CTX + S::SEQ; ++t) {
            long row;
            if (t < S::CTX) row = (long)S::NLAT + (long)b * S::CTX + (dir == 0 ? t : S::CTX - 1 - t);
            else { const int u = t - S::CTX; row = (long)b * S::SEQ + (dir == 0 ? u : S::SEQ - 1 - u); }
            const bf16* pr = p.PROJ + row * S::PCOLS; const float* la = p.LA + row * 2 * S::QKW + dir * S::QKW + h * S::DK;
            const float vv = bf2f(pr[S::P_VA + h * S::DV + v]); float o = 0.f;
            _Pragma("unroll") for (int k = 0; k < S::DK; ++k) { St[k] = expf(la[k]) * St[k] + bf2f(pr[S::P_KA + h * S::DK + k]) * vv; o += bf2f(pr[S::P_QA + h * S::DK + k]) * St[k]; }
            p.OG[((long)dir * S::NTOK + row) * S::VW + h * S::DV + v] = o;
        }
    }
}
template <class S> DEVFN void nv_gla_out(const Params& p, int l, long gt, long gs) {
    const long total = (long)S::NTOK * S::GH;
    for (long i = gt; i < total; i += gs) {
        const int h = (int)(i % S::GH); const long row = i / S::GH;
        const float* o0 = p.OG + row * S::VW + h * S::DV; const float* o1 = o0 + (long)S::NTOK * S::VW;
        float ss = 0.f; for (int v = 0; v < S::DV; ++v) { const float o = o0[v] + o1[v]; ss += o * o; }
        const float rstd = 1.0f / sqrtf(ss / S::DV + S::EPS);
        for (int v = 0; v < S::DV; ++v) { const float o = (o0[v] + o1[v]) * rstd * p.g_gla[l * S::DV + v]; const float r = bf2f(p.PROJ[row * S::PCOLS + S::P_RA + h * S::DV + v]);
            p.Y[row * S::YCOLS + S::Y_A + h * S::DV + v] = f2bf(o * siluf_(r)); }
    }
}

template <class S> DEVFN void nv_merge(const Params& p, int l, long gt, long gs) {
    const long total = (long)S::NTOK * S::D;
    for (long i = gt; i < total; i += gs) {
        const int col = (int)(i % S::D); const long row = i / S::D; const bf16* y = p.Y + row * S::YCOLS; const bf16* g = p.PROJ + row * S::PCOLS + S::P_G;
        float a = 0.f, b = 0.f, c = 0.f;
        const float* wa = p.w_pa + (long)l * S::VW * S::D + col; const float* wb = p.w_pb + (long)l * S::FW * S::D + col; const float* wc = p.w_pc + (long)l * S::SQW * S::D + col;
        for (int k = 0; k < S::VW; ++k) a += bf2f(y[S::Y_A + k]) * wa[(long)k * S::D];
        for (int k = 0; k < S::FW; ++k) b += bf2f(y[S::Y_B + k]) * wb[(long)k * S::D];
        for (int k = 0; k < S::SQW; ++k) c += bf2f(y[S::Y_C + k]) * wc[(long)k * S::D];
        p.MERGED[i] = f2bf(bf2f(g[col]) * a + bf2f(g[S::D + col]) * b + bf2f(g[2 * S::D + col]) * c);
    }
}
template <class S> DEVFN void nv_out(const Params& p, int l, long gt, long gs) {
    const long total = (long)S::NTOK * S::D;
    for (long i = gt; i < total; i += gs) {
        const int col = (int)(i % S::D); const long row = i / S::D; const bf16* m = p.MERGED + row * S::D; const float* w = p.w_out + (long)l * S::D * S::D + col;
        float acc = 0.f; for (int k = 0; k < S::D; ++k) acc += bf2f(m[k]) * w[(long)k * S::D];
        const float g1 = p.MODS[((long)l * (S::B + 1) + row_modrow<S>((int)row)) * S::NMOD + 2 * S::D + col];
        p.X[i] += g1 * acc;
    }
}
template <class S> DEVFN void nv_norm2(const Params& p, int l, long gt, long gs) {
    for (long row = gt; row < S::NTOK; row += gs) {
        const float* xr = p.X + row * S::D; const float* md = p.MODS + ((long)l * (S::B + 1) + row_modrow<S>((int)row)) * S::NMOD; const float* g = p.g_ffn + (long)l * S::D;
        float ss = 0.f; for (int c = 0; c < S::D; ++c) ss += xr[c] * xr[c];
        const float rstd = 1.0f / sqrtf(ss / S::D + S::EPS);
        float gl[S::MG], el[S::NE]; _Pragma("unroll") for (int n = 0; n < S::MG; ++n) gl[n] = 0.f; _Pragma("unroll") for (int n = 0; n < S::NE; ++n) el[n] = 0.f;
        const float* wg = p.w_rg + (long)l * S::D * S::MG; const float* we = p.w_re + (long)l * S::D * S::NE;
        for (int c = 0; c < S::D; ++c) { const float h2 = xr[c] * rstd * g[c] * (1.0f + md[4 * S::D + c]) + md[3 * S::D + c]; p.H[row * S::D + c] = f2bf(h2);
            _Pragma("unroll") for (int n = 0; n < S::MG; ++n) gl[n] += h2 * wg[c * S::MG + n]; _Pragma("unroll") for (int n = 0; n < S::NE; ++n) el[n] += h2 * we[c * S::NE + n]; }
        int gsel = 0; float gmax = gl[0];
        _Pragma("unroll") for (int n = 1; n < S::MG; ++n) if (gl[n] > gmax) { gmax = gl[n]; gsel = n; }
        float gsum = 0.f; _Pragma("unroll") for (int n = 0; n < S::MG; ++n) gsum += expf(gl[n] - gmax);
        const float ggate = 1.0f / gsum;
        float ev[S::MEG];
        _Pragma("unroll") for (int n = 0; n < S::MEG; ++n) { ev[n] = el[n]; _Pragma("unroll") for (int g2 = 1; g2 < S::MG; ++g2) if (g2 == gsel) ev[n] = el[g2 * S::MEG + n]; }
        int i1 = 0; float v1 = ev[0];
        _Pragma("unroll") for (int n = 1; n < S::MEG; ++n) if (ev[n] > v1) { v1 = ev[n]; i1 = n; }
        int i2 = -1; float v2 = 0.f;
        _Pragma("unroll") for (int n = 0; n < S::MEG; ++n) if (n != i1 && (i2 < 0 || ev[n] > v2)) { v2 = ev[n]; i2 = n; }
        const float e2 = expf(v2 - v1);
        p.TOPE[row * 2] = gsel * S::MEG + i1; p.TOPE[row * 2 + 1] = gsel * S::MEG + i2;
        p.TOPW[row * 2] = ggate / (1.0f + e2); p.TOPW[row * 2 + 1] = ggate * e2 / (1.0f + e2);
    }
}
template <class S> DEVFN void nv_moe_up(const Params& p, int l, long gt, long gs) {
    const long total = (long)S::NTOK * 2 * S::DE;
    for (long i = gt; i < total; i += gs) {
        const int j = (int)(i % S::DE); const long rk = i / S::DE; const long row = rk / 2; const int e = p.TOPE[rk];
        const float* a = p.w1 + ((long)(l * S::NE + e) * S::D) * S::DE + j; const float* b = p.w3 + ((long)(l * S::NE + e) * S::D) * S::DE + j; const bf16* h = p.H + row * S::D;
        float u = 0.f, v = 0.f; for (int k = 0; k < S::D; ++k) { const float hv = bf2f(h[k]); u += hv * a[(long)k * S::DE]; v += hv * b[(long)k * S::DE]; }
        p.HIDN[i] = f2bf(siluf_(u) * v);
    }
}
template <class S> DEVFN void nv_moe_down(const Params& p, int l, long gt, long gs) {
    const long total = (long)S::NTOK * 2 * S::D;
    for (long i = gt; i < total; i += gs) {
        const int col = (int)(i % S::D); const long rk = i / S::D; const int e = p.TOPE[rk];
        const float* w = p.w2 + ((long)(l * S::NE + e) * S::DE) * S::D + col; const bf16* hd = p.HIDN + rk * S::DE;
        float acc = 0.f; for (int j = 0; j < S::DE; ++j) acc += bf2f(hd[j]) * w[(long)j * S::D];
        p.C2[i] = f2bf(acc * p.TOPW[rk]);
    }
}

#define XB_TMO      128
#define XB_XCNT(j)  (256  + 64 * (j))
#define XB_XSUB(j)  (1280 + 64 * (j))
#define XB_XGEN(j)  (2304 + 64 * (j))
#define XB_TOP      3328
#define XB_TOPGEN   3392
#define XCD_BAR_WORDS 3456
#define XB_SPIN_CAP (1u << 18)
#define LAS __attribute__((address_space(3)))

__device__ __forceinline__ unsigned xb_ld(unsigned* p)              { return __hip_atomic_load(p, __ATOMIC_RELAXED, __HIP_MEMORY_SCOPE_AGENT); }
__device__ __forceinline__ unsigned xb_add(unsigned* p, unsigned v) { return __hip_atomic_fetch_add(p, v, __ATOMIC_RELAXED, __HIP_MEMORY_SCOPE_AGENT); }
__device__ __forceinline__ unsigned xb_xcc_id() { return (unsigned)__builtin_amdgcn_s_getreg((3 << 11) | 20) & 0xFu; }
#define XB_SPIN(cond, bar) do { unsigned _sp = 0; while (cond) { __builtin_amdgcn_s_sleep(1); \
    if ((++_sp & 255u) == 0u) { if (xb_ld(&(bar)[XB_TMO])) break; if (_sp > XB_SPIN_CAP) { atomicAdd(&(bar)[XB_TMO], 1u); break; } } } } while (0)

struct XcdBarrier {
    unsigned* bar; unsigned x;
    volatile LAS unsigned* st;
};

__device__ __forceinline__ XcdBarrier xcd_barrier_post(unsigned* bar, volatile LAS unsigned* st) {
    XcdBarrier b; b.bar = bar; b.x = xb_xcc_id(); b.st = st;
    if (threadIdx.x == 0) (void)xb_add(&bar[XB_XCNT(b.x)], 1u);
    return b;
}
__device__ __forceinline__ void xcd_barrier_complete(unsigned* bar, unsigned x, unsigned& nloc, unsigned& nx) {
    const unsigned G = gridDim.x * gridDim.y * gridDim.z;
    unsigned sum, cnt, mine, sp = 0u;
    for (;;) {
        sum = 0u; cnt = 0u; mine = 0u;
#pragma unroll
        for (unsigned j = 0; j < 16; ++j) { const unsigned c = xb_ld(&bar[XB_XCNT(j)]); sum += c; cnt += (c > 0u) ? 1u : 0u; mine = (j == x) ? c : mine; }
        if (sum == G) break;
        __builtin_amdgcn_s_sleep(1);
        if ((++sp & 255u) == 0u) { if (xb_ld(&bar[XB_TMO])) break; if (sp > XB_SPIN_CAP) { atomicAdd(&bar[XB_TMO], 1u); break; } }
    }
    nloc = mine > 0u ? mine : 1u; nx = cnt > 0u ? cnt : 1u;
}

__device__ __forceinline__ void xcd_barrier(const XcdBarrier& b) {
    asm volatile("s_waitcnt vmcnt(0)" ::: "memory");
    __syncthreads();
    if (threadIdx.x == 0) {
        unsigned* bar = b.bar;
        __builtin_amdgcn_s_waitcnt(0);
        unsigned nloc = b.st[0], nx = b.st[1];
        if (nloc == 0u) { xcd_barrier_complete(bar, b.x, nloc, nx); b.st[0] = nloc; b.st[1] = nx; }
        const unsigned old = xb_add(&bar[XB_XSUB(b.x)], 1u);
        const unsigned gen = old / nloc;
        if (old + 1u == (gen + 1u) * nloc) {
            __builtin_amdgcn_fence(__ATOMIC_RELEASE, "agent");
            asm volatile("s_waitcnt vmcnt(0)" ::: "memory");
            const unsigned og = xb_add(&bar[XB_TOP], 1u);
            const unsigned tg = og / nx;
            if (og + 1u == (tg + 1u) * nx) xb_add(&bar[XB_TOPGEN], 1u);
            else XB_SPIN(xb_ld(&bar[XB_TOPGEN]) == tg, bar);
            __builtin_amdgcn_fence(__ATOMIC_ACQUIRE, "agent");
            xb_add(&bar[XB_XGEN(b.x)], 1u);
            asm volatile("s_waitcnt vmcnt(0)" ::: "memory");
        } else {
            XB_SPIN(xb_ld(&bar[XB_XGEN(b.x)]) == gen, bar);
            __builtin_amdgcn_fence(__ATOMIC_ACQUIRE, "agent");
            asm volatile("s_waitcnt vmcnt(0)" ::: "memory");
        }
    }
    __syncthreads();
}


namespace g8 {
#define G8_LAS __attribute__((address_space(3)))
typedef short bf16x8 __attribute__((ext_vector_type(8)));
typedef float f32x4 __attribute__((ext_vector_type(4)));
typedef float f32x2 __attribute__((ext_vector_type(2)));
typedef unsigned u32x4 __attribute__((ext_vector_type(4)));
typedef unsigned u32x2 __attribute__((ext_vector_type(2)));
constexpr int BM = 256, BK = 64, HALF = 128, HTB = HALF * BK * 2  , STAGE_BYTES = 8 * HTB, NXCD = 8, WGM = 8;

__device__ __forceinline__ int lds_byte(int r, int c) { const int st = (r >> 4) * 2 + (c >> 5), rr = r & 15, cc = c & 31, ob = rr * 64 + cc * 2; return st * 1024 + (ob ^ (((ob >> 9) & 1) << 5)); }
__device__ __forceinline__ void stage_rc(int b, int& R, int& C) { const int st = b / 1024, sb = b % 1024, swz = sb ^ (((sb >> 9) & 1) << 5); R = (st >> 1) * 16 + swz / 64; C = (st & 1) * 32 + (swz % 64) / 2; }
__device__ __forceinline__ int perm32(int rho) { const int n = rho >> 4, i = rho & 15; return 8 * (i >> 2) + 4 * n + (i & 3); }
__device__ __forceinline__ unsigned cvt_pk_bf16(float lo, float hi) { unsigned r; asm volatile("v_cvt_pk_bf16_f32 %0, %1, %2" : "=v"(r) : "v"(lo), "v"(hi)); return r; }

struct Unit { int pm, pn, e, t; };

__device__ __forceinline__ void tile_of(int wgid, int nM, int nN, int& pm, int& pn) {
    const int nwg = nM * nN; { const int q = nwg / NXCD, r = nwg % NXCD, xcd = wgid % NXCD, off = wgid / NXCD; wgid = (xcd < r ? xcd * (q + 1) : r * (q + 1) + (xcd - r) * q) + off; }
    const int nig = WGM * nN, gid = wgid / nig, fm = gid * WGM, gsz = (nM - fm) < WGM ? (nM - fm) : WGM;
    pm = fm + ((wgid % nig) % gsz); pn = (wgid % nig) / gsz;
}
struct DenseSched {
    const bf16* A; const bf16* Bt; int K, lda, ldb, nM, nN, G, c;
    static constexpr bool GATHER = false;
    __device__ __forceinline__ bool next(int i, Unit& u) const { const long L = (long)i * G + c; if (L >= (long)nM * nN) return false; tile_of((int)L, nM, nN, u.pm, u.pn); u.e = 0; u.t = 0; return true; }
    __device__ __forceinline__ const char* abase(const Unit& u) const { return (const char*)(A + (size_t)u.pm * BM * lda); }
    __device__ __forceinline__ const char* bbase(const Unit& u) const { return (const char*)(Bt + (size_t)u.pn * BM * ldb); }
    __device__ __forceinline__ unsigned arow(const Unit&, int r) const { return (unsigned)r * (unsigned)lda * 2u; }
};

template <class Epi, class Sched>
__device__ __forceinline__ void gemm_run(G8_LAS unsigned char* lds, const Sched& S, const Epi& E) {
    int tid = threadIdx.x; asm volatile("" : "+v"(tid));
    const int wid = __builtin_amdgcn_readfirstlane(tid >> 6), lane = tid & 63, wr = wid >> 2, wc = wid & 3, fr = lane & 15, fq = lane >> 4;
    const int K = S.K, nt = K / BK;
    int sR[2], sC[2]; unsigned voffB[2];
#pragma unroll
    for (int i = 0; i < 2; ++i) { int R, C; stage_rc(tid * 16 + i * 8192, R, C); sR[i] = R; sC[i] = C; const int Rb = Epi::PERM ? ((R & ~31) + perm32(R & 31)) : R;
        voffB[i] = (unsigned)(Rb * S.ldb + C) * 2u; }
    const size_t kstep = (size_t)(BK * 2);
    const size_t hstepB = (size_t)HALF * S.ldb * 2;
    const unsigned ldsw = (unsigned)wid * 1024u;
    const int aoff = lds_byte(wr * 64 + fr, fq * 8), boff = lds_byte(wc * 32 + fr, fq * 8);
#define G8_SA(b, h) (((b) * 2 + (h)) * HTB)
#define G8_SB(b, h) ((4 + (b) * 2 + (h)) * HTB)
#define G8_STAGE(bufoff, gbase, voff) do { _Pragma("unroll") for (int _i = 0; _i < 2; ++_i) \
        __builtin_amdgcn_global_load_lds((const unsigned*)((const char*)(gbase) + (voff)[_i]), (G8_LAS unsigned*)(lds + (bufoff) + ldsw + _i * 8192), 16, 0, 0); } while (0)
#define G8_LDA(dst, b, h) do { _Pragma("unroll") for (int m = 0; m < 4; ++m) _Pragma("unroll") for (int k = 0; k < 2; ++k) dst[m][k] = *(const G8_LAS bf16x8*)(lds + G8_SA(b, h) + aoff + m * 2048 + k * 1024); } while (0)
#define G8_LDB(dst, b, h) do { _Pragma("unroll") for (int n = 0; n < 2; ++n) _Pragma("unroll") for (int k = 0; k < 2; ++k) dst[n][k] = *(const G8_LAS bf16x8*)(lds + G8_SB(b, h) + boff + n * 2048 + k * 1024); } while (0)
#define G8_MMA(ai, bj, At, Bt) do { __builtin_amdgcn_s_setprio(1); _Pragma("unroll") for (int m = 0; m < 4; ++m) _Pragma("unroll") for (int n = 0; n < 2; ++n) _Pragma("unroll") for (int k = 0; k < 2; ++k) \
        acc[ai][bj][m][n] = __builtin_amdgcn_mfma_f32_16x16x32_bf16(Bt[n][k], At[m][k], acc[ai][bj][m][n], 0, 0, 0); __builtin_amdgcn_s_setprio(0); } while (0)
#define G8_WAIT_V(n) asm volatile("s_waitcnt vmcnt(" #n ")" ::: "memory")
#define G8_WAIT_L(n) asm volatile("s_waitcnt lgkmcnt(" #n ")" ::: "memory")
#define G8_BAR __builtin_amdgcn_s_barrier()
#define G8_SCHED __builtin_amdgcn_sched_barrier(0)
#define G8_AOFFS(dst, u) do { _Pragma("unroll") for (int _h = 0; _h < 2; ++_h) _Pragma("unroll") for (int _i = 0; _i < 2; ++_i) dst[_h][_i] = S.arow(u, _h * HALF + sR[_i]) + (unsigned)sC[_i] * 2u; } while (0)
    Unit cur, nxt; int ui = 0;
    if (!S.next(0, cur)) return;
    f32x4 acc[2][2][4][2];
#pragma unroll
    for (int a = 0; a < 2; ++a)
#pragma unroll
        for (int b = 0; b < 2; ++b)
#pragma unroll
            for (int m = 0; m < 4; ++m)
#pragma unroll
                for (int n = 0; n < 2; ++n) acc[a][b][m][n] = (f32x4){0.f, 0.f, 0.f, 0.f};
    bf16x8 At[4][2], B0[2][2], B1[2][2];
    unsigned ao[2][2], no[2][2];
    const char* cA = S.abase(cur); const char* cB = S.bbase(cur);
    G8_AOFFS(ao, cur);
    G8_STAGE(G8_SB(0, 0), cB, voffB); G8_STAGE(G8_SB(0, 1), cB + hstepB, voffB); G8_STAGE(G8_SA(0, 0), cA, ao[0]); G8_STAGE(G8_SA(0, 1), cA, ao[1]);
    if (wr == 1) G8_BAR;
    G8_WAIT_V(2); G8_BAR;
    G8_STAGE(G8_SB(1, 0), cB + kstep, voffB); G8_STAGE(G8_SA(1, 0), cA + kstep, ao[0]); G8_STAGE(G8_SB(1, 1), cB + hstepB + kstep, voffB);
    G8_WAIT_V(6); G8_BAR;
    for (;;) {
        const bool has_next = S.next(ui + 1, nxt);
        const char* nA = has_next ? S.abase(nxt) : cA; const char* nB = has_next ? S.bbase(nxt) : cB;
        if (has_next) { G8_AOFFS(no, nxt); } else {
#pragma unroll
            for (int h = 0; h < 2; ++h)
#pragma unroll
                for (int i = 0; i < 2; ++i) no[h][i] = ao[h][i]; }
        for (int t = 0; t < nt; t += 2) {
            const bool last = (t == nt - 2);
            const char* a1 = cA + (size_t)(t + 1) * kstep;
            const char* a2 = last ? nA : cA + (size_t)(t + 2) * kstep; const char* b2 = last ? nB : cB + (size_t)(t + 2) * kstep;
            const char* a3 = a2 + kstep; const char* b3 = b2 + kstep;
            unsigned o2[2][2];
#pragma unroll
            for (int h = 0; h < 2; ++h)
#pragma unroll
                for (int i = 0; i < 2; ++i) o2[h][i] = last ? no[h][i] : ao[h][i];
            G8_LDB(B0, 0, 0); G8_LDB(B1, 0, 1); G8_SCHED; G8_LDA(At, 0, 0); G8_STAGE(G8_SA(1, 1), a1, ao[1]);
            G8_WAIT_V(8); G8_WAIT_L(0); G8_BAR; G8_MMA(0, 0, At, B0); G8_MMA(0, 1, At, B1); G8_BAR; G8_SCHED;
            G8_LDA(At, 0, 1); G8_STAGE(G8_SB(0, 0), b2, voffB); G8_STAGE(G8_SB(0, 1), b2 + hstepB, voffB); G8_STAGE(G8_SA(0, 0), a2, o2[0]);
            G8_WAIT_V(8); G8_WAIT_L(0); G8_BAR; G8_MMA(1, 0, At, B0); G8_MMA(1, 1, At, B1); G8_BAR; G8_SCHED;
            G8_LDB(B0, 1, 0); G8_LDB(B1, 1, 1); G8_SCHED; G8_LDA(At, 1, 0); G8_STAGE(G8_SA(0, 1), a2, o2[1]);
            G8_WAIT_V(8); G8_WAIT_L(0); G8_BAR; G8_MMA(0, 0, At, B0); G8_MMA(0, 1, At, B1); G8_BAR; G8_SCHED;
            G8_LDA(At, 1, 1); G8_STAGE(G8_SB(1, 0), b3, voffB); G8_STAGE(G8_SB(1, 1), b3 + hstepB, voffB); G8_STAGE(G8_SA(1, 0), a3, o2[0]);
            G8_WAIT_V(8); G8_WAIT_L(0); G8_BAR; G8_MMA(1, 0, At, B0); G8_MMA(1, 1, At, B1); G8_BAR; G8_SCHED;
        }
        if (wr == 0) G8_BAR;
        E(acc, cur, wr, wc, fr, fq);
        if (!has_next) break;
#pragma unroll
        for (int a = 0; a < 2; ++a)
#pragma unroll
            for (int b = 0; b < 2; ++b)
#pragma unroll
                for (int m = 0; m < 4; ++m)
#pragma unroll
                    for (int n = 0; n < 2; ++n) acc[a][b][m][n] = (f32x4){0.f, 0.f, 0.f, 0.f};
        cur = nxt; cA = nA; cB = nB; ++ui;
#pragma unroll
        for (int h = 0; h < 2; ++h)
#pragma unroll
            for (int i = 0; i < 2; ++i) ao[h][i] = no[h][i];
        if (wr == 1) G8_BAR;
    }
    G8_WAIT_V(0);
    G8_BAR;
#undef G8_SA
#undef G8_SB
#undef G8_STAGE
#undef G8_LDA
#undef G8_LDB
#undef G8_MMA
#undef G8_WAIT_V
#undef G8_WAIT_L
#undef G8_BAR
#undef G8_SCHED
#undef G8_AOFFS
}
}

typedef Sh<CfgFull> SF;
#define GAS __attribute__((address_space(1)))
using g8::f32x4; using g8::f32x2; using g8::u32x4; using g8::u32x2; using g8::Unit;
constexpr int NTHREADS = 512, NWAVES = 8;
__device__ __forceinline__ int fresh_tid() { int t = threadIdx.x; asm volatile("" : "+v"(t)); return t; }
__device__ __forceinline__ int fresh_bid() { int b = blockIdx.x; asm volatile("" : "+s"(b)); return b; }
__device__ __forceinline__ long fresh_gt() { return (long)fresh_bid() * NTHREADS + fresh_tid(); }
constexpr int LDS_BYTES = 136 * 1024;
constexpr int LDS_BARW = LDS_BYTES - 16;
constexpr int CW_CNT = 4096;
constexpr int HID_ROWS = 2 * SF::NTOK + SF::NE * 256;

struct FParams {
    bf16 *WIN_T, *WF_T, *WPA_T, *WPB_T, *WPC_T, *WOUT_T, *WUP_T, *WDN_T;
    bf16 *DFTM, *DFTX;
    float* MSCR;
    int* LIST; float* WL;
    bf16* HID;
};
constexpr int WIN_ROWS = SF::PCOLS + 2 * SF::QKW;

__device__ __forceinline__ unsigned pk2(float lo, float hi) { return g8::cvt_pk_bf16(lo, hi); }
__device__ __forceinline__ float fast_sigmoid(float x) { return __builtin_amdgcn_rcpf(1.0f + __expf(-x)); }
__device__ __forceinline__ float fast_silu(float x) { return x * __builtin_amdgcn_rcpf(1.0f + __expf(-x)); }
__device__ __forceinline__ float fast_logsigmoid(float x) { return fminf(x, 0.0f) - __logf(1.0f + __expf(-fabsf(x))); }

__device__ __forceinline__ void cvt_item(const float* W, int ldw, int src_col0, bool perm, bf16* WT, int ldt, int dst_row0, int k0, LAS float* scr, int lane) {
    const int j = lane & 31; const int sc = src_col0 + (perm ? ((j & 1) ? (j >> 1) + 16 : (j >> 1)) : j);
#pragma unroll 8
    for (int i = 0; i < 32; ++i) { const int kk = 2 * i + (lane >> 5); scr[kk * 33 + j] = W[(size_t)(k0 + kk) * ldw + sc]; }
    asm volatile("s_waitcnt lgkmcnt(0)" ::: "memory");
    const int c = lane & 7;
#pragma unroll
    for (int jj = 0; jj < 4; ++jj) { const int n = (lane >> 3) + 8 * jj; const LAS float* s = scr + (8 * c) * 33 + n;
        u32x4 o; o.x = pk2(s[0 * 33], s[1 * 33]); o.y = pk2(s[2 * 33], s[3 * 33]); o.z = pk2(s[4 * 33], s[5 * 33]); o.w = pk2(s[6 * 33], s[7 * 33]);
        *(GAS u32x4*)(WT + (size_t)(dst_row0 + n) * ldt + k0 + 8 * c) = o; }
    asm volatile("s_waitcnt lgkmcnt(0)" ::: "memory");
}
__device__ __forceinline__ void f_convert(const Params& p, const FParams& f, int l, LAS unsigned char* lds) {
    const int tid = fresh_tid(), lane = tid & 63, wave = tid >> 6;
    LAS float* scr = (LAS float*)(lds + wave * 16384);
    const int gw = fresh_bid() * NWAVES + wave, NGW = gridDim.x * NWAVES;
    constexpr int D = SF::D;
    constexpr int I_IN = (SF::PCOLS / 32) * (D / 64);
    constexpr int I_P = (D / 32) * (SF::VW / 64);
    constexpr int I_O = (D / 32) * (D / 64);
    constexpr int I_UP = SF::NE * 2 * (SF::DE / 32) * (D / 64);
    constexpr int I_DN = SF::NE * (D / 32) * (SF::DE / 64);
    constexpr int NITEMS = I_IN + 3 * I_P + I_O + I_UP + I_DN;
    for (int it = gw; it < NITEMS; it += NGW) {
        int r = it;
        if (r < I_IN) { const int nb = r / (D / 64), kb = r % (D / 64); const int pc = 32 * nb;
            int lc; bool perm = false;
            if (pc < SF::P_QC) { lc = pc; perm = (pc >= SF::P_KC && pc < SF::P_VC); }
            else if (pc < SF::P_G) { lc = pc - SF::P_QC + SF::L_QC; perm = true; }
            else lc = pc - SF::P_G + SF::L_G;
            cvt_item(p.w_in + (size_t)l * D * SF::INCOLS, SF::INCOLS, lc, perm, f.WIN_T, D, pc, 64 * kb, scr, lane); continue; }
        r -= I_IN;
        if (r < 3 * I_P) { const int which = r / I_P; r %= I_P; const int nb = r / (SF::VW / 64), kb = r % (SF::VW / 64);
            const float* src = p.w_pa; if (which == 1) src = p.w_pb; if (which == 2) src = p.w_pc; src += (size_t)l * SF::VW * D; bf16* dst = f.WPA_T + (size_t)which * D * SF::VW;
            cvt_item(src, D, 32 * nb, false, dst, SF::VW, 32 * nb, 64 * kb, scr, lane); continue; }
        r -= 3 * I_P;
        if (r < I_O) { const int nb = r / (D / 64), kb = r % (D / 64);
            cvt_item(p.w_out + (size_t)l * D * D, D, 32 * nb, false, f.WOUT_T, D, 32 * nb, 64 * kb, scr, lane); continue; }
        r -= I_O;
        if (r < I_UP) { const int kb = r % (D / 64); r /= (D / 64); const int nb = r % (SF::DE / 32); r /= (SF::DE / 32); const int half = r % 2, e = r / 2;
            const float* src = p.w1; if (half == 1) src = p.w3; src += ((size_t)(l * SF::NE + e) * D) * SF::DE; const int n0 = 32 * nb;
            cvt_item(src, SF::DE, n0, false, f.WUP_T + (size_t)e * 2 * SF::DE * D, D, (n0 / 128) * 256 + half * 128 + (n0 % 128), 64 * kb, scr, lane); continue; }
        r -= I_UP;
        { const int kb = r % (SF::DE / 64); r /= (SF::DE / 64); const int nb = r % (D / 32), e = r / (D / 32);
            cvt_item(p.w2 + ((size_t)(l * SF::NE + e) * SF::DE) * D, D, 32 * nb, false, f.WDN_T + (size_t)e * D * SF::DE, SF::DE, 32 * nb, 64 * kb, scr, lane); }
    }
    const long gt = (long)fresh_bid() * NTHREADS + tid, gs = (long)gridDim.x * NTHREADS;
    for (long i = gt; i < (long)2 * SF::QKW * D; i += gs) { const int k = (int)(i % D), n = (int)((i / D) % SF::QKW), dir = (int)(i / ((long)D * SF::QKW));
        const float* a = p.w_dd + ((size_t)(l * 2 + dir) * D + k) * SF::RANK; const float* b = p.w_du + ((size_t)(l * 2 + dir) * SF::RANK) * SF::QKW + n;
        float acc = 0.f;
#pragma unroll
        for (int r = 0; r < SF::RANK; ++r) acc += a[r] * b[(size_t)r * SF::QKW];
        f.WIN_T[(size_t)(SF::PCOLS + dir * SF::QKW + n) * D + k] = f2bf(acc); }
    const float sc = 1.0f / sqrtf((float)SF::FGW);
    for (long i = gt; i < (long)SF::FG * 2 * SF::FGW * D; i += gs) { const int k = (int)(i % D); const int row = (int)(i / D); const int cp = row % SF::FGW, pq = (row / SF::FGW) % 2, g = row / (2 * SF::FGW);
        const float* w = p.w_in + (size_t)l * D * SF::INCOLS + (size_t)k * SF::INCOLS + SF::L_UB + g * SF::FGW; float acc = 0.f;
        for (int c = 0; c < SF::FGW; ++c) acc += w[c] * p.TABC[2 * ((c * cp) % SF::FGW) + pq];
        f.WF_T[i] = f2bf(acc * sc); }
}
__device__ __forceinline__ void f_dftm(const Params& p, const FParams& f) {
    const long gt = fresh_gt(), gs = (long)gridDim.x * NTHREADS;
    { const float sc = 1.0f / sqrtf((float)SF::SEQ);
      for (long i = gt; i < (long)SF::SEQ * 2 * SF::SEQ / 8; i += gs) { const long e0 = i * 8; const int lp = (int)(e0 / (2 * SF::SEQ)), c0 = (int)(e0 % (2 * SF::SEQ)); const int pq = c0 / SF::SEQ, l0 = c0 % SF::SEQ;
        float v[8];
#pragma unroll
        for (int j = 0; j < 8; ++j) { const int m = (int)(((long)(l0 + j) * lp) % SF::SEQ); v[j] = (pq ? -p.TABL[2 * m + 1] : p.TABL[2 * m]) * sc; }
        u32x4 o; o.x = pk2(v[0], v[1]); o.y = pk2(v[2], v[3]); o.z = pk2(v[4], v[5]); o.w = pk2(v[6], v[7]);
        *(GAS u32x4*)(f.DFTM + e0) = o; } }
    { const float sc = 1.0f / sqrtf((float)SF::CTX);
      for (long i = gt; i < (long)SF::CTX * 2 * SF::CTX / 8; i += gs) { const long e0 = i * 8; const int lp = (int)(e0 / (2 * SF::CTX)), c0 = (int)(e0 % (2 * SF::CTX)); const int pq = c0 / SF::CTX, l0 = c0 % SF::CTX;
        float v[8];
#pragma unroll
        for (int j = 0; j < 8; ++j) { const int m = ((l0 + j) * lp) % SF::CTX; v[j] = (pq ? -p.TABX[2 * m + 1] : p.TABX[2 * m]) * sc; }
        u32x4 o; o.x = pk2(v[0], v[1]); o.y = pk2(v[2], v[3]); o.z = pk2(v[4], v[5]); o.w = pk2(v[6], v[7]);
        *(GAS u32x4*)(f.DFTX + e0) = o; } }
}

struct EpiInproj {
    static constexpr bool PERM = true;
    bf16* PROJ; float* LA; const float* bdec; const float* ROPE;
    __device__ __forceinline__ void operator()(const f32x4 (&acc)[2][2][4][2], const Unit& u, int wr, int wc, int fr, int fq) const {
        const int tile = u.pn; const int row0 = u.pm * 256 + wr * 64 + fr; const int cw = wc * 32 + 8 * fq;
        constexpr int T_DEC = SF::PCOLS / 256;
        if (tile >= T_DEC) {
#pragma unroll
            for (int bj = 0; bj < 2; ++bj) { const int col = (tile - T_DEC) * 256 + bj * 128 + cw;
                const f32x4 b0 = *(const f32x4*)(bdec + col), b1 = *(const f32x4*)(bdec + col + 4);
#pragma unroll
                for (int ai = 0; ai < 2; ++ai)
#pragma unroll
                    for (int m = 0; m < 4; ++m) { const int row = row0 + ai * 128 + m * 16; f32x4 v0 = acc[ai][bj][m][0] + b0, v1 = acc[ai][bj][m][1] + b1;
#pragma unroll
                        for (int j = 0; j < 4; ++j) { v0[j] = fast_logsigmoid(v0[j]) * 0.0625f; v1[j] = fast_logsigmoid(v1[j]) * 0.0625f; }
                        float* d = LA + (size_t)row * (2 * SF::QKW) + col; *(f32x4*)d = v0; *(f32x4*)(d + 4) = v1; } }
            return;
        }
        const bool latent = u.pm < SF::NLAT / 256;
#pragma unroll
        for (int bj = 0; bj < 2; ++bj) {
            const int colt = tile * 256 + bj * 128;
            int mode = 0;
            if (colt >= SF::P_KC && colt < SF::P_VC) mode = latent ? 1 : 0;
            else if (colt >= SF::P_QA && colt < SF::P_RA) mode = 2;
            else if (colt >= SF::P_QC && colt < SF::P_G) mode = latent ? 1 : 0;
            else if (colt >= SF::P_G) mode = 3;
#pragma unroll
            for (int ai = 0; ai < 2; ++ai)
#pragma unroll
                for (int m = 0; m < 4; ++m) { const int row = row0 + ai * 128 + m * 16; f32x4 v0 = acc[ai][bj][m][0], v1 = acc[ai][bj][m][1];
                    if (mode == 1) { const int s = row & (SF::SEQ - 1); const int pos = (wc & 1) ? (s & (SF::GW - 1)) : (s / SF::GW);
                        const float* rp = ROPE + (size_t)(pos * SF::NFREQ + 4 * fq) * 2; const f32x4 r0 = *(const f32x4*)rp, r1 = *(const f32x4*)(rp + 4);
                        v0 = (f32x4){v0[0] * r0[0] - v0[1] * r0[1], v0[0] * r0[1] + v0[1] * r0[0], v0[2] * r0[2] - v0[3] * r0[3], v0[2] * r0[3] + v0[3] * r0[2]};
                        v1 = (f32x4){v1[0] * r1[0] - v1[1] * r1[1], v1[0] * r1[1] + v1[1] * r1[0], v1[2] * r1[2] - v1[3] * r1[3], v1[2] * r1[3] + v1[3] * r1[2]}; }
                    else if (mode == 2) { v0 = v0 * 0.125f; v1 = v1 * 0.125f; }
                    else if (mode == 3) {
#pragma unroll
                        for (int j = 0; j < 4; ++j) { v0[j] = fast_sigmoid(v0[j]); v1[j] = fast_sigmoid(v1[j]); } }
                    u32x4 w; w.x = pk2(v0[0], v0[1]); w.y = pk2(v0[2], v0[3]); w.z = pk2(v1[0], v1[1]); w.w = pk2(v1[2], v1[3]);
                    *(u32x4*)(PROJ + (size_t)row * SF::PCOLS + colt + cw) = w; }
        }
    }
};
struct EpiFourT {
    static constexpr bool PERM = true;
    bf16* PQT; bf16* PQTC;
    __device__ __forceinline__ void operator()(const f32x4 (&acc)[2][2][4][2], const Unit& u, int wr, int wc, int fr, int fq) const {
        const int g = u.pm; const bool latent = u.pn < SF::NLAT / 256; const int b = latent ? u.pn / (SF::SEQ / 256) : u.pn - SF::NLAT / 256;
        const int L = latent ? SF::SEQ : SF::CTX; bf16* base = latent ? PQT : PQTC; const int t0 = latent ? (u.pn % (SF::SEQ / 256)) * 256 : 0;
#pragma unroll
        for (int ai = 0; ai < 2; ++ai)
#pragma unroll
            for (int m = 0; m < 4; ++m) { const int cp = wr * 64 + m * 16 + fr;
                bf16* rowp = base + ((size_t)((b * SF::FG + g) * SF::FGW + cp) * 2 + ai) * L + t0 + wc * 32 + 8 * fq;
#pragma unroll
                for (int bj = 0; bj < 2; ++bj) { const f32x4 v0 = acc[ai][bj][m][0], v1 = acc[ai][bj][m][1];
                    u32x4 w; w.x = pk2(v0[0], v0[1]); w.y = pk2(v0[2], v0[3]); w.z = pk2(v1[0], v1[1]); w.w = pk2(v1[2], v1[3]);
                    *(u32x4*)(rowp + bj * 128) = w; } }
    }
};
struct EpiSeqDft {
    static constexpr bool PERM = true;
    bf16* Y; int row_base; int L;
    __device__ __forceinline__ void operator()(const f32x4 (&acc)[2][2][4][2], const Unit& u, int wr, int wc, int fr, int fq) const {
#pragma unroll
        for (int bj = 0; bj < 2; ++bj) { const int bg = 2 * u.pn + bj, b = bg / SF::FG, g = bg % SF::FG;
#pragma unroll
            for (int ai = 0; ai < 2; ++ai)
#pragma unroll
                for (int m = 0; m < 4; ++m) { const int lp = u.pm * 256 + ai * 128 + wr * 64 + m * 16 + fr; const f32x4 v0 = acc[ai][bj][m][0], v1 = acc[ai][bj][m][1];
                    u32x4 w; w.x = pk2(v0[0], v0[1]); w.y = pk2(v0[2], v0[3]); w.z = pk2(v1[0], v1[1]); w.w = pk2(v1[2], v1[3]);
                    *(u32x4*)(Y + (size_t)(row_base + b * L + lp) * SF::YCOLS + SF::Y_B + g * SF::FGW + wc * 32 + 8 * fq) = w; } }
    }
};
struct MergeSched {
    const bf16* Y; const bf16* WP; int K, lda, ldb, nM, nN, G, c;
    static constexpr bool GATHER = false;
    __device__ __forceinline__ bool next(int i, Unit& u) const { const int ti = i / 3; const long L = (long)ti * G + c; if (L >= (long)nM * nN) return false; g8::tile_of((int)L, nM, nN, u.pm, u.pn); u.e = i % 3; u.t = 0; return true; }
    __device__ __forceinline__ const char* abase(const Unit& u) const { return (const char*)(Y + (size_t)u.pm * 256 * lda + u.e * SF::VW); }
    __device__ __forceinline__ const char* bbase(const Unit& u) const { return (const char*)(WP + (size_t)u.e * SF::D * SF::VW + (size_t)u.pn * 256 * ldb); }
    __device__ __forceinline__ unsigned arow(const Unit&, int r) const { return (unsigned)r * (unsigned)lda * 2u; }
};
struct EpiMerge {
    static constexpr bool PERM = true;
    const bf16* PROJ; bf16* MERGED; float* scr;
    __device__ __forceinline__ void operator()(const f32x4 (&acc)[2][2][4][2], const Unit& u, int wr, int wc, int fr, int fq) const {
        const int br = u.e; const int row0 = u.pm * 256 + wr * 64 + fr; const int col0 = u.pn * 256 + wc * 32 + 8 * fq;
        f32x4* sp = (f32x4*)scr + fresh_tid();
        if (br != 0) asm volatile("s_waitcnt vmcnt(0)" ::: "memory");
#pragma unroll
        for (int ai = 0; ai < 2; ++ai)
#pragma unroll
            for (int m = 0; m < 4; ++m) { const int row = row0 + ai * 128 + m * 16;
#pragma unroll
                for (int bj = 0; bj < 2; ++bj) { const int col = col0 + bj * 128;
                    const u32x4 gw = *(const u32x4*)(PROJ + (size_t)row * SF::PCOLS + SF::P_G + br * SF::D + col);
                    f32x4 g0, g1; g0[0] = __uint_as_float(gw.x << 16); g0[1] = __uint_as_float(gw.x & 0xffff0000u); g0[2] = __uint_as_float(gw.y << 16); g0[3] = __uint_as_float(gw.y & 0xffff0000u);
                    g1[0] = __uint_as_float(gw.z << 16); g1[1] = __uint_as_float(gw.z & 0xffff0000u); g1[2] = __uint_as_float(gw.w << 16); g1[3] = __uint_as_float(gw.w & 0xffff0000u);
                    f32x4 v0 = acc[ai][bj][m][0] * g0, v1 = acc[ai][bj][m][1] * g1;
                    f32x4* s0 = sp + (size_t)(((ai * 4 + m) * 2 + bj) * 2) * NTHREADS; f32x4* s1 = s0 + NTHREADS;
                    if (br != 0) { v0 = v0 + *s0; v1 = v1 + *s1; }
                    if (br != 2) { *s0 = v0; *s1 = v1; }
                    else { u32x4 w; w.x = pk2(v0[0], v0[1]); w.y = pk2(v0[2], v0[3]); w.z = pk2(v1[0], v1[1]); w.w = pk2(v1[2], v1[3]);
                        *(u32x4*)(MERGED + (size_t)row * SF::D + col) = w; }
                    asm volatile("" ::: "memory"); } }
    }
};
struct EpiOut {
    static constexpr bool PERM = false;
    float* X; const float* mods_l;
    __device__ __forceinline__ void operator()(const f32x4 (&acc)[2][2][4][2], const Unit& u, int wr, int wc, int fr, int fq) const {
        const int mr = u.pm < SF::NLAT / 256 ? u.pm / (SF::SEQ / 256) : SF::B; const float* g1 = mods_l + (size_t)mr * SF::NMOD + 2 * SF::D;
        const int row0 = u.pm * 256 + wr * 64 + fr, col0 = u.pn * 256 + wc * 32 + 4 * fq;
        f32x4 gv[2][2];
#pragma unroll
        for (int bj = 0; bj < 2; ++bj)
#pragma unroll
            for (int n = 0; n < 2; ++n) gv[bj][n] = *(const f32x4*)(g1 + col0 + bj * 128 + n * 16);
#pragma unroll
        for (int ai = 0; ai < 2; ++ai)
#pragma unroll
            for (int m = 0; m < 4; ++m) { float* rowp = X + (size_t)(row0 + ai * 128 + m * 16) * SF::D + col0;
#pragma unroll
                for (int bj = 0; bj < 2; ++bj)
#pragma unroll
                    for (int n = 0; n < 2; ++n) { f32x4* d = (f32x4*)(rowp + bj * 128 + n * 16); *d = *d + gv[bj][n] * acc[ai][bj][m][n]; } }
    }
};
struct MoeSched {
    const bf16* A; const bf16* Bt; const int* cnt; const int* list; int K, lda, ldb, G, c; bool up;
    static constexpr bool GATHER = true;
    __device__ __forceinline__ bool next(int i, Unit& u) const {
        const long L = (long)i * G + c; const int q = (int)(L >> 2); u.pn = (int)(L & 3); int tb = 0; bool found = false; u.e = 0; u.t = 0; u.pm = 0;
        for (int e = 0; e < SF::NE; ++e) { const int ntl = (cnt[e] + 255) >> 8; if (!found && q < tb + ntl) { u.e = e; u.t = q - tb; u.pm = q; found = true; } tb += ntl; }
        return found;
    }
    __device__ __forceinline__ const char* abase(const Unit& u) const { return up ? (const char*)A : (const char*)(A + (size_t)u.pm * 256 * lda); }
    __device__ __forceinline__ const char* bbase(const Unit& u) const { return (const char*)(Bt + ((size_t)u.e * 1024 + (size_t)u.pn * 256) * ldb); }
    __device__ __forceinline__ unsigned arow(const Unit& u, int r) const {
        if (!up) return (unsigned)r * (unsigned)lda * 2u;
        const int slot = u.t * 256 + r; const int tok = slot < cnt[u.e] ? (list[(size_t)u.e * SF::NTOK + slot] >> 1) : 0; return (unsigned)tok * (unsigned)lda * 2u; }
};
struct EpiMoeUp {
    static constexpr bool PERM = true;
    bf16* HID;
    __device__ __forceinline__ void operator()(const f32x4 (&acc)[2][2][4][2], const Unit& u, int wr, int wc, int fr, int fq) const {
        const int row0 = u.pm * 256 + wr * 64 + fr, col0 = u.pn * 128 + wc * 32 + 8 * fq;
#pragma unroll
        for (int ai = 0; ai < 2; ++ai)
#pragma unroll
            for (int m = 0; m < 4; ++m) { f32x4 a0 = acc[ai][0][m][0], a1 = acc[ai][0][m][1]; const f32x4 b0 = acc[ai][1][m][0], b1 = acc[ai][1][m][1];
#pragma unroll
                for (int j = 0; j < 4; ++j) { a0[j] = fast_silu(a0[j]) * b0[j]; a1[j] = fast_silu(a1[j]) * b1[j]; }
                u32x4 w; w.x = pk2(a0[0], a0[1]); w.y = pk2(a0[2], a0[3]); w.z = pk2(a1[0], a1[1]); w.w = pk2(a1[2], a1[3]);
                *(u32x4*)(HID + (size_t)(row0 + ai * 128 + m * 16) * SF::DE + col0) = w; }
    }
};
struct EpiMoeDown {
    static constexpr bool PERM = true;
    bf16* C2; const int* cnt; const int* list; const float* wl;
    __device__ __forceinline__ void operator()(const f32x4 (&acc)[2][2][4][2], const Unit& u, int wr, int wc, int fr, int fq) const {
        const int n_e = cnt[u.e]; const int col0 = u.pn * 256 + wc * 32 + 8 * fq;
#pragma unroll
        for (int ai = 0; ai < 2; ++ai)
#pragma unroll
            for (int m = 0; m < 4; ++m) { const int slot = u.t * 256 + ai * 128 + wr * 64 + m * 16 + fr;
                if (slot < n_e) { const int tk = list[(size_t)u.e * SF::NTOK + slot]; const float w8 = wl[(size_t)u.e * SF::NTOK + slot];
#pragma unroll
                    for (int bj = 0; bj < 2; ++bj) { const f32x4 v0 = acc[ai][bj][m][0] * w8, v1 = acc[ai][bj][m][1] * w8;
                        u32x4 w; w.x = pk2(v0[0], v0[1]); w.y = pk2(v0[2], v0[3]); w.z = pk2(v1[0], v1[1]); w.w = pk2(v1[2], v1[3]);
                        *(u32x4*)(C2 + (size_t)tk * SF::D + col0 + bj * 128) = w; } } }
    }
};

__device__ __forceinline__ void f_inproj(const Params& p, const FParams& f, int l, LAS unsigned char* lds) {
    { g8::DenseSched S{p.H, f.WIN_T, SF::D, SF::D, SF::D, SF::NTOK / 256, WIN_ROWS / 256, (int)gridDim.x, fresh_bid()};
      EpiInproj E{p.PROJ, p.LA, p.b_dec + (size_t)l * 2 * SF::QKW, p.ROPE};
      g8::gemm_run(lds, S, E); }
    { g8::DenseSched S{f.WF_T, p.H, SF::D, SF::D, SF::D, (SF::FG * 2 * SF::FGW) / 256, SF::NTOK / 256, (int)gridDim.x, fresh_bid()};
      EpiFourT E{p.PQT, p.PQTC};
      g8::gemm_run(lds, S, E); }
}
__device__ __forceinline__ void f_seqdft(const Params& p, const FParams& f, LAS unsigned char* lds) {
    constexpr int NBGC = SF::B * SF::FG * SF::FGW;
    { g8::DenseSched S{f.DFTM, p.PQT, 2 * SF::SEQ, 2 * SF::SEQ, 2 * SF::SEQ, SF::SEQ / 256, NBGC / 256, (int)gridDim.x, fresh_bid()};
      EpiSeqDft E{p.Y, 0, SF::SEQ};
      g8::gemm_run(lds, S, E); }
    { g8::DenseSched S{f.DFTX, p.PQTC, 2 * SF::CTX, 2 * SF::CTX, 2 * SF::CTX, SF::CTX / 256, NBGC / 256, (int)gridDim.x, fresh_bid()};
      EpiSeqDft E{p.Y, SF::NLAT, SF::CTX};
      g8::gemm_run(lds, S, E); }
}
__device__ __forceinline__ void f_merge(const Params& p, const FParams& f, LAS unsigned char* lds) {
    MergeSched S{p.Y, f.WPA_T, SF::VW, SF::YCOLS, SF::VW, SF::NTOK / 256, SF::D / 256, (int)gridDim.x, fresh_bid()};
    EpiMerge E{p.PROJ, p.MERGED, f.MSCR + (size_t)fresh_bid() * 32 * NTHREADS * 4};
    g8::gemm_run(lds, S, E);
}
__device__ __forceinline__ void f_out(const Params& p, const FParams& f, int l, LAS unsigned char* lds) {
    g8::DenseSched S{p.MERGED, f.WOUT_T, SF::D, SF::D, SF::D, SF::NTOK / 256, SF::D / 256, (int)gridDim.x, fresh_bid()};
    EpiOut E{p.X, p.MODS + (size_t)l * (SF::B + 1) * SF::NMOD};
    g8::gemm_run(lds, S, E);
}
__device__ __forceinline__ void f_norm2(const Params& p, const FParams& f, int l) {
    const long gt = fresh_gt(), gs = (long)gridDim.x * NTHREADS;
    nv_norm2<SF>(p, l, gt, gs);
    int* cnt = (int*)p.ctl + CW_CNT + 64 * l;
    for (long row = gt; row < SF::NTOK; row += gs) {
#pragma unroll
        for (int k = 0; k < 2; ++k) { const int e = p.TOPE[row * 2 + k]; const int slot = atomicAdd(cnt + e, 1);
            f.LIST[(size_t)e * SF::NTOK + slot] = (int)row * 2 + k; f.WL[(size_t)e * SF::NTOK + slot] = p.TOPW[row * 2 + k]; }
    }
}
__device__ __forceinline__ void f_moe_up(const Params& p, const FParams& f, int l, LAS unsigned char* lds) {
    MoeSched S{p.H, f.WUP_T, (const int*)p.ctl + CW_CNT + 64 * l, f.LIST, SF::D, SF::D, SF::D, (int)gridDim.x, fresh_bid(), true};
    EpiMoeUp E{f.HID};
    g8::gemm_run(lds, S, E);
}
__device__ __forceinline__ void f_moe_down(const Params& p, const FParams& f, int l, LAS unsigned char* lds) {
    MoeSched S{f.HID, f.WDN_T, (const int*)p.ctl + CW_CNT + 64 * l, f.LIST, SF::DE, SF::DE, SF::DE, (int)gridDim.x, fresh_bid(), false};
    EpiMoeDown E{p.C2, (const int*)p.ctl + CW_CNT + 64 * l, f.LIST, f.WL};
    g8::gemm_run(lds, S, E);
}

typedef float f32x16 __attribute__((ext_vector_type(16)));
typedef __bf16 bf16x2_t __attribute__((ext_vector_type(2)));
using g8::bf16x8;
__device__ __forceinline__ unsigned pkc(float a, float b) { f32x2 v = {a, b}; return __builtin_bit_cast(unsigned, __builtin_convertvector(v, bf16x2_t)); }
__device__ __forceinline__ float bflo(unsigned w) { return __uint_as_float(w << 16); }
__device__ __forceinline__ float bfhi(unsigned w) { return __uint_as_float(w & 0xffff0000u); }
__device__ __forceinline__ bf16x8 lfrag(const LAS bf16* base, int pitch, int row0, int k0, int lane) { return *(const LAS bf16x8*)(base + (row0 + (lane & 15)) * pitch + k0 + 8 * (lane >> 4)); }
#define MFMA16(a, b, c) __builtin_amdgcn_mfma_f32_16x16x32_bf16((a), (b), (c), 0, 0, 0)
#define MFMA32(a, b, c) __builtin_amdgcn_mfma_f32_32x32x16_bf16((a), (b), (c), 0, 0, 0)

constexpr int GLA_NBLK = (SF::CTX + SF::SEQ) / 64;
constexpr int GLA_CB = SF::CTX / 64;
constexpr int GLA_TASKS = SF::B * SF::GH * GLA_NBLK;
constexpr int GP_K = 72, GP_C = 136;
constexpr int GL_CUM = 0, GL_TOT = 32768, GL_QC = 36864, GL_KF = 54272, GL_KB = 63488, GL_VT = 72704, GL_ST = 91136, GL_P = 125952, GL_END = 135168;
static_assert(GL_END <= LDS_BARW, "GLA LDS map");
struct GlaBufs { float* SLOC; float* DTOT; bf16* SIN; };

__device__ __forceinline__ int gla_row0(int b, int blk) { return blk < GLA_CB ? SF::NLAT + b * SF::CTX + 64 * blk : b * SF::SEQ + 64 * (blk - GLA_CB); }
__device__ __forceinline__ void gla_cum(const Params& p, LAS unsigned char* lds, int row0, int h, int tid) {
    LAS float* CUM = (LAS float*)(lds + GL_CUM); LAS float* TOT = (LAS float*)(lds + GL_TOT);
    const int kk = tid & 63, seg = tid >> 6;
    float c[8], d[8];
    const float* la = p.LA + (size_t)(row0 + 8 * seg) * (2 * SF::QKW) + h * SF::DK + kk;
#pragma unroll
    for (int j = 0; j < 8; ++j) { c[j] = la[(size_t)j * (2 * SF::QKW)]; d[j] = la[(size_t)j * (2 * SF::QKW) + SF::QKW]; }
#pragma unroll
    for (int j = 1; j < 8; ++j) c[j] += c[j - 1];
#pragma unroll
    for (int j = 6; j >= 0; --j) d[j] += d[j + 1];
    TOT[seg * 64 + kk] = c[7]; TOT[512 + seg * 64 + kk] = d[0];
    __syncthreads();
    float of = 0.f, ob = 0.f;
#pragma unroll
    for (int s = 0; s < 8; ++s) { const float a = TOT[s * 64 + kk], b = TOT[512 + s * 64 + kk]; of += (s < seg) ? a : 0.f; ob += (s > seg) ? b : 0.f; }
#pragma unroll
    for (int j = 0; j < 8; ++j) { CUM[(8 * seg + j) * 64 + kk] = c[j] + of; CUM[4096 + (8 * seg + j) * 64 + kk] = d[j] + ob; }
    __syncthreads();
}
__device__ __forceinline__ void gla_vt(const Params& p, LAS unsigned char* lds, int row0, int h, int tid) {
    LAS bf16* VT = (LAS bf16*)(lds + GL_VT);
#pragma unroll
    for (int it = 0; it < 2; ++it) { const int i = tid + it * NTHREADS, s = i >> 4, ch = i & 15;
        const u32x4 v = *(const u32x4*)(p.PROJ + (size_t)(row0 + s) * SF::PCOLS + SF::P_VA + h * SF::DV + 8 * ch);
        LAS bf16* d = VT + (8 * ch) * GP_K + s;
        d[0 * GP_K] = (bf16)(v.x & 0xffffu); d[1 * GP_K] = (bf16)(v.x >> 16); d[2 * GP_K] = (bf16)(v.y & 0xffffu); d[3 * GP_K] = (bf16)(v.y >> 16);
        d[4 * GP_K] = (bf16)(v.z & 0xffffu); d[5 * GP_K] = (bf16)(v.z >> 16); d[6 * GP_K] = (bf16)(v.w & 0xffffu); d[7 * GP_K] = (bf16)(v.w >> 16); }
}
__device__ __forceinline__ void f_gla_local(const Params& p, const GlaBufs& gb, LAS unsigned char* lds) {
    const int tid = fresh_tid(), lane = tid & 63, wave = tid >> 6;
    LAS float* CUM = (LAS float*)(lds + GL_CUM); LAS bf16* KDF = (LAS bf16*)(lds + GL_KF); LAS bf16* KDB = (LAS bf16*)(lds + GL_KB); LAS bf16* VT = (LAS bf16*)(lds + GL_VT);
    for (int task = fresh_bid(); task < GLA_TASKS; task += gridDim.x) {
        const int blk = task % GLA_NBLK, bh = task / GLA_NBLK, h = bh % SF::GH, b = bh / SF::GH; const int row0 = gla_row0(b, blk);
        gla_cum(p, lds, row0, h, tid);
        { const int t = tid >> 3, kk0 = 8 * (tid & 7);
          const u32x4 kv = *(const u32x4*)(p.PROJ + (size_t)(row0 + t) * SF::PCOLS + SF::P_KA + h * SF::DK + kk0);
          const unsigned kw[4] = {kv.x, kv.y, kv.z, kv.w};
#pragma unroll
          for (int j = 0; j < 8; ++j) { const float kf = (j & 1) ? bfhi(kw[j >> 1]) : bflo(kw[j >> 1]); const int kk = kk0 + j;
              const float ef = __expf(CUM[63 * 64 + kk] - CUM[t * 64 + kk]), eb = __expf(CUM[4096 + kk] - CUM[4096 + t * 64 + kk]);
              KDF[kk * GP_K + t] = f2bf(kf * ef); KDB[kk * GP_K + t] = f2bf(kf * eb); }
          if (tid < 128) { const int dir = tid >> 6, kk = tid & 63; gb.DTOT[((size_t)(bh * 2 + dir) * GLA_NBLK + blk) * 64 + kk] = __expf(dir ? CUM[4096 + kk] : CUM[63 * 64 + kk]); } }
        gla_vt(p, lds, row0, h, tid);
        __syncthreads();
        { bf16x8 a[2];
#pragma unroll
          for (int ks = 0; ks < 2; ++ks) a[ks] = lfrag(VT, GP_K, 16 * wave, 32 * ks, lane);
#pragma unroll
          for (int dir = 0; dir < 2; ++dir) { const LAS bf16* KD = dir ? KDB : KDF; float* out = gb.SLOC + ((size_t)(bh * 2 + dir) * GLA_NBLK + blk) * (SF::DV * SF::DK);
#pragma unroll
              for (int j = 0; j < 4; ++j) { f32x4 acc = {0.f, 0.f, 0.f, 0.f};
#pragma unroll
                  for (int ks = 0; ks < 2; ++ks) acc = MFMA16(a[ks], lfrag(KD, GP_K, 16 * j, 32 * ks, lane), acc);
#pragma unroll
                  for (int r = 0; r < 4; ++r) out[(16 * wave + 4 * (lane >> 4) + r) * SF::DK + 16 * j + (lane & 15)] = acc[r]; } } }
        __syncthreads();
    }
}
__device__ __forceinline__ void f_gla_scan(const GlaBufs& gb) {
    const long gs = (long)gridDim.x * NTHREADS;
    for (long e = fresh_gt(); e < (long)SF::B * SF::GH * 2 * SF::DV * SF::DK; e += gs) {
        const int kk = (int)(e & 63), vv = (int)((e >> 6) & 127), dir = (int)((e >> 13) & 1), bh = (int)(e >> 14);
        const float* dt = gb.DTOT + ((size_t)(bh * 2 + dir) * GLA_NBLK) * 64 + kk; const float* sl = gb.SLOC + ((size_t)(bh * 2 + dir) * GLA_NBLK) * (SF::DV * SF::DK) + vv * SF::DK + kk;
        bf16* so = gb.SIN + ((size_t)bh * GLA_NBLK) * (SF::DV * 128) + vv * 128 + dir * 64 + kk;
        float S = 0.f;
        for (int g = 0; g < GLA_NBLK / 4; ++g) {
            float dv[4], sv[4]; int bk[4];
#pragma unroll
            for (int u = 0; u < 4; ++u) { const int step = 4 * g + u; bk[u] = dir == 0 ? step : (step < GLA_CB ? GLA_CB - 1 - step : GLA_NBLK + GLA_CB - 1 - step);
                dv[u] = dt[(size_t)bk[u] * 64]; sv[u] = sl[(size_t)bk[u] * (SF::DV * SF::DK)]; }
#pragma unroll
            for (int u = 0; u < 4; ++u) { so[(size_t)bk[u] * (SF::DV * 128)] = f2bf(S); S = dv[u] * S + sv[u]; }
        }
    }
}
__device__ __forceinline__ void f_gla_out(const Params& p, const GlaBufs& gb, int l, LAS unsigned char* lds) {
    const int tid = fresh_tid(), lane = tid & 63, wave = tid >> 6;
    LAS float* CUM = (LAS float*)(lds + GL_CUM); LAS bf16* QC = (LAS bf16*)(lds + GL_QC); LAS bf16* KF = (LAS bf16*)(lds + GL_KF); LAS bf16* KB = (LAS bf16*)(lds + GL_KB);
    LAS bf16* VT = (LAS bf16*)(lds + GL_VT); LAS bf16* ST = (LAS bf16*)(lds + GL_ST); LAS bf16* P = (LAS bf16*)(lds + GL_P); LAS float* O = (LAS float*)(lds + GL_CUM);
    for (int task = fresh_bid(); task < GLA_TASKS; task += gridDim.x) {
        const int blk = task % GLA_NBLK, bh = task / GLA_NBLK, h = bh % SF::GH, b = bh / SF::GH; const int row0 = gla_row0(b, blk);
        gla_cum(p, lds, row0, h, tid);
        { const int t = tid >> 3, kk0 = 8 * (tid & 7); const bf16* pr = p.PROJ + (size_t)(row0 + t) * SF::PCOLS;
          const u32x4 qv = *(const u32x4*)(pr + SF::P_QA + h * SF::DK + kk0), kv = *(const u32x4*)(pr + SF::P_KA + h * SF::DK + kk0);
          const unsigned qw[4] = {qv.x, qv.y, qv.z, qv.w}, kw[4] = {kv.x, kv.y, kv.z, kv.w};
          float qf[8], qb[8], kf[8], kb[8];
#pragma unroll
          for (int j = 0; j < 8; ++j) { const float q = (j & 1) ? bfhi(qw[j >> 1]) : bflo(qw[j >> 1]), k = (j & 1) ? bfhi(kw[j >> 1]) : bflo(kw[j >> 1]);
              const float cf = CUM[t * 64 + kk0 + j], cb = CUM[4096 + t * 64 + kk0 + j];
              qf[j] = q * __expf(cf); qb[j] = q * __expf(cb); kf[j] = k * __expf(-cf); kb[j] = k * __expf(-cb); }
          u32x4 w; w.x = pkc(qf[0], qf[1]); w.y = pkc(qf[2], qf[3]); w.z = pkc(qf[4], qf[5]); w.w = pkc(qf[6], qf[7]); *(LAS u32x4*)(QC + t * GP_C + kk0) = w;
          w.x = pkc(qb[0], qb[1]); w.y = pkc(qb[2], qb[3]); w.z = pkc(qb[4], qb[5]); w.w = pkc(qb[6], qb[7]); *(LAS u32x4*)(QC + t * GP_C + 64 + kk0) = w;
          w.x = pkc(kf[0], kf[1]); w.y = pkc(kf[2], kf[3]); w.z = pkc(kf[4], kf[5]); w.w = pkc(kf[6], kf[7]); *(LAS u32x4*)(KF + t * GP_K + kk0) = w;
          w.x = pkc(kb[0], kb[1]); w.y = pkc(kb[2], kb[3]); w.z = pkc(kb[4], kb[5]); w.w = pkc(kb[6], kb[7]); *(LAS u32x4*)(KB + t * GP_K + kk0) = w; }
        gla_vt(p, lds, row0, h, tid);
        { const bf16* sin = gb.SIN + (size_t)task * (SF::DV * 128);
#pragma unroll
          for (int it = 0; it < 4; ++it) { const int i = tid + it * NTHREADS, vv = i >> 4, ch = i & 15; *(LAS u32x4*)(ST + vv * GP_C + 8 * ch) = *(const u32x4*)(sin + vv * 128 + 8 * ch); } }
        __syncthreads();
        { const int si = wave & 3;
#pragma unroll
          for (int tt = 0; tt < 2; ++tt) { const int ti = (wave >> 2) * 2 + tt; f32x4 af = {0.f, 0.f, 0.f, 0.f}, ab = {0.f, 0.f, 0.f, 0.f};
#pragma unroll
              for (int ks = 0; ks < 2; ++ks) { af = MFMA16(lfrag(KF, GP_K, 16 * si, 32 * ks, lane), lfrag(QC, GP_C, 16 * ti, 32 * ks, lane), af);
                  ab = MFMA16(lfrag(KB, GP_K, 16 * si, 32 * ks, lane), lfrag(QC, GP_C, 16 * ti, 64 + 32 * ks, lane), ab); }
              const int t = 16 * ti + (lane & 15), s0 = 16 * si + 4 * (lane >> 4); float v[4];
#pragma unroll
              for (int r = 0; r < 4; ++r) { const int s = s0 + r; v[r] = (s <= t ? af[r] : 0.f) + (s >= t ? ab[r] : 0.f); }
              u32x2 w; w.x = pkc(v[0], v[1]); w.y = pkc(v[2], v[3]); *(LAS u32x2*)(P + t * GP_K + s0) = w; } }
        __syncthreads();
        { const int ti = wave & 3; bf16x8 aq[4], ap[2]; f32x4 acc[4];
#pragma unroll
          for (int ks = 0; ks < 4; ++ks) aq[ks] = lfrag(QC, GP_C, 16 * ti, 32 * ks, lane);
#pragma unroll
          for (int ks = 0; ks < 2; ++ks) ap[ks] = lfrag(P, GP_K, 16 * ti, 32 * ks, lane);
#pragma unroll
          for (int j = 0; j < 4; ++j) { const int vt = (wave >> 2) * 4 + j; acc[j] = (f32x4){0.f, 0.f, 0.f, 0.f};
#pragma unroll
              for (int ks = 0; ks < 4; ++ks) acc[j] = MFMA16(aq[ks], lfrag(ST, GP_C, 16 * vt, 32 * ks, lane), acc[j]);
#pragma unroll
              for (int ks = 0; ks < 2; ++ks) acc[j] = MFMA16(ap[ks], lfrag(VT, GP_K, 16 * vt, 32 * ks, lane), acc[j]); }
#pragma unroll
          for (int j = 0; j < 4; ++j) { const int vt = (wave >> 2) * 4 + j;
#pragma unroll
              for (int r = 0; r < 4; ++r) O[(16 * ti + 4 * (lane >> 4) + r) * 128 + 16 * vt + (lane & 15)] = acc[j][r]; } }
        __syncthreads();
        { const int t = tid >> 3, vv0 = 16 * (tid & 7); float o[16]; float ss = 0.f;
#pragma unroll
          for (int j = 0; j < 4; ++j) { const f32x4 x = *(const LAS f32x4*)(O + t * 128 + vv0 + 4 * j); o[4 * j] = x[0]; o[4 * j + 1] = x[1]; o[4 * j + 2] = x[2]; o[4 * j + 3] = x[3]; ss += x[0] * x[0] + x[1] * x[1] + x[2] * x[2] + x[3] * x[3]; }
          ss += __shfl_xor(ss, 1); ss += __shfl_xor(ss, 2); ss += __shfl_xor(ss, 4);
          const float rstd = 1.0f / sqrtf(ss * (1.0f / SF::DV) + SF::EPS);
          const bf16* rp = p.PROJ + (size_t)(row0 + t) * SF::PCOLS + SF::P_RA + h * SF::DV + vv0; const u32x4 r0 = *(const u32x4*)rp, r1 = *(const u32x4*)(rp + 8);
          const unsigned rw[8] = {r0.x, r0.y, r0.z, r0.w, r1.x, r1.y, r1.z, r1.w}; const float* gg = p.g_gla + l * SF::DV + vv0; float y[16];
#pragma unroll
          for (int j = 0; j < 16; ++j) { const float r = (j & 1) ? bfhi(rw[j >> 1]) : bflo(rw[j >> 1]); y[j] = o[j] * rstd * gg[j] * fast_silu(r); }
          u32x4 w0, w1; w0.x = pkc(y[0], y[1]); w0.y = pkc(y[2], y[3]); w0.z = pkc(y[4], y[5]); w0.w = pkc(y[6], y[7]); w1.x = pkc(y[8], y[9]); w1.y = pkc(y[10], y[11]); w1.z = pkc(y[12], y[13]); w1.w = pkc(y[14], y[15]);
          bf16* yp = p.Y + (size_t)(row0 + t) * SF::YCOLS + SF::Y_A + h * SF::DV + vv0; *(u32x4*)yp = w0; *(u32x4*)(yp + 8) = w1; }
        __syncthreads();
    }
}

constexpr int AT_KS = 0, AT_VT = 18432, AT_END = 18432 + 64 * GP_C * 2;
__device__ __forceinline__ void f_attn(const Params& p, int l, LAS unsigned char* lds) {
    const int tid = fresh_tid(), lane = tid & 63, wave = __builtin_amdgcn_readfirstlane(tid >> 6), g = wave >> 1, qh = wave & 1, hl = lane >> 5, c = lane & 31;
    LAS bf16* KS = (LAS bf16*)(lds + AT_KS); LAS bf16* VT = (LAS bf16*)(lds + AT_VT);
    constexpr float LOG2E = 1.4426950408889634f; constexpr float SC = 0.125f * LOG2E;
    constexpr int NQB = SF::SEQ / 128, NLU = SF::B * SF::SKV * NQB, NCU = SF::B * SF::SKV * (SF::CTX / 128);
    const int nunits = NLU + NCU;
    for (int u = fresh_bid(); u < nunits; u += gridDim.x) {
        const bool lat = u < NLU; int b, hk, qb;
        if (lat) { qb = u % NQB; hk = (u / NQB) % SF::SKV; b = u / (NQB * SF::SKV); } else { const int v = u - NLU; qb = v % (SF::CTX / 128); hk = (v / (SF::CTX / 128)) % SF::SKV; b = v / ((SF::CTX / 128) * SF::SKV); }
        const int qrow0 = (lat ? b * SF::SEQ : SF::NLAT + b * SF::CTX) + qb * 128 + 64 * qh; const int hq = hk * SF::SG + g;
        bf16x8 qf[2][4];
#pragma unroll
        for (int qs = 0; qs < 2; ++qs)
#pragma unroll
            for (int ks = 0; ks < 4; ++ks) qf[qs][ks] = *(const bf16x8*)(p.PROJ + (size_t)(qrow0 + 32 * qs + c) * SF::PCOLS + SF::P_QC + hq * SF::HD + 16 * ks + 8 * hl);
        float m[2], ls[2]; f32x16 O[2][2];
#pragma unroll
        for (int qs = 0; qs < 2; ++qs) { m[qs] = p.sink[l * SF::SH + hq] * LOG2E; ls[qs] = hl == 0 ? 1.0f : 0.0f;
#pragma unroll
            for (int dt = 0; dt < 2; ++dt)
#pragma unroll
                for (int r = 0; r < 16; ++r) O[dt][qs][r] = 0.f; }
        const int nkb = lat ? 5 : 2;
        for (int kbi = 0; kbi < nkb; ++kbi) {
            if ((kbi == 2 && qb == 0) || (kbi == 4 && qb == NQB - 1)) continue;
            const int krow0 = kbi < 2 ? SF::NLAT + b * SF::CTX + 128 * kbi : b * SF::SEQ + (qb + kbi - 3) * 128;
            __syncthreads();
#pragma unroll
            for (int it = 0; it < 2; ++it) { const int i = tid + it * NTHREADS, key = i >> 3, ch = i & 7; const bf16* src = p.PROJ + (size_t)(krow0 + key) * SF::PCOLS + hk * SF::HD + 8 * ch;
                *(LAS u32x4*)(KS + key * GP_K + 8 * ch) = *(const u32x4*)(src + SF::P_KC);
                const u32x4 v = *(const u32x4*)(src + SF::P_VC); LAS bf16* d = VT + (8 * ch) * GP_C + key;
                d[0 * GP_C] = (bf16)(v.x & 0xffffu); d[1 * GP_C] = (bf16)(v.x >> 16); d[2 * GP_C] = (bf16)(v.y & 0xffffu); d[3 * GP_C] = (bf16)(v.y >> 16);
                d[4 * GP_C] = (bf16)(v.z & 0xffffu); d[5 * GP_C] = (bf16)(v.z >> 16); d[6 * GP_C] = (bf16)(v.w & 0xffffu); d[7 * GP_C] = (bf16)(v.w >> 16); }
            __syncthreads();
            for (int kt = 0; kt < 4; ++kt) {
#pragma unroll
                for (int qs = 0; qs < 2; ++qs) {
                    const int rel = 32 * kt - (64 * qh + 32 * qs);
                    if ((kbi == 2 && rel < 0) || (kbi == 4 && rel > 0)) continue;
                    f32x16 S;
#pragma unroll
                    for (int r = 0; r < 16; ++r) S[r] = 0.f;
#pragma unroll
                    for (int ks = 0; ks < 4; ++ks) { const bf16x8 a = *(const LAS bf16x8*)(KS + (32 * kt + c) * GP_K + 16 * ks + 8 * hl); S = MFMA32(a, qf[qs][ks], S); }
                    float mx = m[qs];
                    if (rel == 0 && kbi >= 2 && kbi != 3) {
#pragma unroll
                        for (int r = 0; r < 16; ++r) { const int rr = (r & 3) + 8 * (r >> 2) + 4 * hl; const bool bad = kbi == 2 ? (rr < c) : (rr > c); const float x = bad ? -1e30f : S[r] * SC; S[r] = x; mx = fmaxf(mx, x); } }
                    else {
#pragma unroll
                        for (int r = 0; r < 16; ++r) { const float x = S[r] * SC; S[r] = x; mx = fmaxf(mx, x); } }
                    { auto rr = __builtin_amdgcn_permlane32_swap(__float_as_uint(mx), __float_as_uint(mx), false, false); mx = fmaxf(__uint_as_float(rr[0]), __uint_as_float(rr[1])); }
                    const float alpha = __builtin_amdgcn_exp2f(m[qs] - mx); m[qs] = mx; float rs = 0.f;
#pragma unroll
                    for (int r = 0; r < 16; ++r) { const float pv = __builtin_amdgcn_exp2f(S[r] - mx); S[r] = pv; rs += pv; }
                    ls[qs] = ls[qs] * alpha + rs;
#pragma unroll
                    for (int dt = 0; dt < 2; ++dt)
#pragma unroll
                        for (int r = 0; r < 16; ++r) O[dt][qs][r] *= alpha;
                    bf16x8 pf[2];
#pragma unroll
                    for (int s = 0; s < 2; ++s) { u32x4 w; w.x = pkc(S[8 * s], S[8 * s + 1]); w.y = pkc(S[8 * s + 2], S[8 * s + 3]); w.z = pkc(S[8 * s + 4], S[8 * s + 5]); w.w = pkc(S[8 * s + 6], S[8 * s + 7]);
                        pf[s] = __builtin_bit_cast(bf16x8, w); }
#pragma unroll
                    for (int dt = 0; dt < 2; ++dt)
#pragma unroll
                        for (int s = 0; s < 2; ++s) { const LAS bf16* vp = VT + (32 * dt + c) * GP_C + 32 * kt + 16 * s + 4 * hl;
                            const u32x2 v0 = *(const LAS u32x2*)vp, v1 = *(const LAS u32x2*)(vp + 8); u32x4 w; w.x = v0.x; w.y = v0.y; w.z = v1.x; w.w = v1.y;
                            O[dt][qs] = MFMA32(__builtin_bit_cast(bf16x8, w), pf[s], O[dt][qs]); }
                }
            }
        }
#pragma unroll
        for (int qs = 0; qs < 2; ++qs) { float lt = ls[qs];
            { auto rr = __builtin_amdgcn_permlane32_swap(__float_as_uint(lt), __float_as_uint(lt), false, false); lt = __uint_as_float(rr[0]) + __uint_as_float(rr[1]); }
            const float inv = 1.0f / lt; bf16* yp = p.Y + (size_t)(qrow0 + 32 * qs + c) * SF::YCOLS + SF::Y_C + hq * SF::HD;
#pragma unroll
            for (int dt = 0; dt < 2; ++dt)
#pragma unroll
                for (int gq = 0; gq < 4; ++gq) { u32x2 w; w.x = pkc(O[dt][qs][4 * gq] * inv, O[dt][qs][4 * gq + 1] * inv); w.y = pkc(O[dt][qs][4 * gq + 2] * inv, O[dt][qs][4 * gq + 3] * inv);
                    *(u32x2*)(yp + 32 * dt + 8 * gq + 4 * hl) = w; } }
    }
}

__device__ __forceinline__ float wave_sum(float v) {
#pragma unroll
    for (int o = 1; o < 64; o <<= 1) v += __shfl_xor(v, o);
    return v;
}
__device__ __forceinline__ void f_mods(const Params& p, LAS unsigned char* lds) {
    const int tid = fresh_tid(); LAS float* act = (LAS float*)lds; LAS float* PS = (LAS float*)(lds + 20480);
    constexpr int R = SF::B + 1; static_assert(R == 5, "mods rows");
    for (int i = tid; i < R * SF::D; i += NTHREADS) { const int r = i / SF::D, k = i % SF::D; const float v = r < SF::B ? p.c[r * SF::D + k] : p.c_ctx[k]; act[i] = v / (1.0f + __expf(-v)); }
    __syncthreads();
    constexpr int NCH = SF::NMOD / 128;
    for (int u = fresh_bid(); u < SF::DEPTH * NCH; u += gridDim.x) {
        const int l = u / NCH, n0 = (u % NCH) * 128; const int q = tid & 31, kg = tid >> 5;
        f32x4 acc[R];
#pragma unroll
        for (int r = 0; r < R; ++r) acc[r] = (f32x4){0.f, 0.f, 0.f, 0.f};
        const float* w = p.w_ada + ((size_t)l * SF::D + kg * 64) * SF::NMOD + n0 + 4 * q;
#pragma unroll 4
        for (int k = 0; k < 64; ++k) { const f32x4 w4 = *(const f32x4*)(w + (size_t)k * SF::NMOD);
#pragma unroll
            for (int r = 0; r < R; ++r) acc[r] = acc[r] + w4 * act[r * SF::D + kg * 64 + k]; }
#pragma unroll
        for (int r = 0; r < R; ++r) *(LAS f32x4*)(PS + ((kg * 32 + q) * R + r) * 4) = acc[r];
        __syncthreads();
        for (int t2 = tid; t2 < 32 * R * 4; t2 += NTHREADS) { const int qq = t2 / (R * 4), ri = t2 % (R * 4), r = ri / 4, i = ri % 4; float s = 0.f;
#pragma unroll
            for (int g2 = 0; g2 < 16; ++g2) s += PS[((g2 * 32 + qq) * R + r) * 4 + i];
            const int n = n0 + 4 * qq + i; p.MODS[((size_t)l * R + r) * SF::NMOD + n] = s + p.b_ada[(size_t)l * SF::NMOD + n]; }
        __syncthreads();
    }
}
__device__ __forceinline__ void f_resnorm(const Params& p, int l, int mode) {
    const int tid = fresh_tid(), lane = tid & 63, wave = tid >> 6; const int NGW = gridDim.x * NWAVES;
    for (int row = fresh_bid() * NWAVES + wave; row < SF::NTOK; row += NGW) {
        if (mode == 2 && row >= SF::NLAT) continue;
        const int mr = row < SF::NLAT ? row / SF::SEQ : SF::B;
        float* xr = p.X + (size_t)row * SF::D; f32x4 x[4]; float ss = 0.f;
        if (mode == 0) { const float* src = row < SF::NLAT ? p.x + (size_t)row * SF::D : p.ctx + (size_t)(row - SF::NLAT) * SF::D;
#pragma unroll
            for (int j = 0; j < 4; ++j) x[j] = *(const f32x4*)(src + 4 * lane + 256 * j); }
        else { const float* g2 = p.MODS + ((size_t)(l - 1) * (SF::B + 1) + mr) * SF::NMOD + 5 * SF::D; const bf16* ca = p.C2 + (size_t)row * 2 * SF::D; const bf16* cb = ca + SF::D;
#pragma unroll
            for (int j = 0; j < 4; ++j) { const int c0 = 4 * lane + 256 * j; const f32x4 xv = *(const f32x4*)(xr + c0), gv = *(const f32x4*)(g2 + c0); const u32x2 a = *(const u32x2*)(ca + c0), b = *(const u32x2*)(cb + c0);
                x[j] = xv + gv * (f32x4){bflo(a.x) + bflo(b.x), bfhi(a.x) + bfhi(b.x), bflo(a.y) + bflo(b.y), bfhi(a.y) + bfhi(b.y)}; } }
#pragma unroll
        for (int j = 0; j < 4; ++j) { if (mode != 2) *(f32x4*)(xr + 4 * lane + 256 * j) = x[j]; ss += x[j][0] * x[j][0] + x[j][1] * x[j][1] + x[j][2] * x[j][2] + x[j][3] * x[j][3]; }
        const float rstd = 1.0f / sqrtf(wave_sum(ss) * (1.0f / SF::D) + SF::EPS);
        if (mode == 2) {
#pragma unroll
            for (int j = 0; j < 4; ++j) { const int c0 = 4 * lane + 256 * j; *(f32x4*)(p.out + (size_t)row * SF::D + c0) = x[j] * rstd * *(const f32x4*)(p.g_final + c0); } }
        else { const float* md = p.MODS + ((size_t)l * (SF::B + 1) + mr) * SF::NMOD; const float* g = p.g_mix + (size_t)l * SF::D;
#pragma unroll
            for (int j = 0; j < 4; ++j) { const int c0 = 4 * lane + 256 * j; const f32x4 y = x[j] * rstd * *(const f32x4*)(g + c0) * (*(const f32x4*)(md + SF::D + c0) + 1.0f) + *(const f32x4*)(md + c0);
                u32x2 w; w.x = pk2(y[0], y[1]); w.y = pk2(y[2], y[3]); *(u32x2*)(p.H + (size_t)row * SF::D + c0) = w; } }
    }
}
__device__ __forceinline__ void f_norm2w(const Params& p, const FParams& f, int l, LAS unsigned char* lds) {
    const int tid = fresh_tid(), lane = tid & 63, wave = tid >> 6; const int NGW = gridDim.x * NWAVES;
    constexpr int NR = SF::MG + SF::NE;
    LAS float* WT = (LAS float*)lds;
    { const float* wg = p.w_rg + (size_t)l * SF::D * SF::MG; const float* we = p.w_re + (size_t)l * SF::D * SF::NE;
      for (int i = tid; i < SF::D; i += NTHREADS) { const f32x4 v = *(const f32x4*)(wg + 4 * i); WT[0 * SF::D + i] = v[0]; WT[1 * SF::D + i] = v[1]; WT[2 * SF::D + i] = v[2]; WT[3 * SF::D + i] = v[3]; }
      for (int i = tid; i < SF::D * 4; i += NTHREADS) { const int k = i >> 2, n0 = 4 * (i & 3); const f32x4 v = *(const f32x4*)(we + 4 * i);
          WT[(4 + n0) * SF::D + k] = v[0]; WT[(5 + n0) * SF::D + k] = v[1]; WT[(6 + n0) * SF::D + k] = v[2]; WT[(7 + n0) * SF::D + k] = v[3]; } }
    __syncthreads();
    int* cnt = (int*)p.ctl + CW_CNT + 64 * l;
    for (int row = fresh_bid() * NWAVES + wave; row < SF::NTOK; row += NGW) {
        const int mr = row < SF::NLAT ? row / SF::SEQ : SF::B; const float* xr = p.X + (size_t)row * SF::D;
        const float* md = p.MODS + ((size_t)l * (SF::B + 1) + mr) * SF::NMOD; const float* g = p.g_ffn + (size_t)l * SF::D;
        f32x4 x[4]; float ss = 0.f;
#pragma unroll
        for (int j = 0; j < 4; ++j) { x[j] = *(const f32x4*)(xr + 4 * lane + 256 * j); ss += x[j][0] * x[j][0] + x[j][1] * x[j][1] + x[j][2] * x[j][2] + x[j][3] * x[j][3]; }
        const float rstd = 1.0f / sqrtf(wave_sum(ss) * (1.0f / SF::D) + SF::EPS);
#pragma unroll
        for (int j = 0; j < 4; ++j) { const int c0 = 4 * lane + 256 * j; x[j] = x[j] * rstd * *(const f32x4*)(g + c0) * (*(const f32x4*)(md + 4 * SF::D + c0) + 1.0f) + *(const f32x4*)(md + 3 * SF::D + c0);
            u32x2 w; w.x = pk2(x[j][0], x[j][1]); w.y = pk2(x[j][2], x[j][3]); *(u32x2*)(p.H + (size_t)row * SF::D + c0) = w; }
        float lg[NR];
#pragma unroll
        for (int n = 0; n < NR; ++n) { float a = 0.f;
#pragma unroll
            for (int j = 0; j < 4; ++j) { const f32x4 w4 = *(const LAS f32x4*)(WT + n * SF::D + 4 * lane + 256 * j); a += x[j][0] * w4[0] + x[j][1] * w4[1] + x[j][2] * w4[2] + x[j][3] * w4[3]; }
            lg[n] = wave_sum(a); }
        int gsel = 0; float gmax = lg[0];
#pragma unroll
        for (int n = 1; n < SF::MG; ++n) if (lg[n] > gmax) { gmax = lg[n]; gsel = n; }
        float gsum = 0.f;
#pragma unroll
        for (int n = 0; n < SF::MG; ++n) gsum += __expf(lg[n] - gmax);
        const float ggate = 1.0f / gsum;
        float ev[SF::MEG];
#pragma unroll
        for (int n = 0; n < SF::MEG; ++n) { ev[n] = lg[SF::MG + n];
#pragma unroll
            for (int g2 = 1; g2 < SF::MG; ++g2) if (g2 == gsel) ev[n] = lg[SF::MG + g2 * SF::MEG + n]; }
        int i1 = 0; float v1 = ev[0];
#pragma unroll
        for (int n = 1; n < SF::MEG; ++n) if (ev[n] > v1) { v1 = ev[n]; i1 = n; }
        int i2 = -1; float v2 = 0.f;
#pragma unroll
        for (int n = 0; n < SF::MEG; ++n) if (n != i1 && (i2 < 0 || ev[n] > v2)) { v2 = ev[n]; i2 = n; }
        const float e2 = __expf(v2 - v1);
        if (lane < 2) { const int e = gsel * SF::MEG + (lane == 0 ? i1 : i2); const float wgt = lane == 0 ? ggate / (1.0f + e2) : ggate * e2 / (1.0f + e2);
            const int slot = atomicAdd(cnt + e, 1); f.LIST[(size_t)e * SF::NTOK + slot] = row * 2 + lane; f.WL[(size_t)e * SF::NTOK + slot] = wgt; }
    }
}

#ifndef MK_PER_PHASE
#define MK_PER_PHASE 0
#endif
#ifndef F_GLA
#define F_GLA 1
#endif
#ifndef F_ATTN
#define F_ATTN 1
#endif
#ifndef F_NORM
#define F_NORM 1
#endif
#ifndef F_MODS
#define F_MODS 1
#endif

struct KArgs { Params p; FParams f; GlaBufs gb; int lo, hi; };

__global__ void __launch_bounds__(NTHREADS, 2) mega(KArgs a) {
    extern __shared__ __attribute__((aligned(16))) unsigned char lds_raw[];
    LAS unsigned char* lds = (LAS unsigned char*)lds_raw;
    const Params& p = a.p; const FParams& f = a.f; const GlaBufs& gb = a.gb;
    const int tid = threadIdx.x;
    const long gs = (long)gridDim.x * NTHREADS;
#define gt fresh_gt()
    const int lo = a.lo, hi = a.hi;
    if (tid < 4) ((LAS unsigned*)(lds + LDS_BARW))[tid] = 0u;
    __syncthreads();
    XcdBarrier bar; bar.bar = p.ctl; bar.x = 0; bar.st = (volatile LAS unsigned*)(lds + LDS_BARW);
    if (hi - lo > 1) bar = xcd_barrier_post(p.ctl, (volatile LAS unsigned*)(lds + LDS_BARW));
    int ph = 0;
#define PHASE(body) do { if (ph >= lo && ph < hi) { body; if (ph + 1 < hi) xcd_barrier(bar); } ++ph; } while (0)
    PHASE(nv_tables<SF>(p, gt, gs));
#if F_MODS
    PHASE({ f_mods(p, lds); f_dftm(p, f); });
#else
    PHASE({ nv_mods<SF>(p, gt, gs); f_dftm(p, f); });
#endif
#if F_NORM
    PHASE(f_resnorm(p, 0, 0));
#else
    PHASE(nv_resnorm<SF>(p, 0, 0, gt, gs));
#endif
    for (int l = 0; l < SF::DEPTH; ++l) {
        PHASE(f_convert(p, f, l, lds));
        PHASE(f_inproj(p, f, l, lds));
        PHASE(f_seqdft(p, f, lds));
#if F_ATTN
        PHASE(f_attn(p, l, lds));
#else
        PHASE(nv_attn<SF>(p, l, gt, gs));
#endif
#if F_GLA
        PHASE(f_gla_local(p, gb, lds));
        PHASE(f_gla_scan(gb));
        PHASE(f_gla_out(p, gb, l, lds));
#else
        PHASE(nv_gla_rec<SF>(p, gt, gs));
        PHASE(nv_gla_out<SF>(p, l, gt, gs));
#endif
        PHASE(f_merge(p, f, lds));
        PHASE(f_out(p, f, l, lds));
#if F_NORM
        PHASE(f_norm2w(p, f, l, lds));
#else
        PHASE(f_norm2(p, f, l));
#endif
        PHASE(f_moe_up(p, f, l, lds));
        PHASE(f_moe_down(p, f, l, lds));
#if F_NORM
        PHASE(f_resnorm(p, l + 1, (l + 1 < SF::DEPTH) ? 1 : 2));
#else
        PHASE(nv_resnorm<SF>(p, l + 1, (l + 1 < SF::DEPTH) ? 1 : 2, gt, gs));
#endif
    }
#undef PHASE
#undef gt
}
constexpr int N_PHASES = 3 + SF::DEPTH * (12 + (F_GLA ? 1 : 0));

extern "C" void kernel_launch(void* const* d_in, const int* in_sizes, int n_in, void* d_out, int out_size, void* d_ws, size_t ws_size, hipStream_t stream) {
    static int grid = 0;
    if (grid == 0) {
        int dev = 0, cus = 0;
        if (hipGetDevice(&dev) != hipSuccess || hipDeviceGetAttribute(&cus, hipDeviceAttributeMultiprocessorCount, dev) != hipSuccess) { fprintf(stderr, "kernel_launch: device query failed\n"); grid = -1; return; }
        if (hipFuncSetAttribute((const void*)mega, hipFuncAttributeMaxDynamicSharedMemorySize, LDS_BYTES) != hipSuccess) { fprintf(stderr, "kernel_launch: hipFuncSetAttribute failed\n"); grid = -1; return; }
        int per_cu = 0;
        if (hipOccupancyMaxActiveBlocksPerMultiprocessor(&per_cu, (const void*)mega, NTHREADS, LDS_BYTES) != hipSuccess || per_cu < 1) { fprintf(stderr, "kernel_launch: occupancy query says %d\n", per_cu); }
        (void)hipGetLastError();
        grid = cus;
        if (grid > 256) grid = 256;
    }
    if (grid < 0) return;
    if (n_in != 24 || out_size != SF::NLAT * SF::D) { fprintf(stderr, "kernel_launch: unexpected shapes (n_in %d, out %d)\n", n_in, out_size); return; }
    KArgs a; memset(&a, 0, sizeof(a));
    Params& p = a.p; FParams& f = a.f; GlaBufs& gb = a.gb;
    const float* const* in = (const float* const*)d_in;
    p.x = in[0]; p.c = in[1]; p.ctx = in[2]; p.c_ctx = in[3]; p.w_ada = in[4]; p.b_ada = in[5]; p.g_mix = in[6]; p.g_ffn = in[7]; p.w_in = in[8]; p.w_dd = in[9]; p.w_du = in[10];
    p.b_dec = in[11]; p.g_gla = in[12]; p.sink = in[13]; p.w_pa = in[14]; p.w_pb = in[15]; p.w_pc = in[16]; p.w_out = in[17]; p.w_rg = in[18]; p.w_re = in[19]; p.w1 = in[20];
    p.w3 = in[21]; p.w2 = in[22]; p.g_final = in[23];
    p.out = (float*)d_out;
    size_t off = 0; unsigned char* ws = (unsigned char*)d_ws;
    auto take = [&](size_t bytes) { void* q = ws + off; off += (bytes + 255) & ~(size_t)255; return q; };
    const size_t NT = SF::NTOK, D = SF::D;
    constexpr size_t CTL_BYTES = 64 * 1024;
    p.ctl = (unsigned*)take(CTL_BYTES);
    p.X = (float*)take(NT * D * 4); p.MODS = (float*)take((size_t)SF::DEPTH * (SF::B + 1) * SF::NMOD * 4);
    p.TABL = (float*)take(2 * SF::SEQ * 4); p.TABX = (float*)take(2 * SF::CTX * 4); p.TABC = (float*)take(2 * SF::FGW * 4); p.ROPE = (float*)take(2 * SF::NPOS * SF::NFREQ * 4);
    p.H = (bf16*)take(NT * D * 2); p.PROJ = (bf16*)take(NT * SF::PCOLS * 2); p.LA = (float*)take(NT * 2 * SF::QKW * 4);
    p.MERGED = (bf16*)take(NT * D * 2);
    p.PQT = (bf16*)take((size_t)SF::B * SF::FG * SF::FGW * 2 * SF::SEQ * 2); p.PQTC = (bf16*)take((size_t)SF::B * SF::FG * SF::FGW * 2 * SF::CTX * 2);
    p.Y = (bf16*)take(NT * SF::YCOLS * 2); p.OG = (float*)take(2 * NT * SF::VW * 4);
    { unsigned char* q = (unsigned char*)p.PROJ; size_t o2 = 0; auto take2 = [&](size_t bytes) { void* r = q + o2; o2 += (bytes + 255) & ~(size_t)255; return r; };
      f.HID = (bf16*)take2((size_t)HID_ROWS * SF::DE * 2); p.C2 = (bf16*)take2(NT * 2 * D * 2);
      if (o2 > NT * SF::PCOLS * 2) { fprintf(stderr, "kernel_launch: MoE overlay too large\n"); return; } }
    f.MSCR = p.OG; gb.SLOC = p.OG;
    static_assert((size_t)256 * 32 * NTHREADS * 16 <= (size_t)2 * SF::NTOK * SF::VW * 4, "merge scratch must fit the OG region");
    static_assert((size_t)GLA_TASKS * 2 * SF::DV * SF::DK * 4 <= (size_t)2 * SF::NTOK * SF::VW * 4, "chunk states must fit the OG region");
    gb.DTOT = (float*)take((size_t)GLA_TASKS * 2 * SF::DK * 4); gb.SIN = (bf16*)take((size_t)GLA_TASKS * SF::DV * 128 * 2);
    f.WIN_T = (bf16*)take((size_t)WIN_ROWS * D * 2); f.WF_T = (bf16*)take((size_t)SF::FG * 2 * SF::FGW * D * 2);
    f.WPA_T = (bf16*)take(3 * D * SF::VW * 2); f.WPB_T = f.WPA_T + D * SF::VW; f.WPC_T = f.WPB_T + D * SF::VW;
    static_assert(SF::VW == SF::FW && SF::VW == SF::SQW, "merge branches share K");
    f.WOUT_T = (bf16*)take(D * D * 2);
    f.WUP_T = (bf16*)take((size_t)SF::NE * 2 * SF::DE * D * 2); f.WDN_T = (bf16*)take((size_t)SF::NE * D * SF::DE * 2);
    f.DFTM = (bf16*)take((size_t)SF::SEQ * 2 * SF::SEQ * 2); f.DFTX = (bf16*)take((size_t)SF::CTX * 2 * SF::CTX * 2);
    f.LIST = (int*)take((size_t)SF::NE * NT * 4); f.WL = (float*)take((size_t)SF::NE * NT * 4);
#if !F_NORM
    p.TOPE = (int*)take(NT * 2 * 4); p.TOPW = (float*)take(NT * 2 * 4);
#endif
    if (off > ws_size) { fprintf(stderr, "kernel_launch: workspace too small: need %zu, have %zu\n", off, ws_size); return; }
    if (hipMemsetAsync(d_ws, 0, CTL_BYTES, stream) != hipSuccess) { fprintf(stderr, "kernel_launch: memset failed\n"); return; }
#if MK_PER_PHASE
    for (int i = 0; i < N_PHASES; ++i) { a.lo = i; a.hi = i + 1; hipLaunchKernelGGL(mega, dim3(grid), dim3(NTHREADS), LDS_BYTES, stream, a); }
#else
    a.lo = 0; a.hi = N_PHASES; hipLaunchKernelGGL(mega, dim3(grid), dim3(NTHREADS), LDS_BYTES, stream, a);
#endif
    const hipError_t le = hipPeekAtLastError();
    if (le != hipSuccess) fprintf(stderr, "kernel_launch: launch failed: %s\n", hipGetErrorName(le));
}
```

```cpp
#include <hip/hip_runtime.h>
#include <cstdio>
#include <cstdint>
#include <cstring>
#ifdef CPU_EMU
#include <cmath>
#include <cstdint>
#include <cstring>
#define DEVFN static inline
#else
#define DEVFN __device__ __forceinline__
#endif

typedef unsigned short bf16;
DEVFN float bf2f(bf16 v) { unsigned u = ((unsigned)v) << 16; float f; memcpy(&f, &u, 4); return f; }
DEVFN bf16 f2bf(float f) { unsigned u; memcpy(&u, &f, 4); u += 0x7fffu + ((u >> 16) & 1u); return (bf16)(u >> 16); }
DEVFN float sigmoidf_(float x) { return 1.0f / (1.0f + expf(-x)); }
DEVFN float siluf_(float x) { return x / (1.0f + expf(-x)); }
DEVFN float logsigmoidf_(float x) { return fminf(x, 0.0f) - log1pf(expf(-fabsf(x))); }

struct CfgFull { static constexpr int D = 1024, B = 4, SEQ = 4096, DEPTH = 4, GW = 64, CTX = 256, GH = 4, DK = 64, DV = 128, RANK = 16, FG = 4, FGW = 128,
                 SH = 8, SKV = 2, HD = 64, WIN = 128, MG = 4, MEG = 4, DE = 512; };
#ifndef SMALL_SEQ
#define SMALL_SEQ 256
#endif
struct CfgSmall { static constexpr int D = 64, B = 2, SEQ = SMALL_SEQ, DEPTH = 2, GW = 16, CTX = 64, GH = 2, DK = 8, DV = 16, RANK = 4, FG = 2, FGW = 16,
                  SH = 4, SKV = 2, HD = 8, WIN = 32, MG = 2, MEG = 4, DE = 32; };

template <class C> struct Sh : C {
    static constexpr int NLAT = C::B * C::SEQ, NCTX = C::B * C::CTX, NTOK = NLAT + NCTX;
    static constexpr int QKW = C::GH * C::DK, VW = C::GH * C::DV, FW = C::FG * C::FGW, SQW = C::SH * C::HD, SKW = C::SKV * C::HD, NE = C::MG * C::MEG, SG = C::SH / C::SKV;
    static constexpr int NMOD = 6 * C::D;
    static constexpr int L_KA = 0, L_VA = L_KA + QKW, L_KC = L_VA + VW, L_VC = L_KC + SKW, L_QA = L_VC + SKW, L_RA = L_QA + QKW, L_UB = L_RA + VW, L_QC = L_UB + FW, L_G = L_QC + SQW, INCOLS = L_G + 3 * C::D;
    static constexpr int P_KA = 0, P_VA = P_KA + QKW, P_KC = P_VA + VW, P_VC = P_KC + SKW, P_QA = P_VC + SKW, P_RA = P_QA + QKW, P_QC = P_RA + VW, P_G = P_QC + SQW, PCOLS = P_G + 3 * C::D;
    static constexpr int YCOLS = VW + FW + SQW;
    static constexpr int Y_A = 0, Y_B = VW, Y_C = VW + FW;
    static constexpr int NFREQ = C::HD / 4;
    static constexpr int NPOS = (C::GW > C::SEQ / C::GW) ? C::GW : C::SEQ / C::GW;
    static constexpr float EPS = 1e-6f;
};

template <class S> DEVFN int row_batch(int row) { return row < S::NLAT ? row / S::SEQ : (row - S::NLAT) / S::CTX; }
template <class S> DEVFN int row_modrow(int row) { return row < S::NLAT ? row / S::SEQ : S::B; }

struct Params {
    const float *x, *c, *ctx, *c_ctx, *w_ada, *b_ada, *g_mix, *g_ffn, *w_in, *w_dd, *w_du, *b_dec, *g_gla, *sink, *w_pa, *w_pb, *w_pc, *w_out, *w_rg, *w_re, *w1, *w3, *w2, *g_final;
    float* out;
    unsigned* ctl;
    float* X;
    float* MODS;
    float* TABL;
    float* TABX;
    float* TABC;
    float* ROPE;
    bf16* H;
    bf16* PROJ;
    float* LA;
    float* UB;
    float* D16;
    bf16* PQT;
    bf16* PQTC;
    bf16* Y;
    float* OG;
    bf16* MERGED;
    int* TOPE;
    float* TOPW;
    bf16* HIDN;
    bf16* C2;
};

template <class S> DEVFN void nv_tables(const Params& p, long gt, long gs) {
    const float TWO_PI = 6.283185307179586f;
    for (long i = gt; i < S::SEQ; i += gs) { double a = 6.283185307179586 * (double)i / S::SEQ; p.TABL[2 * i] = (float)cos(a); p.TABL[2 * i + 1] = (float)sin(a); }
    for (long i = gt; i < S::CTX; i += gs) { double a = 6.283185307179586 * (double)i / S::CTX; p.TABX[2 * i] = (float)cos(a); p.TABX[2 * i + 1] = (float)sin(a); }
    for (long i = gt; i < S::FGW; i += gs) { double a = 6.283185307179586 * (double)i / S::FGW; p.TABC[2 * i] = (float)cos(a); p.TABC[2 * i + 1] = (float)sin(a); }
    for (long i = gt; i < S::NPOS * S::NFREQ; i += gs) {
        int pos = (int)(i / S::NFREQ), f = (int)(i % S::NFREQ);
        float inv = powf(10000.0f, -(float)(2 * f) / (float)(S::HD / 2));
        float a = (float)pos * inv; p.ROPE[2 * i] = cosf(a); p.ROPE[2 * i + 1] = sinf(a);
    }
    (void)TWO_PI;
}

template <class S> DEVFN void nv_mods(const Params& p, long gt, long gs) {
    const long total = (long)S::DEPTH * (S::B + 1) * S::NMOD;
    for (long i = gt; i < total; i += gs) {
        int n = (int)(i % S::NMOD); int r = (int)((i / S::NMOD) % (S::B + 1)); int l = (int)(i / ((long)S::NMOD * (S::B + 1)));
        const float* cv = r < S::B ? p.c + (long)r * S::D : p.c_ctx;
        const float* w = p.w_ada + (long)l * S::D * S::NMOD + n;
        float acc = 0.f;
        for (int k = 0; k < S::D; ++k) acc += siluf_(cv[k]) * w[(long)k * S::NMOD];
        p.MODS[i] = acc + p.b_ada[(long)l * S::NMOD + n];
    }
}

template <class S> DEVFN void nv_resnorm(const Params& p, int l, int mode, long gt, long gs) {
    for (long row = gt; row < S::NTOK; row += gs) {
        const int mr = row_modrow<S>((int)row);
        float* xr = p.X + row * S::D;
        const float* src = nullptr;
        if (mode == 0) src = row < S::NLAT ? p.x + row * S::D : p.ctx + (row - S::NLAT) * S::D;
        const float* gate2 = (mode != 0) ? p.MODS + ((long)(l - 1) * (S::B + 1) + mr) * S::NMOD + 5 * S::D : nullptr;
        float ss = 0.f;
        for (int c = 0; c < S::D; ++c) {
            float v;
            if (mode == 0) v = src[c];
            else v = xr[c] + gate2[c] * (bf2f(p.C2[(row * 2) * S::D + c]) + bf2f(p.C2[(row * 2 + 1) * S::D + c]));
            xr[c] = v; ss += v * v;
        }
        const float rstd = 1.0f / sqrtf(ss / S::D + S::EPS);
        if (mode == 2) {
            if (row < S::NLAT) for (int c = 0; c < S::D; ++c) p.out[row * S::D + c] = xr[c] * rstd * p.g_final[c];
        } else {
            const float* md = p.MODS + ((long)l * (S::B + 1) + mr) * S::NMOD;
            const float* g = p.g_mix + (long)l * S::D;
            for (int c = 0; c < S::D; ++c) p.H[row * S::D + c] = f2bf(xr[c] * rstd * g[c] * (1.0f + md[S::D + c]) + md[c]);
        }
    }
}

template <class S> DEVFN float rope_apply(const Params& p, int s, int d, float own, float partner) {
    const int half = d / (S::HD / 2), i = d % (S::HD / 2), f = i % S::NFREQ; const bool second = i >= S::NFREQ;
    const int pos = half == 0 ? s / S::GW : s % S::GW;
    const float cs = p.ROPE[2 * (pos * S::NFREQ + f)], sn = p.ROPE[2 * (pos * S::NFREQ + f) + 1];
    return second ? partner * sn + own * cs : own * cs - partner * sn;
}

template <class S> DEVFN void nv_inproj(const Params& p, int l, long gt, long gs) {
    const long total = (long)S::NTOK * S::INCOLS;
    const float* W = p.w_in + (long)l * S::D * S::INCOLS;
    for (long i = gt; i < total; i += gs) {
        const int col = (int)(i % S::INCOLS); const long row = i / S::INCOLS;
        const bf16* h = p.H + row * S::D;
        const bool is_kc = col >= S::L_KC && col < S::L_VC, is_qc = col >= S::L_QC && col < S::L_G;
        int pcol = col;
        if (is_kc || is_qc) { const int base = is_kc ? S::L_KC : S::L_QC; const int d = (col - base) % S::HD; const int ii = d % (S::HD / 2);
            pcol = ii < S::NFREQ ? col + S::NFREQ : col - S::NFREQ; }
        float acc = 0.f, acc2 = 0.f;
        if (is_kc || is_qc) { for (int k = 0; k < S::D; ++k) { const float hv = bf2f(h[k]); acc += hv * W[(long)k * S::INCOLS + col]; acc2 += hv * W[(long)k * S::INCOLS + pcol]; } }
        else { for (int k = 0; k < S::D; ++k) acc += bf2f(h[k]) * W[(long)k * S::INCOLS + col]; }
        bf16* pr = p.PROJ + row * S::PCOLS;
        if (col < S::L_VA) pr[S::P_KA + col - S::L_KA] = f2bf(acc);
        else if (col < S::L_KC) pr[S::P_VA + col - S::L_VA] = f2bf(acc);
        else if (col < S::L_VC) { float v = acc; if (row < S::NLAT) v = rope_apply<S>(p, (int)(row % S::SEQ), (col - S::L_KC) % S::HD, acc, acc2); pr[S::P_KC + col - S::L_KC] = f2bf(v); }
        else if (col < S::L_QA) pr[S::P_VC + col - S::L_VC] = f2bf(acc);
        else if (col < S::L_RA) pr[S::P_QA + col - S::L_QA] = f2bf(acc * (1.0f / sqrtf((float)S::DK)));
        else if (col < S::L_UB) pr[S::P_RA + col - S::L_RA] = f2bf(acc);
        else if (col < S::L_QC) p.UB[row * S::FW + col - S::L_UB] = acc;
        else if (col < S::L_G) { float v = acc; if (row < S::NLAT) v = rope_apply<S>(p, (int)(row % S::SEQ), (col - S::L_QC) % S::HD, acc, acc2); pr[S::P_QC + col - S::L_QC] = f2bf(v); }
        else pr[S::P_G + col - S::L_G] = f2bf(sigmoidf_(acc));
    }
}

template <class S> DEVFN void nv_decay1(const Params& p, int l, long gt, long gs) {
    const long total = (long)S::NTOK * 2 * S::RANK;
    for (long i = gt; i < total; i += gs) {
        const int r = (int)(i % S::RANK), dir = (int)((i / S::RANK) % 2); const long row = i / (2 * S::RANK);
        const float* w = p.w_dd + ((long)(l * 2 + dir) * S::D) * S::RANK + r; const bf16* h = p.H + row * S::D;
        float acc = 0.f; for (int k = 0; k < S::D; ++k) acc += bf2f(h[k]) * w[(long)k * S::RANK];
        p.D16[i] = acc;
    }
}
template <class S> DEVFN void nv_decay2(const Params& p, int l, long gt, long gs) {
    const long total = (long)S::NTOK * 2 * S::QKW;
    for (long i = gt; i < total; i += gs) {
        const int n = (int)(i % S::QKW), dir = (int)((i / S::QKW) % 2); const long row = i / (2 * S::QKW);
        const float* w = p.w_du + ((long)(l * 2 + dir) * S::RANK) * S::QKW + n; const float* d = p.D16 + (row * 2 + dir) * S::RANK;
        float z = p.b_dec[(long)(l * 2 + dir) * S::QKW + n]; for (int r = 0; r < S::RANK; ++r) z += d[r] * w[(long)r * S::QKW];
        p.LA[i] = logsigmoidf_(z) * (1.0f / 16.0f);
    }
}

template <class S> DEVFN void nv_chdft(const Params& p, long gt, long gs) {
    const long total = (long)S::NTOK * S::FG * S::FGW * 2;
    const float sc = 1.0f / sqrtf((float)S::FGW);
    for (long i = gt; i < total; i += gs) {
        const int pq = (int)(i % 2), cp = (int)((i / 2) % S::FGW), g = (int)((i / (2 * S::FGW)) % S::FG); const long row = i / (2 * S::FGW * S::FG);
        const float* u = p.UB + row * S::FW + g * S::FGW; float acc = 0.f;
        for (int c = 0; c < S::FGW; ++c) acc += u[c] * p.TABC[2 * ((c * cp) % S::FGW) + pq];
        acc *= sc;
        if (row < S::NLAT) { const int b = (int)(row / S::SEQ), s = (int)(row % S::SEQ); p.PQT[((((long)b * S::FG + g) * S::FGW + cp) * 2 + pq) * S::SEQ + s] = f2bf(acc); }
        else { const int b = (int)((row - S::NLAT) / S::CTX), j = (int)((row - S::NLAT) % S::CTX); p.PQTC[((((long)b * S::FG + g) * S::FGW + cp) * 2 + pq) * S::CTX + j] = f2bf(acc); }
    }
}
template <class S> DEVFN void nv_seqdft(const Params& p, long gt, long gs) {
    { const long total = (long)S::B * S::FG * S::FGW * S::SEQ; const float sc = 1.0f / sqrtf((float)S::SEQ);
      for (long i = gt; i < total; i += gs) {
        const int lp = (int)(i % S::SEQ); const long bgc = i / S::SEQ; const int cp = (int)(bgc % S::FGW), g = (int)((bgc / S::FGW) % S::FG), b = (int)(bgc / ((long)S::FGW * S::FG));
        const bf16* P = p.PQT + (bgc * 2) * S::SEQ; const bf16* Q = P + S::SEQ; float acc = 0.f;
        for (int l = 0; l < S::SEQ; ++l) { const int m = (int)(((long)l * lp) % S::SEQ); acc += p.TABL[2 * m] * bf2f(P[l]) - p.TABL[2 * m + 1] * bf2f(Q[l]); }
        p.Y[((long)b * S::SEQ + lp) * S::YCOLS + S::Y_B + g * S::FGW + cp] = f2bf(acc * sc); } }
    { const long total = (long)S::B * S::FG * S::FGW * S::CTX; const float sc = 1.0f / sqrtf((float)S::CTX);
      for (long i = gt; i < total; i += gs) {
        const int lp = (int)(i % S::CTX); const long bgc = i / S::CTX; const int cp = (int)(bgc % S::FGW), g = (int)((bgc / S::FGW) % S::FG), b = (int)(bgc / ((long)S::FGW * S::FG));
        const bf16* P = p.PQTC + (bgc * 2) * S::CTX; const bf16* Q = P + S::CTX; float acc = 0.f;
        for (int l = 0; l < S::CTX; ++l) { const int m = (l * lp) % S::CTX; acc += p.TABX[2 * m] * bf2f(P[l]) - p.TABX[2 * m + 1] * bf2f(Q[l]); }
        p.Y[((long)S::NLAT + (long)b * S::CTX + lp) * S::YCOLS + S::Y_B + g * S::FGW + cp] = f2bf(acc * sc); } }
}

template <class S> DEVFN void nv_attn(const Params& p, int l, long gt, long gs) {
    const float scale = 1.0f / sqrtf((float)S::HD);
    const long total = (long)S::NTOK * S::SH;
    for (long i = gt; i < total; i += gs) {
        const int hq = (int)(i % S::SH); const long row = i / S::SH; const int hk = hq / S::SG; const int b = row_batch<S>((int)row);
        float q[S::HD], o[S::HD];
        _Pragma("unroll") for (int d = 0; d < S::HD; ++d) { q[d] = bf2f(p.PROJ[row * S::PCOLS + S::P_QC + hq * S::HD + d]) * scale; o[d] = 0.f; }
        float m = p.sink[l * S::SH + hq], lsum = 1.0f;
        const bool lat = row < S::NLAT; const int s = (int)(row % S::SEQ);
        const int nwin = lat ? 2 * S::WIN + 1 : 0;
        for (int t = 0; t < nwin + S::CTX; ++t) {
            long krow;
            if (t < nwin) { const int kp = s - S::WIN + t; if (kp < 0 || kp >= S::SEQ) continue; krow = (long)b * S::SEQ + kp; }
            else krow = (long)S::NLAT + (long)b * S::CTX + (t - nwin);
            const bf16* kr = p.PROJ + krow * S::PCOLS + S::P_KC + hk * S::HD; const bf16* vr = p.PROJ + krow * S::PCOLS + S::P_VC + hk * S::HD;
            float sc = 0.f; _Pragma("unroll") for (int d = 0; d < S::HD; ++d) sc += q[d] * bf2f(kr[d]);
            if (sc > m) { const float r = expf(m - sc); lsum *= r; _Pragma("unroll") for (int d = 0; d < S::HD; ++d) o[d] *= r; m = sc; }
            const float pe = expf(sc - m); lsum += pe;
            _Pragma("unroll") for (int d = 0; d < S::HD; ++d) o[d] += pe * bf2f(vr[d]);
        }
        const float inv = 1.0f / lsum;
        _Pragma("unroll") for (int d = 0; d < S::HD; ++d) p.Y[row * S::YCOLS + S::Y_C + hq * S::HD + d] = f2bf(o[d] * inv);
    }
}

template <class S> DEVFN void nv_gla_rec(const Params& p, long gt, long gs) {
    const long total = (long)S::B * S::GH * 2 * S::DV;
    for (long i = gt; i < total; i += gs) {
        const int v = (int)(i % S::DV), dir = (int)((i / S::DV) % 2), h = (int)((i / (2 * S::DV)) % S::GH), b = (int)(i / (2 * S::DV * S::GH));
        float St[S::DK]; _Pragma("unroll") for (int k = 0; k < S::DK; ++k) St[k] = 0.f;
        for (int t = 0; t < S::CTX + S::SEQ; ++t) {
            long row;
            if (t < S::CTX) row = (long)S::NLAT + (long)b * S::CTX + (dir == 0 ? t : S::CTX - 1 - t);
            else { const int u = t - S::CTX; row = (long)b * S::SEQ + (dir == 0 ? u : S::SEQ - 1 - u); }
            const bf16* pr = p.PROJ + row * S::PCOLS; const float* la = p.LA + row * 2 * S::QKW + dir * S::QKW + h * S::DK;
            const float vv = bf2f(pr[S::P_VA + h * S::DV + v]); float o = 0.f;
            _Pragma("unroll") for (int k = 0; k < S::DK; ++k) { St[k] = expf(la[k]) * St[k] + bf2f(pr[S::P_KA + h * S::DK + k]) * vv; o += bf2f(pr[S::P_QA + h * S::DK + k]) * St[k]; }
            p.OG[((long)dir * S::NTOK + row) * S::VW + h * S::DV + v] = o;
        }
    }
}
template <class S> DEVFN void nv_gla_out(const Params& p, int l, long gt, long gs) {
    const long total = (long)S::NTOK * S::GH;
    for (long i = gt; i < total; i += gs) {
        const int h = (int)(i % S::GH); const long row = i / S::GH;
        const float* o0 = p.OG + row * S::VW + h * S::DV; const float* o1 = o0 + (long)S::NTOK * S::VW;
        float ss = 0.f; for (int v = 0; v < S::DV; ++v) { const float o = o0[v] + o1[v]; ss += o * o; }
        const float rstd = 1.0f / sqrtf(ss / S::DV + S::EPS);
        for (int v = 0; v < S::DV; ++v) { const float o = (o0[v] + o1[v]) * rstd * p.g_gla[l * S::DV + v]; const float r = bf2f(p.PROJ[row * S::PCOLS + S::P_RA + h * S::DV + v]);
            p.Y[row * S::YCOLS + S::Y_A + h * S::DV + v] = f2bf(o * siluf_(r)); }
    }
}

template <class S> DEVFN void nv_merge(const Params& p, int l, long gt, long gs) {
    const long total = (long)S::NTOK * S::D;
    for (long i = gt; i < total; i += gs) {
        const int col = (int)(i % S::D); const long row = i / S::D; const bf16* y = p.Y + row * S::YCOLS; const bf16* g = p.PROJ + row * S::PCOLS + S::P_G;
        float a = 0.f, b = 0.f, c = 0.f;
        const float* wa = p.w_pa + (long)l * S::VW * S::D + col; const float* wb = p.w_pb + (long)l * S::FW * S::D + col; const float* wc = p.w_pc + (long)l * S::SQW * S::D + col;
        for (int k = 0; k < S::VW; ++k) a += bf2f(y[S::Y_A + k]) * wa[(long)k * S::D];
        for (int k = 0; k < S::FW; ++k) b += bf2f(y[S::Y_B + k]) * wb[(long)k * S::D];
        for (int k = 0; k < S::SQW; ++k) c += bf2f(y[S::Y_C + k]) * wc[(long)k * S::D];
        p.MERGED[i] = f2bf(bf2f(g[col]) * a + bf2f(g[S::D + col]) * b + bf2f(g[2 * S::D + col]) * c);
    }
}
template <class S> DEVFN void nv_out(const Params& p, int l, long gt, long gs) {
    const long total = (long)S::NTOK * S::D;
    for (long i = gt; i < total; i += gs) {
        const int col = (int)(i % S::D); const long row = i / S::D; const bf16* m = p.MERGED + row * S::D; const float* w = p.w_out + (long)l * S::D * S::D + col;
        float acc = 0.f; for (int k = 0; k < S::D; ++k) acc += bf2f(m[k]) * w[(long)k * S::D];
        const float g1 = p.MODS[((long)l * (S::B + 1) + row_modrow<S>((int)row)) * S::NMOD + 2 * S::D + col];
        p.X[i] += g1 * acc;
    }
}
template <class S> DEVFN void nv_norm2(const Params& p, int l, long gt, long gs) {
    for (long row = gt; row < S::NTOK; row += gs) {
        const float* xr = p.X + row * S::D; const float* md = p.MODS + ((long)l * (S::B + 1) + row_modrow<S>((int)row)) * S::NMOD; const float* g = p.g_ffn + (long)l * S::D;
        float ss = 0.f; for (int c = 0; c < S::D; ++c) ss += xr[c] * xr[c];
        const float rstd = 1.0f / sqrtf(ss / S::D + S::EPS);
        float gl[S::MG], el[S::NE]; _Pragma("unroll") for (int n = 0; n < S::MG; ++n) gl[n] = 0.f; _Pragma("unroll") for (int n = 0; n < S::NE; ++n) el[n] = 0.f;
        const float* wg = p.w_rg + (long)l * S::D * S::MG; const float* we = p.w_re + (long)l * S::D * S::NE;
        for (int c = 0; c < S::D; ++c) { const float h2 = xr[c] * rstd * g[c] * (1.0f + md[4 * S::D + c]) + md[3 * S::D + c]; p.H[row * S::D + c] = f2bf(h2);
            _Pragma("unroll") for (int n = 0; n < S::MG; ++n) gl[n] += h2 * wg[c * S::MG + n]; _Pragma("unroll") for (int n = 0; n < S::NE; ++n) el[n] += h2 * we[c * S::NE + n]; }
        int gsel = 0; float gmax = gl[0];
        _Pragma("unroll") for (int n = 1; n < S::MG; ++n) if (gl[n] > gmax) { gmax = gl[n]; gsel = n; }
        float gsum = 0.f; _Pragma("unroll") for (int n = 0; n < S::MG; ++n) gsum += expf(gl[n] - gmax);
        const float ggate = 1.0f / gsum;
        float ev[S::MEG];
        _Pragma("unroll") for (int n = 0; n < S::MEG; ++n) { ev[n] = el[n]; _Pragma("unroll") for (int g2 = 1; g2 < S::MG; ++g2) if (g2 == gsel) ev[n] = el[g2 * S::MEG + n]; }
        int i1 = 0; float v1 = ev[0];
        _Pragma("unroll") for (int n = 1; n < S::MEG; ++n) if (ev[n] > v1) { v1 = ev[n]; i1 = n; }
        int i2 = -1; float v2 = 0.f;
        _Pragma("unroll") for (int n = 0; n < S::MEG; ++n) if (n != i1 && (i2 < 0 || ev[n] > v2)) { v2 = ev[n]; i2 = n; }
        const float e2 = expf(v2 - v1);
        p.TOPE[row * 2] = gsel * S::MEG + i1; p.TOPE[row * 2 + 1] = gsel * S::MEG + i2;
        p.TOPW[row * 2] = ggate / (1.0f + e2); p.TOPW[row * 2 + 1] = ggate * e2 / (1.0f + e2);
    }
}
template <class S> DEVFN void nv_moe_up(const Params& p, int l, long gt, long gs) {
    const long total = (long)S::NTOK * 2 * S::DE;
    for (long i = gt; i < total; i += gs) {
        const int j = (int)(i % S::DE); const long rk = i / S::DE; const long row = rk / 2; const int e = p.TOPE[rk];
        const float* a = p.w1 + ((long)(l * S::NE + e) * S::D) * S::DE + j; const float* b = p.w3 + ((long)(l * S::NE + e) * S::D) * S::DE + j; const bf16* h = p.H + row * S::D;
        float u = 0.f, v = 0.f; for (int k = 0; k < S::D; ++k) { const float hv = bf2f(h[k]); u += hv * a[(long)k * S::DE]; v += hv * b[(long)k * S::DE]; }
        p.HIDN[i] = f2bf(siluf_(u) * v);
    }
}
template <class S> DEVFN void nv_moe_down(const Params& p, int l, long gt, long gs) {
    const long total = (long)S::NTOK * 2 * S::D;
    for (long i = gt; i < total; i += gs) {
        const int col = (int)(i % S::D); const long rk = i / S::D; const int e = p.TOPE[rk];
        const float* w = p.w2 + ((long)(l * S::NE + e) * S::DE) * S::D + col; const bf16* hd = p.HIDN + rk * S::DE;
        float acc = 0.f; for (int j = 0; j < S::DE; ++j) acc += bf2f(hd[j]) * w[(long)j * S::D];
        p.C2[i] = f2bf(acc * p.TOPW[rk]);
    }
}

#define XB_TMO      128
#define XB_XCNT(j)  (256  + 64 * (j))
#define XB_XSUB(j)  (1280 + 64 * (j))
#define XB_XGEN(j)  (2304 + 64 * (j))
#define XB_TOP      3328
#define XB_TOPGEN   3392
#define XCD_BAR_WORDS 3456
#define XB_SPIN_CAP (1u << 18)
#define LAS __attribute__((address_space(3)))

__device__ __forceinline__ unsigned xb_ld(unsigned* p)              { return __hip_atomic_load(p, __ATOMIC_RELAXED, __HIP_MEMORY_SCOPE_AGENT); }
__device__ __forceinline__ unsigned xb_add(unsigned* p, unsigned v) { return __hip_atomic_fetch_add(p, v, __ATOMIC_RELAXED, __HIP_MEMORY_SCOPE_AGENT); }
__device__ __forceinline__ unsigned xb_xcc_id() { return (unsigned)__builtin_amdgcn_s_getreg((3 << 11) | 20) & 0xFu; }
#define XB_SPIN(cond, bar) do { unsigned _sp = 0; while (cond) { __builtin_amdgcn_s_sleep(1); \
    if ((++_sp & 255u) == 0u) { if (xb_ld(&(bar)[XB_TMO])) break; if (_sp > XB_SPIN_CAP) { atomicAdd(&(bar)[XB_TMO], 1u); break; } } } } while (0)

struct XcdBarrier {
    unsigned* bar; unsigned x;
    volatile LAS unsigned* st;
};

__device__ __forceinline__ XcdBarrier xcd_barrier_post(unsigned* bar, volatile LAS unsigned* st) {
    XcdBarrier b; b.bar = bar; b.x = xb_xcc_id(); b.st = st;
    if (threadIdx.x == 0) (void)xb_add(&bar[XB_XCNT(b.x)], 1u);
    return b;
}
__device__ __forceinline__ void xcd_barrier_complete(unsigned* bar, unsigned x, unsigned& nloc, unsigned& nx) {
    const unsigned G = gridDim.x * gridDim.y * gridDim.z;
    unsigned sum, cnt, mine, sp = 0u;
    for (;;) {
        sum = 0u; cnt = 0u; mine = 0u;
#pragma unroll
        for (unsigned j = 0; j < 16; ++j) { const unsigned c = xb_ld(&bar[XB_XCNT(j)]); sum += c; cnt += (c > 0u) ? 1u : 0u; mine = (j == x) ? c : mine; }
        if (sum == G) break;
        __builtin_amdgcn_s_sleep(1);
        if ((++sp & 255u) == 0u) { if (xb_ld(&bar[XB_TMO])) break; if (sp > XB_SPIN_CAP) { atomicAdd(&bar[XB_TMO], 1u); break; } }
    }
    nloc = mine > 0u ? mine : 1u; nx = cnt > 0u ? cnt : 1u;
}

__device__ __forceinline__ void xcd_barrier(const XcdBarrier& b) {
    asm volatile("s_waitcnt vmcnt(0)" ::: "memory");
    __syncthreads();
    if (threadIdx.x == 0) {
        unsigned* bar = b.bar;
        __builtin_amdgcn_s_waitcnt(0);
        unsigned nloc = b.st[0], nx = b.st[1];
        if (nloc == 0u) { xcd_barrier_complete(bar, b.x, nloc, nx); b.st[0] = nloc; b.st[1] = nx; }
        const unsigned old = xb_add(&bar[XB_XSUB(b.x)], 1u);
        const unsigned gen = old / nloc;
        if (old + 1u == (gen + 1u) * nloc) {
            __builtin_amdgcn_fence(__ATOMIC_RELEASE, "agent");
            asm volatile("s_waitcnt vmcnt(0)" ::: "memory");
            const unsigned og = xb_add(&bar[XB_TOP], 1u);
            const unsigned tg = og / nx;
            if (og + 1u == (tg + 1u) * nx) xb_add(&bar[XB_TOPGEN], 1u);
            else XB_SPIN(xb_ld(&bar[XB_TOPGEN]) == tg, bar);
            __builtin_amdgcn_fence(__ATOMIC_ACQUIRE, "agent");
            xb_add(&bar[XB_XGEN(b.x)], 1u);
            asm volatile("s_waitcnt vmcnt(0)" ::: "memory");
        } else {
            XB_SPIN(xb_ld(&bar[XB_XGEN(b.x)]) == gen, bar);
            __builtin_amdgcn_fence(__ATOMIC_ACQUIRE, "agent");
            asm volatile("s_waitcnt vmcnt(0)" ::: "memory");
        }
    }
    __syncthreads();
}


namespace g8 {
#define G8_LAS __attribute__((address_space(3)))
typedef short bf16x8 __attribute__((ext_vector_type(8)));
typedef float f32x4 __attribute__((ext_vector_type(4)));
typedef float f32x2 __attribute__((ext_vector_type(2)));
typedef unsigned u32x4 __attribute__((ext_vector_type(4)));
typedef unsigned u32x2 __attribute__((ext_vector_type(2)));
constexpr int BM = 256, BK = 64, HALF = 128, HTB = HALF * BK * 2  , STAGE_BYTES = 8 * HTB, NXCD = 8, WGM = 8;

__device__ __forceinline__ int lds_byte(int r, int c) { const int st = (r >> 4) * 2 + (c >> 5), rr = r & 15, cc = c & 31, ob = rr * 64 + cc * 2; return st * 1024 + (ob ^ (((ob >> 9) & 1) << 5)); }
__device__ __forceinline__ void stage_rc(int b, int& R, int& C) { const int st = b / 1024, sb = b % 1024, swz = sb ^ (((sb >> 9) & 1) << 5); R = (st >> 1) * 16 + swz / 64; C = (st & 1) * 32 + (swz % 64) / 2; }
__device__ __forceinline__ int perm32(int rho) { const int n = rho >> 4, i = rho & 15; return 8 * (i >> 2) + 4 * n + (i & 3); }
__device__ __forceinline__ unsigned cvt_pk_bf16(float lo, float hi) { unsigned r; asm volatile("v_cvt_pk_bf16_f32 %0, %1, %2" : "=v"(r) : "v"(lo), "v"(hi)); return r; }

struct Unit { int pm, pn, e, t; };

__device__ __forceinline__ void tile_of(int wgid, int nM, int nN, int& pm, int& pn) {
    const int nwg = nM * nN; { const int q = nwg / NXCD, r = nwg % NXCD, xcd = wgid % NXCD, off = wgid / NXCD; wgid = (xcd < r ? xcd * (q + 1) : r * (q + 1) + (xcd - r) * q) + off; }
    const int nig = WGM * nN, gid = wgid / nig, fm = gid * WGM, gsz = (nM - fm) < WGM ? (nM - fm) : WGM;
    pm = fm + ((wgid % nig) % gsz); pn = (wgid % nig) / gsz;
}
struct DenseSched {
    const bf16* A; const bf16* Bt; int K, lda, ldb, nM, nN, G, c;
    static constexpr bool GATHER = false;
    __device__ __forceinline__ bool next(int i, Unit& u) const { const long L = (long)i * G + c; if (L >= (long)nM * nN) return false; tile_of((int)L, nM, nN, u.pm, u.pn); u.e = 0; u.t = 0; return true; }
    __device__ __forceinline__ const char* abase(const Unit& u) const { return (const char*)(A + (size_t)u.pm * BM * lda); }
    __device__ __forceinline__ const char* bbase(const Unit& u) const { return (const char*)(Bt + (size_t)u.pn * BM * ldb); }
    __device__ __forceinline__ unsigned arow(const Unit&, int r) const { return (unsigned)r * (unsigned)lda * 2u; }
};

template <class Epi, class Sched>
__device__ __forceinline__ void gemm_run(G8_LAS unsigned char* lds, const Sched& S, const Epi& E) {
    int tid = threadIdx.x; asm volatile("" : "+v"(tid));
    const int wid = __builtin_amdgcn_readfirstlane(tid >> 6), lane = tid & 63, wr = wid >> 2, wc = wid & 3, fr = lane & 15, fq = lane >> 4;
    const int K = S.K, nt = K / BK;
    int sR[2], sC[2]; unsigned voffB[2];
#pragma unroll
    for (int i = 0; i < 2; ++i) { int R, C; stage_rc(tid * 16 + i * 8192, R, C); sR[i] = R; sC[i] = C; const int Rb = Epi::PERM ? ((R & ~31) + perm32(R & 31)) : R;
        voffB[i] = (unsigned)(Rb * S.ldb + C) * 2u; }
    const size_t kstep = (size_t)(BK * 2);
    const size_t hstepB = (size_t)HALF * S.ldb * 2;
    const unsigned ldsw = (unsigned)wid * 1024u;
    const int aoff = lds_byte(wr * 64 + fr, fq * 8), boff = lds_byte(wc * 32 + fr, fq * 8);
#define G8_SA(b, h) (((b) * 2 + (h)) * HTB)
#define G8_SB(b, h) ((4 + (b) * 2 + (h)) * HTB)
#define G8_STAGE(bufoff, gbase, voff) do { _Pragma("unroll") for (int _i = 0; _i < 2; ++_i) \
        __builtin_amdgcn_global_load_lds((const unsigned*)((const char*)(gbase) + (voff)[_i]), (G8_LAS unsigned*)(lds + (bufoff) + ldsw + _i * 8192), 16, 0, 0); } while (0)
#define G8_LDA(dst, b, h) do { _Pragma("unroll") for (int m = 0; m < 4; ++m) _Pragma("unroll") for (int k = 0; k < 2; ++k) dst[m][k] = *(const G8_LAS bf16x8*)(lds + G8_SA(b, h) + aoff + m * 2048 + k * 1024); } while (0)
#define G8_LDB(dst, b, h) do { _Pragma("unroll") for (int n = 0; n < 2; ++n) _Pragma("unroll") for (int k = 0; k < 2; ++k) dst[n][k] = *(const G8_LAS bf16x8*)(lds + G8_SB(b, h) + boff + n * 2048 + k * 1024); } while (0)
#define G8_MMA(ai, bj, At, Bt) do { __builtin_amdgcn_s_setprio(1); _Pragma("unroll") for (int m = 0; m < 4; ++m) _Pragma("unroll") for (int n = 0; n < 2; ++n) _Pragma("unroll") for (int k = 0; k < 2; ++k) \
        acc[ai][bj][m][n] = __builtin_amdgcn_mfma_f32_16x16x32_bf16(Bt[n][k], At[m][k], acc[ai][bj][m][n], 0, 0, 0); __builtin_amdgcn_s_setprio(0); } while (0)
#define G8_WAIT_V(n) asm volatile("s_waitcnt vmcnt(" #n ")" ::: "memory")
#define G8_WAIT_L(n) asm volatile("s_waitcnt lgkmcnt(" #n ")" ::: "memory")
#define G8_BAR __builtin_amdgcn_s_barrier()
#define G8_SCHED __builtin_amdgcn_sched_barrier(0)
#define G8_AOFFS(dst, u) do { _Pragma("unroll") for (int _h = 0; _h < 2; ++_h) _Pragma("unroll") for (int _i = 0; _i < 2; ++_i) dst[_h][_i] = S.arow(u, _h * HALF + sR[_i]) + (unsigned)sC[_i] * 2u; } while (0)
    Unit cur, nxt; int ui = 0;
    if (!S.next(0, cur)) return;
    f32x4 acc[2][2][4][2];
#pragma unroll
    for (int a = 0; a < 2; ++a)
#pragma unroll
        for (int b = 0; b < 2; ++b)
#pragma unroll
            for (int m = 0; m < 4; ++m)
#pragma unroll
                for (int n = 0; n < 2; ++n) acc[a][b][m][n] = (f32x4){0.f, 0.f, 0.f, 0.f};
    bf16x8 At[4][2], B0[2][2], B1[2][2];
    unsigned ao[2][2], no[2][2];
    const char* cA = S.abase(cur); const char* cB = S.bbase(cur);
    G8_AOFFS(ao, cur);
    G8_STAGE(G8_SB(0, 0), cB, voffB); G8_STAGE(G8_SB(0, 1), cB + hstepB, voffB); G8_STAGE(G8_SA(0, 0), cA, ao[0]); G8_STAGE(G8_SA(0, 1), cA, ao[1]);
    if (wr == 1) G8_BAR;
    G8_WAIT_V(2); G8_BAR;
    G8_STAGE(G8_SB(1, 0), cB + kstep, voffB); G8_STAGE(G8_SA(1, 0), cA + kstep, ao[0]); G8_STAGE(G8_SB(1, 1), cB + hstepB + kstep, voffB);
    G8_WAIT_V(6); G8_BAR;
    for (;;) {
        const bool has_next = S.next(ui + 1, nxt);
        const char* nA = has_next ? S.abase(nxt) : cA; const char* nB = has_next ? S.bbase(nxt) : cB;
        if (has_next) { G8_AOFFS(no, nxt); } else {
#pragma unroll
            for (int h = 0; h < 2; ++h)
#pragma unroll
                for (int i = 0; i < 2; ++i) no[h][i] = ao[h][i]; }
        for (int t = 0; t < nt; t += 2) {
            const bool last = (t == nt - 2);
            const char* a1 = cA + (size_t)(t + 1) * kstep;
            const char* a2 = last ? nA : cA + (size_t)(t + 2) * kstep; const char* b2 = last ? nB : cB + (size_t)(t + 2) * kstep;
            const char* a3 = a2 + kstep; const char* b3 = b2 + kstep;
            unsigned o2[2][2];
#pragma unroll
            for (int h = 0; h < 2; ++h)
#pragma unroll
                for (int i = 0; i < 2; ++i) o2[h][i] = last ? no[h][i] : ao[h][i];
            G8_LDB(B0, 0, 0); G8_LDB(B1, 0, 1); G8_SCHED; G8_LDA(At, 0, 0); G8_STAGE(G8_SA(1, 1), a1, ao[1]);
            G8_WAIT_V(8); G8_WAIT_L(0); G8_BAR; G8_MMA(0, 0, At, B0); G8_MMA(0, 1, At, B1); G8_BAR; G8_SCHED;
            G8_LDA(At, 0, 1); G8_STAGE(G8_SB(0, 0), b2, voffB); G8_STAGE(G8_SB(0, 1), b2 + hstepB, voffB); G8_STAGE(G8_SA(0, 0), a2, o2[0]);
            G8_WAIT_V(8); G8_WAIT_L(0); G8_BAR; G8_MMA(1, 0, At, B0); G8_MMA(1, 1, At, B1); G8_BAR; G8_SCHED;
            G8_LDB(B0, 1, 0); G8_LDB(B1, 1, 1); G8_SCHED; G8_LDA(At, 1, 0); G8_STAGE(G8_SA(0, 1), a2, o2[1]);
            G8_WAIT_V(8); G8_WAIT_L(0); G8_BAR; G8_MMA(0, 0, At, B0); G8_MMA(0, 1, At, B1); G8_BAR; G8_SCHED;
            G8_LDA(At, 1, 1); G8_STAGE(G8_SB(1, 0), b3, voffB); G8_STAGE(G8_SB(1, 1), b3 + hstepB, voffB); G8_STAGE(G8_SA(1, 0), a3, o2[0]);
            G8_WAIT_V(8); G8_WAIT_L(0); G8_BAR; G8_MMA(1, 0, At, B0); G8_MMA(1, 1, At, B1); G8_BAR; G8_SCHED;
        }
        if (wr == 0) G8_BAR;
        E(acc, cur, wr, wc, fr, fq);
        if (!has_next) break;
#pragma unroll
        for (int a = 0; a < 2; ++a)
#pragma unroll
            for (int b = 0; b < 2; ++b)
#pragma unroll
                for (int m = 0; m < 4; ++m)
#pragma unroll
                    for (int n = 0; n < 2; ++n) acc[a][b][m][n] = (f32x4){0.f, 0.f, 0.f, 0.f};
        cur = nxt; cA = nA; cB = nB; ++ui;
#pragma unroll
        for (int h = 0; h < 2; ++h)
#pragma unroll
            for (int i = 0; i < 2; ++i) ao[h][i] = no[h][i];
        if (wr == 1) G8_BAR;
    }
    G8_WAIT_V(0);
    G8_BAR;
#undef G8_SA
#undef G8_SB
#undef G8_STAGE
#undef G8_LDA
#undef G8_LDB
#undef G8_MMA
#undef G8_WAIT_V
#undef G8_WAIT_L
#undef G8_BAR
#undef G8_SCHED
#undef G8_AOFFS
}
}

typedef Sh<CfgFull> SF;
#define GAS __attribute__((address_space(1)))
using g8::f32x4; using g8::f32x2; using g8::u32x4; using g8::u32x2; using g8::Unit;
constexpr int NTHREADS = 512, NWAVES = 8;
__device__ __forceinline__ int fresh_tid() { int t = threadIdx.x; asm volatile("" : "+v"(t)); return t; }
__device__ __forceinline__ int fresh_bid() { int b = blockIdx.x; asm volatile("" : "+s"(b)); return b; }
__device__ __forceinline__ long fresh_gt() { return (long)fresh_bid() * NTHREADS + fresh_tid(); }
constexpr int LDS_BYTES = 136 * 1024;
constexpr int LDS_BARW = LDS_BYTES - 16;
constexpr int CW_CNT = 4096;
constexpr int HID_ROWS = 2 * SF::NTOK + SF::NE * 256;

struct WSet { bf16 *WIN_T, *WF_T, *WP_T, *WOUT_T, *WUP_T, *WDN_T; };
struct FParams {
    WSet W[2];
    float* MSCR;
    int* LIST; float* WL;
    bf16* HID;
};
__device__ __forceinline__ WSet wsel(const FParams& f, int par) {
    WSet w = f.W[0]; const WSet& o = f.W[1];
    if (par & 1) { w.WIN_T = o.WIN_T; w.WF_T = o.WF_T; w.WP_T = o.WP_T; w.WOUT_T = o.WOUT_T; w.WUP_T = o.WUP_T; w.WDN_T = o.WDN_T; }
    return w; }
constexpr int WF_ROWS = SF::FG * SF::FGW;
constexpr int WIN_ROWS = SF::PCOLS + 2 * SF::QKW;

__device__ __forceinline__ unsigned pk2(float lo, float hi) { return g8::cvt_pk_bf16(lo, hi); }
__device__ __forceinline__ float bflo(unsigned w) { return __uint_as_float(w << 16); }
__device__ __forceinline__ float bfhi(unsigned w) { return __uint_as_float(w & 0xffff0000u); }
__device__ __forceinline__ float fast_sigmoid(float x) { return __builtin_amdgcn_rcpf(1.0f + __expf(-x)); }
__device__ __forceinline__ float fast_silu(float x) { return x * __builtin_amdgcn_rcpf(1.0f + __expf(-x)); }
__device__ __forceinline__ float fast_logsigmoid(float x) { return fminf(x, 0.0f) - __logf(1.0f + __expf(-fabsf(x))); }

__device__ __forceinline__ void cvt_item(const float* W, int ldw, int src_col0, bool perm, bf16* WT, int ldt, int dst_row0, int k0, LAS float* scr, int lane) {
    const int j = lane & 31; const int sc = src_col0 + (perm ? ((j & 1) ? (j >> 1) + 16 : (j >> 1)) : j);
#pragma unroll 8
    for (int i = 0; i < 32; ++i) { const int kk = 2 * i + (lane >> 5); scr[kk * 33 + j] = W[(size_t)(k0 + kk) * ldw + sc]; }
    asm volatile("s_waitcnt lgkmcnt(0)" ::: "memory");
    const int c = lane & 7;
#pragma unroll
    for (int jj = 0; jj < 4; ++jj) { const int n = (lane >> 3) + 8 * jj; const LAS float* s = scr + (8 * c) * 33 + n;
        u32x4 o; o.x = pk2(s[0 * 33], s[1 * 33]); o.y = pk2(s[2 * 33], s[3 * 33]); o.z = pk2(s[4 * 33], s[5 * 33]); o.w = pk2(s[6 * 33], s[7 * 33]);
        *(GAS u32x4*)(WT + (size_t)(dst_row0 + n) * ldt + k0 + 8 * c) = o; }
    asm volatile("s_waitcnt lgkmcnt(0)" ::: "memory");
}
constexpr int CV_I_IN = (SF::PCOLS / 32) * (SF::D / 64), CV_I_P = (SF::D / 32) * (SF::VW / 64), CV_I_O = (SF::D / 32) * (SF::D / 64);
constexpr int CV_I_UP = SF::NE * 2 * (SF::DE / 32) * (SF::D / 64), CV_I_DN = SF::NE * (SF::D / 32) * (SF::DE / 64);
constexpr int CV_NITEMS = CV_I_IN + 3 * CV_I_P + CV_I_O + CV_I_UP + CV_I_DN;
constexpr int CV_ITEMT = (CV_NITEMS + 63) / 64, CV_DEC = 32, CV_FOU = SF::FG * (SF::D / 32), CV_TASKS = CV_ITEMT + CV_DEC + CV_FOU;
__device__ __forceinline__ void convert_task(const Params& p, const WSet& W, int l, int task, LAS unsigned char* lds, int lds_off) {
    const int tid = fresh_tid(), lane = tid & 63, wave = tid >> 6;
    constexpr int D = SF::D;
    if (task < CV_ITEMT) {
        LAS float* scr = (LAS float*)(lds + lds_off + wave * 8704);
        for (int q = 0; q < 8; ++q) {
            int r = task * 64 + q * 8 + wave; if (r >= CV_NITEMS) break;
            if (r < CV_I_IN) { const int nb = r / (D / 64), kb = r % (D / 64); const int pc = 32 * nb;
                int lc; bool perm = false;
                if (pc < SF::P_QC) { lc = pc; perm = (pc >= SF::P_KC && pc < SF::P_VC); }
                else if (pc < SF::P_G) { lc = pc - SF::P_QC + SF::L_QC; perm = true; }
                else lc = pc - SF::P_G + SF::L_G;
                cvt_item(p.w_in + (size_t)l * D * SF::INCOLS, SF::INCOLS, lc, perm, W.WIN_T, D, pc, 64 * kb, scr, lane); continue; }
            r -= CV_I_IN;
            if (r < 3 * CV_I_P) { const int which = r / CV_I_P; r %= CV_I_P; const int nb = r / (SF::VW / 64), kb = r % (SF::VW / 64);
                const float* src = p.w_pa; if (which == 1) src = p.w_pb; if (which == 2) src = p.w_pc; src += (size_t)l * SF::VW * D; bf16* dst = W.WP_T + (size_t)which * D * SF::VW;
                cvt_item(src, D, 32 * nb, false, dst, SF::VW, 32 * nb, 64 * kb, scr, lane); continue; }
            r -= 3 * CV_I_P;
            if (r < CV_I_O) { const int nb = r / (D / 64), kb = r % (D / 64);
                cvt_item(p.w_out + (size_t)l * D * D, D, 32 * nb, false, W.WOUT_T, D, 32 * nb, 64 * kb, scr, lane); continue; }
            r -= CV_I_O;
            if (r < CV_I_UP) { const int kb = r % (D / 64); r /= (D / 64); const int nb = r % (SF::DE / 32); r /= (SF::DE / 32); const int half = r % 2, e = r / 2;
                const float* src = p.w1; if (half == 1) src = p.w3; src += ((size_t)(l * SF::NE + e) * D) * SF::DE; const int n0 = 32 * nb;
                cvt_item(src, SF::DE, n0, false, W.WUP_T + (size_t)e * 2 * SF::DE * D, D, (n0 / 128) * 256 + half * 128 + (n0 % 128), 64 * kb, scr, lane); continue; }
            r -= CV_I_UP;
            { const int kb = r % (SF::DE / 64); r /= (SF::DE / 64); const int nb = r % (D / 32), e = r / (D / 32);
                cvt_item(p.w2 + ((size_t)(l * SF::NE + e) * SF::DE) * D, D, 32 * nb, false, W.WDN_T + (size_t)e * D * SF::DE, SF::DE, 32 * nb, 64 * kb, scr, lane); }
        }
    } else if (task < CV_ITEMT + CV_DEC) {
        constexpr int PER = 2 * SF::QKW * D / CV_DEC; const int base = (task - CV_ITEMT) * PER;
        for (int i = base + tid; i < base + PER; i += NTHREADS) { const int k = i % D, n = (i / D) % SF::QKW, dir = i / (D * SF::QKW);
            const float* a = p.w_dd + ((size_t)(l * 2 + dir) * D + k) * SF::RANK; const float* b = p.w_du + ((size_t)(l * 2 + dir) * SF::RANK) * SF::QKW + n;
            float acc = 0.f;
#pragma unroll
            for (int r = 0; r < SF::RANK; ++r) acc += a[r] * b[(size_t)r * SF::QKW];
            W.WIN_T[(size_t)(SF::PCOLS + dir * SF::QKW + n) * D + k] = f2bf(acc); }
    } else {
        const int tq = task - CV_ITEMT - CV_DEC, g = tq / (D / 32), k0 = (tq % (D / 32)) * 32; const float sc = 1.0f / sqrtf((float)SF::FGW);
        LAS float* wl = (LAS float*)(lds + lds_off); LAS float* tb = wl + 32 * SF::FGW;
        __syncthreads();
        for (int i = tid; i < 32 * SF::FGW; i += NTHREADS) wl[i] = p.w_in[(size_t)l * D * SF::INCOLS + (size_t)(k0 + i / SF::FGW) * SF::INCOLS + SF::L_UB + g * SF::FGW + (i % SF::FGW)];
        for (int i = tid; i < 2 * SF::FGW; i += NTHREADS) tb[i] = p.TABC[i];
        __syncthreads();
        for (int i = tid; i < SF::FGW * 32; i += NTHREADS) { const int kk = i & 31, r = i >> 5; const int pq = r > SF::FGW / 2 ? 1 : 0, cp = pq ? r - SF::FGW / 2 : r; float acc = 0.f;
#pragma unroll 8
            for (int c = 0; c < SF::FGW; ++c) acc += wl[kk * SF::FGW + c] * tb[2 * ((c * cp) & (SF::FGW - 1)) + pq];
            W.WF_T[(size_t)(g * SF::FGW + r) * D + k0 + kk] = f2bf(acc * sc); }
        __syncthreads();
    }
}
__device__ __forceinline__ void f_convert_all(const Params& p, const WSet& W, int l, LAS unsigned char* lds) {
    for (int t = fresh_bid(); t < CV_TASKS; t += gridDim.x) convert_task(p, W, l, t, lds, 0);
}
struct EpiInproj {
    static constexpr bool PERM = true;
    bf16* PROJ; float* LA; const float* bdec; const float* ROPE;
    __device__ __forceinline__ void operator()(const f32x4 (&acc)[2][2][4][2], const Unit& u, int wr, int wc, int fr, int fq) const {
        const int tile = u.pn; const int row0 = u.pm * 256 + wr * 64 + fr; const int cw = wc * 32 + 8 * fq;
        constexpr int T_DEC = SF::PCOLS / 256;
        if (tile >= T_DEC) {
#pragma unroll
            for (int bj = 0; bj < 2; ++bj) { const int col = (tile - T_DEC) * 256 + bj * 128 + cw;
                const f32x4 b0 = *(const f32x4*)(bdec + col), b1 = *(const f32x4*)(bdec + col + 4);
#pragma unroll
                for (int ai = 0; ai < 2; ++ai)
#pragma unroll
                    for (int m = 0; m < 4; ++m) { const int row = row0 + ai * 128 + m * 16; f32x4 v0 = acc[ai][bj][m][0] + b0, v1 = acc[ai][bj][m][1] + b1;
#pragma unroll
                        for (int j = 0; j < 4; ++j) { v0[j] = fast_logsigmoid(v0[j]) * 0.0625f; v1[j] = fast_logsigmoid(v1[j]) * 0.0625f; }
                        float* d = LA + (size_t)row * (2 * SF::QKW) + col; *(f32x4*)d = v0; *(f32x4*)(d + 4) = v1; } }
            return;
        }
        const bool latent = u.pm < SF::NLAT / 256;
#pragma unroll
        for (int bj = 0; bj < 2; ++bj) {
            const int colt = tile * 256 + bj * 128;
            int mode = 0;
            if (colt >= SF::P_KC && colt < SF::P_VC) mode = latent ? 1 : 0;
            else if (colt >= SF::P_QA && colt < SF::P_RA) mode = 2;
            else if (colt >= SF::P_QC && colt < SF::P_G) mode = latent ? 1 : 0;
            else if (colt >= SF::P_G) mode = 3;
#pragma unroll
            for (int ai = 0; ai < 2; ++ai)
#pragma unroll
                for (int m = 0; m < 4; ++m) { const int row = row0 + ai * 128 + m * 16; f32x4 v0 = acc[ai][bj][m][0], v1 = acc[ai][bj][m][1];
                    if (mode == 1) { const int s = row & (SF::SEQ - 1); const int pos = (wc & 1) ? (s & (SF::GW - 1)) : (s / SF::GW);
                        const float* rp = ROPE + (size_t)(pos * SF::NFREQ + 4 * fq) * 2; const f32x4 r0 = *(const f32x4*)rp, r1 = *(const f32x4*)(rp + 4);
                        v0 = (f32x4){v0[0] * r0[0] - v0[1] * r0[1], v0[0] * r0[1] + v0[1] * r0[0], v0[2] * r0[2] - v0[3] * r0[3], v0[2] * r0[3] + v0[3] * r0[2]};
                        v1 = (f32x4){v1[0] * r1[0] - v1[1] * r1[1], v1[0] * r1[1] + v1[1] * r1[0], v1[2] * r1[2] - v1[3] * r1[3], v1[2] * r1[3] + v1[3] * r1[2]}; }
                    else if (mode == 2) { v0 = v0 * 0.125f; v1 = v1 * 0.125f; }
                    else if (mode == 3) {
#pragma unroll
                        for (int j = 0; j < 4; ++j) { v0[j] = fast_sigmoid(v0[j]); v1[j] = fast_sigmoid(v1[j]); } }
                    u32x4 w; w.x = pk2(v0[0], v0[1]); w.y = pk2(v0[2], v0[3]); w.z = pk2(v1[0], v1[1]); w.w = pk2(v1[2], v1[3]);
                    *(u32x4*)(PROJ + (size_t)row * SF::PCOLS + colt + cw) = w; }
        }
    }
};
struct EpiFourT {
    static constexpr bool PERM = true;
    bf16* PQT;
    __device__ __forceinline__ void operator()(const f32x4 (&acc)[2][2][4][2], const Unit& u, int wr, int wc, int fr, int fq) const {
        const bool latent = u.pn < SF::NLAT / 256; const int b = latent ? u.pn / (SF::SEQ / 256) : u.pn - SF::NLAT / 256;
        const int L = latent ? SF::SEQ : SF::CTX; bf16* base = PQT + (latent ? (size_t)0 : (size_t)SF::B * SF::FG * SF::FGW * SF::SEQ); const int t0 = latent ? (u.pn % (SF::SEQ / 256)) * 256 : 0;
#pragma unroll
        for (int ai = 0; ai < 2; ++ai) { const int g = 2 * u.pm + ai;
#pragma unroll
            for (int m = 0; m < 4; ++m) { const int r = wr * 64 + m * 16 + fr;
                bf16* rowp = base + ((size_t)(b * SF::FG + g) * SF::FGW + r) * L + t0 + wc * 32 + 8 * fq;
#pragma unroll
                for (int bj = 0; bj < 2; ++bj) { const f32x4 v0 = acc[ai][bj][m][0], v1 = acc[ai][bj][m][1];
                    u32x4 w; w.x = pk2(v0[0], v0[1]); w.y = pk2(v0[2], v0[3]); w.z = pk2(v1[0], v1[1]); w.w = pk2(v1[2], v1[3]);
                    *(u32x4*)(rowp + bj * 128) = w; } } }
    }
};
struct InprojSched {
    const bf16* H; const bf16* WIN; const bf16* WF; int K, lda, ldb, G, c;
    static constexpr bool GATHER = false;
    static constexpr int nM1 = SF::NTOK / 256, nN1 = WIN_ROWS / 256, NU1 = nM1 * nN1, nM2 = WF_ROWS / 256, nN2 = SF::NTOK / 256, NU2 = nM2 * nN2;
    __device__ __forceinline__ bool next(int i, Unit& u) const { const long L = (long)i * G + c; if (L >= NU1 + NU2) return false;
        if (L < NU1) { g8::tile_of((int)L, nM1, nN1, u.pm, u.pn); u.e = 0; } else { g8::tile_of((int)L - NU1, nM2, nN2, u.pm, u.pn); u.e = 1; } u.t = 0; return true; }
    __device__ __forceinline__ const char* abase(const Unit& u) const { const bf16* a = H; if (u.e) a = WF; return (const char*)(a + (size_t)u.pm * 256 * lda); }
    __device__ __forceinline__ const char* bbase(const Unit& u) const { const bf16* b = WIN; if (u.e) b = H; return (const char*)(b + (size_t)u.pn * 256 * ldb); }
    __device__ __forceinline__ unsigned arow(const Unit&, int r) const { return (unsigned)r * (unsigned)lda * 2u; }
};
struct EpiInprojAll {
    static constexpr bool PERM = true;
    EpiInproj e1; EpiFourT e2;
    __device__ __forceinline__ void operator()(const f32x4 (&acc)[2][2][4][2], const Unit& u, int wr, int wc, int fr, int fq) const { if (u.e == 0) e1(acc, u, wr, wc, fr, fq); else e2(acc, u, wr, wc, fr, fq); }
};
struct MergeSched {
    const bf16* Y; const bf16* WP; int K, lda, ldb, nM, nN, G, c;
    static constexpr bool GATHER = false;
    __device__ __forceinline__ bool next(int i, Unit& u) const { const int ti = i / 3; const long L = (long)ti * G + c; if (L >= (long)nM * nN) return false; g8::tile_of((int)L, nM, nN, u.pm, u.pn); u.e = i % 3; u.t = 0; return true; }
    __device__ __forceinline__ const char* abase(const Unit& u) const { return (const char*)(Y + (size_t)u.pm * 256 * lda + u.e * SF::VW); }
    __device__ __forceinline__ const char* bbase(const Unit& u) const { return (const char*)(WP + (size_t)u.e * SF::D * SF::VW + (size_t)u.pn * 256 * ldb); }
    __device__ __forceinline__ unsigned arow(const Unit&, int r) const { return (unsigned)r * (unsigned)lda * 2u; }
};
struct EpiMerge {
    static constexpr bool PERM = true;
    const bf16* PROJ; bf16* MERGED; float* scr;
    __device__ __forceinline__ void operator()(const f32x4 (&acc)[2][2][4][2], const Unit& u, int wr, int wc, int fr, int fq) const {
        const int br = u.e; const int row0 = u.pm * 256 + wr * 64 + fr; const int col0 = u.pn * 256 + wc * 32 + 8 * fq;
        u32x4* sp = (u32x4*)scr + fresh_tid();
        if (br != 0) asm volatile("s_waitcnt vmcnt(0)" ::: "memory");
#pragma unroll
        for (int ai = 0; ai < 2; ++ai)
#pragma unroll
            for (int mp = 0; mp < 2; ++mp) {
                u32x4 gw[2][2], sw[2][2];
#pragma unroll
                for (int mm = 0; mm < 2; ++mm)
#pragma unroll
                    for (int bj = 0; bj < 2; ++bj) { const int m = 2 * mp + mm; const int row = row0 + ai * 128 + m * 16;
                        gw[mm][bj] = *(const u32x4*)(PROJ + (size_t)row * SF::PCOLS + SF::P_G + br * SF::D + col0 + bj * 128);
                        if (br != 0) sw[mm][bj] = sp[(size_t)(((ai * 4 + m) * 2 + bj)) * NTHREADS]; }
#pragma unroll
                for (int mm = 0; mm < 2; ++mm)
#pragma unroll
                    for (int bj = 0; bj < 2; ++bj) { const int m = 2 * mp + mm; const int row = row0 + ai * 128 + m * 16; const u32x4 g = gw[mm][bj];
                        f32x4 v0 = acc[ai][bj][m][0] * (f32x4){bflo(g.x), bfhi(g.x), bflo(g.y), bfhi(g.y)}, v1 = acc[ai][bj][m][1] * (f32x4){bflo(g.z), bfhi(g.z), bflo(g.w), bfhi(g.w)};
                        if (br != 0) { const u32x4 s = sw[mm][bj]; v0 = v0 + (f32x4){bflo(s.x), bfhi(s.x), bflo(s.y), bfhi(s.y)}; v1 = v1 + (f32x4){bflo(s.z), bfhi(s.z), bflo(s.w), bfhi(s.w)}; }
                        u32x4 w; w.x = pk2(v0[0], v0[1]); w.y = pk2(v0[2], v0[3]); w.z = pk2(v1[0], v1[1]); w.w = pk2(v1[2], v1[3]);
                        if (br != 2) sp[(size_t)(((ai * 4 + m) * 2 + bj)) * NTHREADS] = w;
                        else *(u32x4*)(MERGED + (size_t)row * SF::D + col0 + bj * 128) = w; }
                asm volatile("" ::: "memory"); }
    }
};
struct EpiOut {
    static constexpr bool PERM = false;
    float* X; const float* mods_l;
    __device__ __forceinline__ void operator()(const f32x4 (&acc)[2][2][4][2], const Unit& u, int wr, int wc, int fr, int fq) const {
        const int mr = u.pm < SF::NLAT / 256 ? u.pm / (SF::SEQ / 256) : SF::B; const float* g1 = mods_l + (size_t)mr * SF::NMOD + 2 * SF::D;
        const int row0 = u.pm * 256 + wr * 64 + fr, col0 = u.pn * 256 + wc * 32 + 4 * fq;
        f32x4 gv[2][2];
#pragma unroll
        for (int bj = 0; bj < 2; ++bj)
#pragma unroll
            for (int n = 0; n < 2; ++n) gv[bj][n] = *(const f32x4*)(g1 + col0 + bj * 128 + n * 16);
#pragma unroll
        for (int ai = 0; ai < 2; ++ai)
#pragma unroll
            for (int m = 0; m < 4; ++m) { float* rowp = X + (size_t)(row0 + ai * 128 + m * 16) * SF::D + col0;
#pragma unroll
                for (int bj = 0; bj < 2; ++bj)
#pragma unroll
                    for (int n = 0; n < 2; ++n) { f32x4* d = (f32x4*)(rowp + bj * 128 + n * 16); *d = *d + gv[bj][n] * acc[ai][bj][m][n]; } }
    }
};
struct MoeSched {
    const bf16* A; const bf16* Bt; const int* cnt; const int* list; int K, lda, ldb, G, c; bool up;
    static constexpr bool GATHER = true;
    __device__ __forceinline__ bool next(int i, Unit& u) const {
        const long L = (long)i * G + c; const int q = (int)(L >> 2); u.pn = (int)(L & 3); int tb = 0; bool found = false; u.e = 0; u.t = 0; u.pm = 0;
        for (int e = 0; e < SF::NE; ++e) { const int ntl = (cnt[e] + 255) >> 8; if (!found && q < tb + ntl) { u.e = e; u.t = q - tb; u.pm = q; found = true; } tb += ntl; }
        return found;
    }
    __device__ __forceinline__ const char* abase(const Unit& u) const { return up ? (const char*)A : (const char*)(A + (size_t)u.pm * 256 * lda); }
    __device__ __forceinline__ const char* bbase(const Unit& u) const { return (const char*)(Bt + ((size_t)u.e * 1024 + (size_t)u.pn * 256) * ldb); }
    __device__ __forceinline__ unsigned arow(const Unit& u, int r) const {
        if (!up) return (unsigned)r * (unsigned)lda * 2u;
        const int slot = u.t * 256 + r; const int tok = slot < cnt[u.e] ? (list[(size_t)u.e * SF::NTOK + slot] >> 1) : 0; return (unsigned)tok * (unsigned)lda * 2u; }
};
struct EpiMoeUp {
    static constexpr bool PERM = true;
    bf16* HID;
    __device__ __forceinline__ void operator()(const f32x4 (&acc)[2][2][4][2], const Unit& u, int wr, int wc, int fr, int fq) const {
        const int row0 = u.pm * 256 + wr * 64 + fr, col0 = u.pn * 128 + wc * 32 + 8 * fq;
#pragma unroll
        for (int ai = 0; ai < 2; ++ai)
#pragma unroll
            for (int m = 0; m < 4; ++m) { f32x4 a0 = acc[ai][0][m][0], a1 = acc[ai][0][m][1]; const f32x4 b0 = acc[ai][1][m][0], b1 = acc[ai][1][m][1];
#pragma unroll
                for (int j = 0; j < 4; ++j) { a0[j] = fast_silu(a0[j]) * b0[j]; a1[j] = fast_silu(a1[j]) * b1[j]; }
                u32x4 w; w.x = pk2(a0[0], a0[1]); w.y = pk2(a0[2], a0[3]); w.z = pk2(a1[0], a1[1]); w.w = pk2(a1[2], a1[3]);
                *(u32x4*)(HID + (size_t)(row0 + ai * 128 + m * 16) * SF::DE + col0) = w; }
    }
};
struct EpiMoeDown {
    static constexpr bool PERM = true;
    bf16* C2; const int* cnt; const int* list; const float* wl;
    __device__ __forceinline__ void operator()(const f32x4 (&acc)[2][2][4][2], const Unit& u, int wr, int wc, int fr, int fq) const {
        const int n_e = cnt[u.e]; const int col0 = u.pn * 256 + wc * 32 + 8 * fq;
#pragma unroll
        for (int ai = 0; ai < 2; ++ai)
#pragma unroll
            for (int m = 0; m < 4; ++m) { const int slot = u.t * 256 + ai * 128 + wr * 64 + m * 16 + fr;
                if (slot < n_e) { const int tk = list[(size_t)u.e * SF::NTOK + slot]; const float w8 = wl[(size_t)u.e * SF::NTOK + slot];
#pragma unroll
                    for (int bj = 0; bj < 2; ++bj) { const f32x4 v0 = acc[ai][bj][m][0] * w8, v1 = acc[ai][bj][m][1] * w8;
                        u32x4 w; w.x = pk2(v0[0], v0[1]); w.y = pk2(v0[2], v0[3]); w.z = pk2(v1[0], v1[1]); w.w = pk2(v1[2], v1[3]);
                        *(u32x4*)(C2 + (size_t)tk * SF::D + col0 + bj * 128) = w; } } }
    }
};

__device__ __forceinline__ void f_inproj(const Params& p, const FParams& f, int l, LAS unsigned char* lds) {
    const WSet W = wsel(f, l);
    InprojSched S{p.H, W.WIN_T, W.WF_T, SF::D, SF::D, SF::D, (int)gridDim.x, fresh_bid()};
    EpiInprojAll E{EpiInproj{p.PROJ, p.LA, p.b_dec + (size_t)l * 2 * SF::QKW, p.ROPE}, EpiFourT{p.PQT}};
    g8::gemm_run(lds, S, E);
}
__device__ __forceinline__ void f_merge(const Params& p, const FParams& f, int l, LAS unsigned char* lds) {
    MergeSched S{p.Y, wsel(f, l).WP_T, SF::VW, SF::YCOLS, SF::VW, SF::NTOK / 256, SF::D / 256, (int)gridDim.x, fresh_bid()};
    EpiMerge E{p.PROJ, p.MERGED, f.MSCR + (size_t)fresh_bid() * 16 * NTHREADS * 4};
    g8::gemm_run(lds, S, E);
}
__device__ __forceinline__ void f_out(const Params& p, const FParams& f, int l, LAS unsigned char* lds, float* Xdst = nullptr) {
    g8::DenseSched S{p.MERGED, wsel(f, l).WOUT_T, SF::D, SF::D, SF::D, SF::NTOK / 256, SF::D / 256, (int)gridDim.x, fresh_bid()};
    EpiOut E{Xdst ? Xdst : p.X, p.MODS + (size_t)l * (SF::B + 1) * SF::NMOD};
    g8::gemm_run(lds, S, E);
}
__device__ __forceinline__ void f_norm2(const Params& p, const FParams& f, int l) {
    const long gt = fresh_gt(), gs = (long)gridDim.x * NTHREADS;
    nv_norm2<SF>(p, l, gt, gs);
    int* cnt = (int*)p.ctl + CW_CNT + 64 * l;
    for (long row = gt; row < SF::NTOK; row += gs) {
#pragma unroll
        for (int k = 0; k < 2; ++k) { const int e = p.TOPE[row * 2 + k]; const int slot = atomicAdd(cnt + e, 1);
            f.LIST[(size_t)e * SF::NTOK + slot] = (int)row * 2 + k; f.WL[(size_t)e * SF::NTOK + slot] = p.TOPW[row * 2 + k]; }
    }
}
__device__ __forceinline__ void f_moe_up(const Params& p, const FParams& f, int l, LAS unsigned char* lds) {
    MoeSched S{p.H, wsel(f, l).WUP_T, (const int*)p.ctl + CW_CNT + 64 * l, f.LIST, SF::D, SF::D, SF::D, (int)gridDim.x, fresh_bid(), true};
    EpiMoeUp E{f.HID};
    g8::gemm_run(lds, S, E);
}
__device__ __forceinline__ void f_moe_down(const Params& p, const FParams& f, int l, LAS unsigned char* lds) {
    MoeSched S{f.HID, wsel(f, l).WDN_T, (const int*)p.ctl + CW_CNT + 64 * l, f.LIST, SF::DE, SF::DE, SF::DE, (int)gridDim.x, fresh_bid(), false};
    EpiMoeDown E{p.C2, (const int*)p.ctl + CW_CNT + 64 * l, f.LIST, f.WL};
    g8::gemm_run(lds, S, E);
}

typedef float f32x16 __attribute__((ext_vector_type(16)));
typedef __bf16 bf16x2_t __attribute__((ext_vector_type(2)));
using g8::bf16x8;
__device__ __forceinline__ unsigned pkc(float a, float b) { f32x2 v = {a, b}; return __builtin_bit_cast(unsigned, __builtin_convertvector(v, bf16x2_t)); }
__device__ __forceinline__ bf16x8 lfrag(const LAS bf16* base, int pitch, int row0, int k0, int lane) { return *(const LAS bf16x8*)(base + (row0 + (lane & 15)) * pitch + k0 + 8 * (lane >> 4)); }
#define MFMA16(a, b, c) __builtin_amdgcn_mfma_f32_16x16x32_bf16((a), (b), (c), 0, 0, 0)
#define MFMA32(a, b, c) __builtin_amdgcn_mfma_f32_32x32x16_bf16((a), (b), (c), 0, 0, 0)

constexpr int GLA_NBLK = (SF::CTX + SF::SEQ) / 64;
constexpr int GLA_CB = SF::CTX / 64;
constexpr int GLA_TASKS = SF::B * SF::GH * GLA_NBLK;
constexpr int GP_K = 72, GP_C = 136;
constexpr int GL_CUM = 0, GL_TOT = 32768, GL_QC = 36864, GL_KF = 54272, GL_KB = 63488, GL_VT = 72704, GL_ST = 91136, GL_P = 125952, GL_END = 135168;
static_assert(GL_END <= LDS_BARW, "GLA LDS map");
struct GlaBufs { float* SLOC; float* DTOT; bf16* SIN; };

__device__ __forceinline__ int gla_row0(int b, int blk) { return blk < GLA_CB ? SF::NLAT + b * SF::CTX + 64 * blk : b * SF::SEQ + 64 * (blk - GLA_CB); }
__device__ __forceinline__ void gla_cum(const Params& p, LAS unsigned char* lds, int row0, int h, int tid, int off_tot = GL_TOT) {
    LAS float* CUM = (LAS float*)(lds + GL_CUM); LAS float* TOT = (LAS float*)(lds + off_tot);
    const int kk = tid & 63, seg = tid >> 6;
    float c[8], d[8];
    const float* la = p.LA + (size_t)(row0 + 8 * seg) * (2 * SF::QKW) + h * SF::DK + kk;
#pragma unroll
    for (int j = 0; j < 8; ++j) { c[j] = la[(size_t)j * (2 * SF::QKW)]; d[j] = la[(size_t)j * (2 * SF::QKW) + SF::QKW]; }
#pragma unroll
    for (int j = 1; j < 8; ++j) c[j] += c[j - 1];
#pragma unroll
    for (int j = 6; j >= 0; --j) d[j] += d[j + 1];
    TOT[seg * 64 + kk] = c[7]; TOT[512 + seg * 64 + kk] = d[0];
    __syncthreads();
    float of = 0.f, ob = 0.f;
#pragma unroll
    for (int s = 0; s < 8; ++s) { const float a = TOT[s * 64 + kk], b = TOT[512 + s * 64 + kk]; of += (s < seg) ? a : 0.f; ob += (s > seg) ? b : 0.f; }
#pragma unroll
    for (int j = 0; j < 8; ++j) { CUM[(8 * seg + j) * 64 + kk] = c[j] + of; CUM[4096 + (8 * seg + j) * 64 + kk] = d[j] + ob; }
    __syncthreads();
}
__device__ __forceinline__ void gla_vt(const Params& p, LAS unsigned char* lds, int row0, int h, int tid, int off_vt = GL_VT) {
    LAS bf16* VT = (LAS bf16*)(lds + off_vt);
#pragma unroll
    for (int it = 0; it < 2; ++it) { const int i = tid + it * NTHREADS, s = i >> 4, ch = i & 15;
        const u32x4 v = *(const u32x4*)(p.PROJ + (size_t)(row0 + s) * SF::PCOLS + SF::P_VA + h * SF::DV + 8 * ch);
        LAS bf16* d = VT + (8 * ch) * GP_K + s;
        d[0 * GP_K] = (bf16)(v.x & 0xffffu); d[1 * GP_K] = (bf16)(v.x >> 16); d[2 * GP_K] = (bf16)(v.y & 0xffffu); d[3 * GP_K] = (bf16)(v.y >> 16);
        d[4 * GP_K] = (bf16)(v.z & 0xffffu); d[5 * GP_K] = (bf16)(v.z >> 16); d[6 * GP_K] = (bf16)(v.w & 0xffffu); d[7 * GP_K] = (bf16)(v.w >> 16); }
}
constexpr int LC_TOT = 32768, LC_KF = 36864, LC_KB = 46080, LC_VT = 55296, LC_END = 73728;
__device__ __forceinline__ void gla_local_task(const Params& p, const GlaBufs& gb, LAS unsigned char* lds, int task) {
    const int tid = fresh_tid(), lane = tid & 63, wave = tid >> 6;
    LAS float* CUM = (LAS float*)(lds + GL_CUM); LAS bf16* KDF = (LAS bf16*)(lds + LC_KF); LAS bf16* KDB = (LAS bf16*)(lds + LC_KB); LAS bf16* VT = (LAS bf16*)(lds + LC_VT);
    {
        const int blk = task % GLA_NBLK, bh = task / GLA_NBLK, h = bh % SF::GH, b = bh / SF::GH; const int row0 = gla_row0(b, blk);
        gla_cum(p, lds, row0, h, tid, LC_TOT);
        { const int t = tid >> 3, kk0 = 8 * (tid & 7);
          const u32x4 kv = *(const u32x4*)(p.PROJ + (size_t)(row0 + t) * SF::PCOLS + SF::P_KA + h * SF::DK + kk0);
          const unsigned kw[4] = {kv.x, kv.y, kv.z, kv.w};
#pragma unroll
          for (int j = 0; j < 8; ++j) { const float kf = (j & 1) ? bfhi(kw[j >> 1]) : bflo(kw[j >> 1]); const int kk = kk0 + j;
              const float ef = __expf(CUM[63 * 64 + kk] - CUM[t * 64 + kk]), eb = __expf(CUM[4096 + kk] - CUM[4096 + t * 64 + kk]);
              KDF[kk * GP_K + t] = f2bf(kf * ef); KDB[kk * GP_K + t] = f2bf(kf * eb); }
          if (tid < 128) { const int dir = tid >> 6, kk = tid & 63; gb.DTOT[((size_t)(bh * 2 + dir) * GLA_NBLK + blk) * 64 + kk] = __expf(dir ? CUM[4096 + kk] : CUM[63 * 64 + kk]); } }
        gla_vt(p, lds, row0, h, tid, LC_VT);
        __syncthreads();
        { bf16x8 a[2];
#pragma unroll
          for (int ks = 0; ks < 2; ++ks) a[ks] = lfrag(VT, GP_K, 16 * wave, 32 * ks, lane);
#pragma unroll
          for (int dir = 0; dir < 2; ++dir) { const LAS bf16* KD = dir ? KDB : KDF; float* out = gb.SLOC + ((size_t)(bh * 2 + dir) * GLA_NBLK + blk) * (SF::DV * SF::DK);
#pragma unroll
              for (int j = 0; j < 4; ++j) { f32x4 acc = {0.f, 0.f, 0.f, 0.f};
#pragma unroll
                  for (int ks = 0; ks < 2; ++ks) acc = MFMA16(a[ks], lfrag(KD, GP_K, 16 * j, 32 * ks, lane), acc);
#pragma unroll
                  for (int r = 0; r < 4; ++r) out[(16 * wave + 4 * (lane >> 4) + r) * SF::DK + 16 * j + (lane & 15)] = acc[r]; } } }
        __syncthreads();
    }
}
__device__ __forceinline__ void f_gla_scan(const GlaBufs& gb) {
    const long gs = (long)gridDim.x * NTHREADS;
    for (long e = fresh_gt(); e < (long)SF::B * SF::GH * 2 * SF::DV * SF::DK; e += gs) {
        const int kk = (int)(e & 63), vv = (int)((e >> 6) & 127), dir = (int)((e >> 13) & 1), bh = (int)(e >> 14);
        const float* dt = gb.DTOT + ((size_t)(bh * 2 + dir) * GLA_NBLK) * 64 + kk; const float* sl = gb.SLOC + ((size_t)(bh * 2 + dir) * GLA_NBLK) * (SF::DV * SF::DK) + vv * SF::DK + kk;
        bf16* so = gb.SIN + ((size_t)bh * GLA_NBLK) * (SF::DV * 128) + vv * 128 + dir * 64 + kk;
        float S = 0.f;
        for (int g = 0; g < GLA_NBLK / 4; ++g) {
            float dv[4], sv[4]; int bk[4];
#pragma unroll
            for (int u = 0; u < 4; ++u) { const int step = 4 * g + u; bk[u] = dir == 0 ? step : (step < GLA_CB ? GLA_CB - 1 - step : GLA_NBLK + GLA_CB - 1 - step);
                dv[u] = dt[(size_t)bk[u] * 64]; sv[u] = sl[(size_t)bk[u] * (SF::DV * SF::DK)]; }
#pragma unroll
            for (int u = 0; u < 4; ++u) { so[(size_t)bk[u] * (SF::DV * 128)] = f2bf(S); S = dv[u] * S + sv[u]; }
        }
    }
}
__device__ __forceinline__ void f_gla_out(const Params& p, const GlaBufs& gb, int l, LAS unsigned char* lds) {
    const int tid = fresh_tid(), lane = tid & 63, wave = tid >> 6;
    LAS float* CUM = (LAS float*)(lds + GL_CUM); LAS bf16* QC = (LAS bf16*)(lds + GL_QC); LAS bf16* KF = (LAS bf16*)(lds + GL_KF); LAS bf16* KB = (LAS bf16*)(lds + GL_KB);
    LAS bf16* VT = (LAS bf16*)(lds + GL_VT); LAS bf16* ST = (LAS bf16*)(lds + GL_ST); LAS bf16* P = (LAS bf16*)(lds + GL_P); LAS float* O = (LAS float*)(lds + GL_CUM);
    for (int task = fresh_bid(); task < GLA_TASKS; task += gridDim.x) {
        const int blk = task % GLA_NBLK, bh = task / GLA_NBLK, h = bh % SF::GH, b = bh / SF::GH; const int row0 = gla_row0(b, blk);
        gla_cum(p, lds, row0, h, tid);
        { const int t = tid >> 3, kk0 = 8 * (tid & 7); const bf16* pr = p.PROJ + (size_t)(row0 + t) * SF::PCOLS;
          const u32x4 qv = *(const u32x4*)(pr + SF::P_QA + h * SF::DK + kk0), kv = *(const u32x4*)(pr + SF::P_KA + h * SF::DK + kk0);
          const unsigned qw[4] = {qv.x, qv.y, qv.z, qv.w}, kw[4] = {kv.x, kv.y, kv.z, kv.w};
          float qf[8], qb[8], kf[8], kb[8];
#pragma unroll
          for (int j = 0; j < 8; ++j) { const float q = (j & 1) ? bfhi(qw[j >> 1]) : bflo(qw[j >> 1]), k = (j & 1) ? bfhi(kw[j >> 1]) : bflo(kw[j >> 1]);
              const float cf = CUM[t * 64 + kk0 + j], cb = CUM[4096 + t * 64 + kk0 + j];
              qf[j] = q * __expf(cf); qb[j] = q * __expf(cb); kf[j] = k * __expf(-cf); kb[j] = k * __expf(-cb); }
          u32x4 w; w.x = pkc(qf[0], qf[1]); w.y = pkc(qf[2], qf[3]); w.z = pkc(qf[4], qf[5]); w.w = pkc(qf[6], qf[7]); *(LAS u32x4*)(QC + t * GP_C + kk0) = w;
          w.x = pkc(qb[0], qb[1]); w.y = pkc(qb[2], qb[3]); w.z = pkc(qb[4], qb[5]); w.w = pkc(qb[6], qb[7]); *(LAS u32x4*)(QC + t * GP_C + 64 + kk0) = w;
          w.x = pkc(kf[0], kf[1]); w.y = pkc(kf[2], kf[3]); w.z = pkc(kf[4], kf[5]); w.w = pkc(kf[6], kf[7]); *(LAS u32x4*)(KF + t * GP_K + kk0) = w;
          w.x = pkc(kb[0], kb[1]); w.y = pkc(kb[2], kb[3]); w.z = pkc(kb[4], kb[5]); w.w = pkc(kb[6], kb[7]); *(LAS u32x4*)(KB + t * GP_K + kk0) = w; }
        gla_vt(p, lds, row0, h, tid);
        { const bf16* sin = gb.SIN + (size_t)task * (SF::DV * 128);
#pragma unroll
          for (int it = 0; it < 4; ++it) { const int i = tid + it * NTHREADS, vv = i >> 4, ch = i & 15; *(LAS u32x4*)(ST + vv * GP_C + 8 * ch) = *(const u32x4*)(sin + vv * 128 + 8 * ch); } }
        __syncthreads();
        { const int si = wave & 3;
#pragma unroll
          for (int tt = 0; tt < 2; ++tt) { const int ti = (wave >> 2) * 2 + tt; f32x4 af = {0.f, 0.f, 0.f, 0.f}, ab = {0.f, 0.f, 0.f, 0.f};
#pragma unroll
              for (int ks = 0; ks < 2; ++ks) { af = MFMA16(lfrag(KF, GP_K, 16 * si, 32 * ks, lane), lfrag(QC, GP_C, 16 * ti, 32 * ks, lane), af);
                  ab = MFMA16(lfrag(KB, GP_K, 16 * si, 32 * ks, lane), lfrag(QC, GP_C, 16 * ti, 64 + 32 * ks, lane), ab); }
              const int t = 16 * ti + (lane & 15), s0 = 16 * si + 4 * (lane >> 4); float v[4];
#pragma unroll
              for (int r = 0; r < 4; ++r) { const int s = s0 + r; v[r] = (s <= t ? af[r] : 0.f) + (s >= t ? ab[r] : 0.f); }
              u32x2 w; w.x = pkc(v[0], v[1]); w.y = pkc(v[2], v[3]); *(LAS u32x2*)(P + t * GP_K + s0) = w; } }
        __syncthreads();
        { const int ti = wave & 3; bf16x8 aq[4], ap[2]; f32x4 acc[4];
#pragma unroll
          for (int ks = 0; ks < 4; ++ks) aq[ks] = lfrag(QC, GP_C, 16 * ti, 32 * ks, lane);
#pragma unroll
          for (int ks = 0; ks < 2; ++ks) ap[ks] = lfrag(P, GP_K, 16 * ti, 32 * ks, lane);
#pragma unroll
          for (int j = 0; j < 4; ++j) { const int vt = (wave >> 2) * 4 + j; acc[j] = (f32x4){0.f, 0.f, 0.f, 0.f};
#pragma unroll
              for (int ks = 0; ks < 4; ++ks) acc[j] = MFMA16(aq[ks], lfrag(ST, GP_C, 16 * vt, 32 * ks, lane), acc[j]);
#pragma unroll
              for (int ks = 0; ks < 2; ++ks) acc[j] = MFMA16(ap[ks], lfrag(VT, GP_K, 16 * vt, 32 * ks, lane), acc[j]); }
#pragma unroll
          for (int j = 0; j < 4; ++j) { const int vt = (wave >> 2) * 4 + j;
#pragma unroll
              for (int r = 0; r < 4; ++r) O[(16 * ti + 4 * (lane >> 4) + r) * 128 + 16 * vt + (lane & 15)] = acc[j][r]; } }
        __syncthreads();
        { const int t = tid >> 3, vv0 = 16 * (tid & 7); float o[16]; float ss = 0.f;
#pragma unroll
          for (int j = 0; j < 4; ++j) { const f32x4 x = *(const LAS f32x4*)(O + t * 128 + vv0 + 4 * j); o[4 * j] = x[0]; o[4 * j + 1] = x[1]; o[4 * j + 2] = x[2]; o[4 * j + 3] = x[3]; ss += x[0] * x[0] + x[1] * x[1] + x[2] * x[2] + x[3] * x[3]; }
          ss += __shfl_xor(ss, 1); ss += __shfl_xor(ss, 2); ss += __shfl_xor(ss, 4);
          const float rstd = 1.0f / sqrtf(ss * (1.0f / SF::DV) + SF::EPS);
          const bf16* rp = p.PROJ + (size_t)(row0 + t) * SF::PCOLS + SF::P_RA + h * SF::DV + vv0; const u32x4 r0 = *(const u32x4*)rp, r1 = *(const u32x4*)(rp + 8);
          const unsigned rw[8] = {r0.x, r0.y, r0.z, r0.w, r1.x, r1.y, r1.z, r1.w}; const float* gg = p.g_gla + l * SF::DV + vv0; float y[16];
#pragma unroll
          for (int j = 0; j < 16; ++j) { const float r = (j & 1) ? bfhi(rw[j >> 1]) : bflo(rw[j >> 1]); y[j] = o[j] * rstd * gg[j] * fast_silu(r); }
          u32x4 w0, w1; w0.x = pkc(y[0], y[1]); w0.y = pkc(y[2], y[3]); w0.z = pkc(y[4], y[5]); w0.w = pkc(y[6], y[7]); w1.x = pkc(y[8], y[9]); w1.y = pkc(y[10], y[11]); w1.z = pkc(y[12], y[13]); w1.w = pkc(y[14], y[15]);
          bf16* yp = p.Y + (size_t)(row0 + t) * SF::YCOLS + SF::Y_A + h * SF::DV + vv0; *(u32x4*)yp = w0; *(u32x4*)(yp + 8) = w1; }
        __syncthreads();
    }
}

constexpr int AT_KS = 0, AT_VT = 18432, AT_END = 18432 + 64 * GP_C * 2;
__device__ __forceinline__ void attn_unit(const Params& p, int l, LAS unsigned char* lds, int u) {
    const int tid = fresh_tid(), lane = tid & 63, wave = __builtin_amdgcn_readfirstlane(tid >> 6), g = wave >> 1, qh = wave & 1, hl = lane >> 5, c = lane & 31;
    LAS bf16* KS = (LAS bf16*)(lds + AT_KS); LAS bf16* VT = (LAS bf16*)(lds + AT_VT);
    constexpr float LOG2E = 1.4426950408889634f; constexpr float SC = 0.125f * LOG2E;
    constexpr int NQB = SF::SEQ / 128, NLU = SF::B * SF::SKV * NQB;
    {
        const bool lat = u < NLU; int b, hk, qb;
        if (lat) { qb = u % NQB; hk = (u / NQB) % SF::SKV; b = u / (NQB * SF::SKV); } else { const int v = u - NLU; qb = v % (SF::CTX / 128); hk = (v / (SF::CTX / 128)) % SF::SKV; b = v / ((SF::CTX / 128) * SF::SKV); }
        const int qrow0 = (lat ? b * SF::SEQ : SF::NLAT + b * SF::CTX) + qb * 128 + 64 * qh; const int hq = hk * SF::SG + g;
        bf16x8 qf[2][4];
#pragma unroll
        for (int qs = 0; qs < 2; ++qs)
#pragma unroll
            for (int ks = 0; ks < 4; ++ks) qf[qs][ks] = *(const bf16x8*)(p.PROJ + (size_t)(qrow0 + 32 * qs + c) * SF::PCOLS + SF::P_QC + hq * SF::HD + 16 * ks + 8 * hl);
        float m[2], ls[2]; f32x16 O[2][2];
#pragma unroll
        for (int qs = 0; qs < 2; ++qs) { m[qs] = p.sink[l * SF::SH + hq] * LOG2E; ls[qs] = hl == 0 ? 1.0f : 0.0f;
#pragma unroll
            for (int dt = 0; dt < 2; ++dt)
#pragma unroll
                for (int r = 0; r < 16; ++r) O[dt][qs][r] = 0.f; }
        const int nkb = lat ? 5 : 2;
        for (int kbi = 0; kbi < nkb; ++kbi) {
            if ((kbi == 2 && qb == 0) || (kbi == 4 && qb == NQB - 1)) continue;
            const int krow0 = kbi < 2 ? SF::NLAT + b * SF::CTX + 128 * kbi : b * SF::SEQ + (qb + kbi - 3) * 128;
            __syncthreads();
#pragma unroll
            for (int it = 0; it < 2; ++it) { const int i = tid + it * NTHREADS, key = i >> 3, ch = i & 7; const bf16* src = p.PROJ + (size_t)(krow0 + key) * SF::PCOLS + hk * SF::HD + 8 * ch;
                *(LAS u32x4*)(KS + key * GP_K + 8 * ch) = *(const u32x4*)(src + SF::P_KC);
                const u32x4 v = *(const u32x4*)(src + SF::P_VC); LAS bf16* d = VT + (8 * ch) * GP_C + key;
                d[0 * GP_C] = (bf16)(v.x & 0xffffu); d[1 * GP_C] = (bf16)(v.x >> 16); d[2 * GP_C] = (bf16)(v.y & 0xffffu); d[3 * GP_C] = (bf16)(v.y >> 16);
                d[4 * GP_C] = (bf16)(v.z & 0xffffu); d[5 * GP_C] = (bf16)(v.z >> 16); d[6 * GP_C] = (bf16)(v.w & 0xffffu); d[7 * GP_C] = (bf16)(v.w >> 16); }
            __syncthreads();
            for (int kt = 0; kt < 4; ++kt) {
#pragma unroll
                for (int qs = 0; qs < 2; ++qs) {
                    const int rel = 32 * kt - (64 * qh + 32 * qs);
                    if ((kbi == 2 && rel < 0) || (kbi == 4 && rel > 0)) continue;
                    f32x16 S;
#pragma unroll
                    for (int r = 0; r < 16; ++r) S[r] = 0.f;
#pragma unroll
                    for (int ks = 0; ks < 4; ++ks) { const bf16x8 a = *(const LAS bf16x8*)(KS + (32 * kt + c) * GP_K + 16 * ks + 8 * hl); S = MFMA32(a, qf[qs][ks], S); }
                    float mx = m[qs];
                    if (rel == 0 && kbi >= 2 && kbi != 3) {
#pragma unroll
                        for (int r = 0; r < 16; ++r) { const int rr = (r & 3) + 8 * (r >> 2) + 4 * hl; const bool bad = kbi == 2 ? (rr < c) : (rr > c); const float x = bad ? -1e30f : S[r] * SC; S[r] = x; mx = fmaxf(mx, x); } }
                    else {
#pragma unroll
                        for (int r = 0; r < 16; ++r) { const float x = S[r] * SC; S[r] = x; mx = fmaxf(mx, x); } }
                    { auto rr = __builtin_amdgcn_permlane32_swap(__float_as_uint(mx), __float_as_uint(mx), false, false); mx = fmaxf(__uint_as_float(rr[0]), __uint_as_float(rr[1])); }
                    const float alpha = __builtin_amdgcn_exp2f(m[qs] - mx); m[qs] = mx; float rs = 0.f;
#pragma unroll
                    for (int r = 0; r < 16; ++r) { const float pv = __builtin_amdgcn_exp2f(S[r] - mx); S[r] = pv; rs += pv; }
                    ls[qs] = ls[qs] * alpha + rs;
#pragma unroll
                    for (int dt = 0; dt < 2; ++dt)
#pragma unroll
                        for (int r = 0; r < 16; ++r) O[dt][qs][r] *= alpha;
                    bf16x8 pf[2];
#pragma unroll
                    for (int s = 0; s < 2; ++s) { u32x4 w; w.x = pkc(S[8 * s], S[8 * s + 1]); w.y = pkc(S[8 * s + 2], S[8 * s + 3]); w.z = pkc(S[8 * s + 4], S[8 * s + 5]); w.w = pkc(S[8 * s + 6], S[8 * s + 7]);
                        pf[s] = __builtin_bit_cast(bf16x8, w); }
#pragma unroll
                    for (int dt = 0; dt < 2; ++dt)
#pragma unroll
                        for (int s = 0; s < 2; ++s) { const LAS bf16* vp = VT + (32 * dt + c) * GP_C + 32 * kt + 16 * s + 4 * hl;
                            const u32x2 v0 = *(const LAS u32x2*)vp, v1 = *(const LAS u32x2*)(vp + 8); u32x4 w; w.x = v0.x; w.y = v0.y; w.z = v1.x; w.w = v1.y;
                            O[dt][qs] = MFMA32(__builtin_bit_cast(bf16x8, w), pf[s], O[dt][qs]); }
                }
            }
        }
#pragma unroll
        for (int qs = 0; qs < 2; ++qs) { float lt = ls[qs];
            { auto rr = __builtin_amdgcn_permlane32_swap(__float_as_uint(lt), __float_as_uint(lt), false, false); lt = __uint_as_float(rr[0]) + __uint_as_float(rr[1]); }
            const float inv = 1.0f / lt; bf16* yp = p.Y + (size_t)(qrow0 + 32 * qs + c) * SF::YCOLS + SF::Y_C + hq * SF::HD;
#pragma unroll
            for (int dt = 0; dt < 2; ++dt)
#pragma unroll
                for (int gq = 0; gq < 4; ++gq) { u32x2 w; w.x = pkc(O[dt][qs][4 * gq] * inv, O[dt][qs][4 * gq + 1] * inv); w.y = pkc(O[dt][qs][4 * gq + 2] * inv, O[dt][qs][4 * gq + 3] * inv);
                    *(u32x2*)(yp + 32 * dt + 8 * gq + 4 * hl) = w; } }
    }
}

constexpr int FF_ZT = 0, FF_G = 17408, FF_OUT = 34816, FF_WEND = 67584, FF_M1 = 86016, FF_M2 = 120832, FF_END = 138240;
static_assert(FF_END <= LDS_BARW - 16 && LC_END <= FF_M1 && FF_WEND <= FF_M1, "mixed-phase LDS map");
constexpr int FFT_TPG = 17, FFT_TASKS = SF::B * SF::FG * FFT_TPG;
__device__ __forceinline__ void fft_setup(const Params& p, LAS unsigned char* lds) {
    const int tid = fresh_tid(); LAS bf16* M1 = (LAS bf16*)(lds + FF_M1); LAS bf16* M2 = (LAS bf16*)(lds + FF_M2);
    for (int i = tid; i < 128 * 128; i += NTHREADS) { const int row = i >> 7, col = i & 127, rp = row >> 6, v = row & 63, ri = col >> 6, a = col & 63; const int m = ((a * v) & 63) * (SF::SEQ / 64);
        const float cs = p.TABL[2 * m], sn = p.TABL[2 * m + 1]; const float val = rp == 0 ? (ri == 0 ? cs : -sn) : (ri == 0 ? -sn : -cs); M1[row * GP_C + col] = f2bf(val); }
    for (int i = tid; i < 64 * 128; i += NTHREADS) { const int u = i >> 7, col = i & 127, ri = col >> 6, bp = col & 63; const int m = ((bp * u) & 63) * (SF::SEQ / 64);
        M2[u * GP_C + col] = f2bf((ri == 0 ? p.TABL[2 * m] : p.TABL[2 * m + 1]) * (1.0f / 64.0f)); }
}
__device__ __forceinline__ void fft_task(const Params& p, LAS unsigned char* lds, int task) {
    const int tid = fresh_tid(), lane = tid & 63, wave = __builtin_amdgcn_readfirstlane(tid >> 6);
    LAS bf16* ZT = (LAS bf16*)(lds + FF_ZT); LAS bf16* G = (LAS bf16*)(lds + FF_G); LAS bf16* OUT = (LAS bf16*)(lds + FF_OUT);
    const LAS bf16* M1 = (const LAS bf16*)(lds + FF_M1); const LAS bf16* M2 = (const LAS bf16*)(lds + FF_M2);
    const int bg = task / FFT_TPG, tt = task % FFT_TPG, b = bg / SF::FG, g = bg % SF::FG;
    const int ncol = tt < 16 ? 4 : 1, c0 = tt < 16 ? 4 * tt : 64;
    const bf16* src = p.PQT + (size_t)bg * SF::FGW * SF::SEQ;
    for (int cc = 0; cc < ncol; ++cc) {
        const int cp = c0 + cc; const bool hasq = cp >= 1 && cp <= 63;
#pragma unroll
        for (int it = 0; it < 2; ++it) { const int i = tid + it * NTHREADS, pq = i >> 9, idx = i & 511, l0 = 8 * idx, a = l0 >> 6, bp0 = l0 & 63;
            u32x4 v = {0u, 0u, 0u, 0u}; if (pq == 0) v = *(const u32x4*)(src + (size_t)cp * SF::SEQ + l0); else if (hasq) v = *(const u32x4*)(src + (size_t)(64 + cp) * SF::SEQ + l0);
            LAS bf16* d = ZT + bp0 * GP_C + pq * 64 + a;
            d[0 * GP_C] = (bf16)(v.x & 0xffffu); d[1 * GP_C] = (bf16)(v.x >> 16); d[2 * GP_C] = (bf16)(v.y & 0xffffu); d[3 * GP_C] = (bf16)(v.y >> 16);
            d[4 * GP_C] = (bf16)(v.z & 0xffffu); d[5 * GP_C] = (bf16)(v.z >> 16); d[6 * GP_C] = (bf16)(v.w & 0xffffu); d[7 * GP_C] = (bf16)(v.w >> 16); }
        __syncthreads();
        { const int i = wave & 3; bf16x8 za[4];
#pragma unroll
          for (int ks = 0; ks < 4; ++ks) za[ks] = lfrag(ZT, GP_C, 16 * i, 32 * ks, lane);
#pragma unroll
          for (int jj = 0; jj < 2; ++jj) { const int j = 2 * (wave >> 2) + jj; f32x4 ar = {0.f, 0.f, 0.f, 0.f}, ai = {0.f, 0.f, 0.f, 0.f};
#pragma unroll
              for (int ks = 0; ks < 4; ++ks) { ar = MFMA16(za[ks], lfrag(M1, GP_C, 16 * j, 32 * ks, lane), ar); ai = MFMA16(za[ks], lfrag(M1, GP_C, 64 + 16 * j, 32 * ks, lane), ai); }
              const int v = 16 * j + (lane & 15), bp0 = 16 * i + 4 * (lane >> 4); float tr[4], ti[4];
#pragma unroll
              for (int r = 0; r < 4; ++r) { const f32x2 w = *(const f32x2*)(p.TABL + 2 * ((bp0 + r) * v)); tr[r] = ar[r] * w[0] + ai[r] * w[1]; ti[r] = ai[r] * w[0] - ar[r] * w[1]; }
              u32x2 w; w.x = pkc(tr[0], tr[1]); w.y = pkc(tr[2], tr[3]); *(LAS u32x2*)(G + v * GP_C + bp0) = w;
              w.x = pkc(ti[0], ti[1]); w.y = pkc(ti[2], ti[3]); *(LAS u32x2*)(G + v * GP_C + 64 + bp0) = w; } }
        __syncthreads();
        { const int i = wave & 3; bf16x8 ga[4];
#pragma unroll
          for (int ks = 0; ks < 4; ++ks) ga[ks] = lfrag(G, GP_C, 16 * i, 32 * ks, lane);
#pragma unroll
          for (int jj = 0; jj < 2; ++jj) { const int j = 2 * (wave >> 2) + jj; f32x4 acc = {0.f, 0.f, 0.f, 0.f};
#pragma unroll
              for (int ks = 0; ks < 4; ++ks) acc = MFMA16(ga[ks], lfrag(M2, GP_C, 16 * j, 32 * ks, lane), acc);
              const int u = 16 * j + (lane & 15), v0 = 16 * i + 4 * (lane >> 4);
#pragma unroll
              for (int r = 0; r < 4; ++r) OUT[(64 * u + v0 + r) * 4 + cc] = f2bf(acc[r]); } }
    }
    __syncthreads();
    bf16* yb = p.Y + (size_t)b * SF::SEQ * SF::YCOLS + SF::Y_B + g * SF::FGW;
    for (int lp = tid; lp < SF::SEQ; lp += NTHREADS) { const u32x2 o = *(const LAS u32x2*)(OUT + lp * 4); const int lm = (SF::SEQ - lp) & (SF::SEQ - 1);
        if (ncol == 4) { *(u32x2*)(yb + (size_t)lp * SF::YCOLS + c0) = o;
            bf16* ym = yb + (size_t)lm * SF::YCOLS + SF::FGW - c0;
            if (c0 != 0) ym[0] = (bf16)(o.x & 0xffffu);
            ym[-1] = (bf16)(o.x >> 16); ym[-2] = (bf16)(o.y & 0xffffu); ym[-3] = (bf16)(o.y >> 16); }
        else yb[(size_t)lp * SF::YCOLS + c0] = (bf16)(o.x & 0xffffu); }
    __syncthreads();
}
constexpr int CXD_CPT = 13, CXD_TPG = 5, CXD_TASKS = SF::B * SF::FG * CXD_TPG;
__device__ __forceinline__ void ctxdft_task(const Params& p, LAS unsigned char* lds, int task) {
    const int tid = fresh_tid(); const int bg = task / CXD_TPG, c0 = (task % CXD_TPG) * CXD_CPT, b = bg / SF::FG, g = bg % SF::FG; const float sc = 1.0f / sqrtf((float)SF::CTX);
    const bf16* src = p.PQTC + (size_t)bg * SF::FGW * SF::CTX; bf16* yb = p.Y + ((size_t)SF::NLAT + (size_t)b * SF::CTX) * SF::YCOLS + SF::Y_B + g * SF::FGW;
    LAS float* PL = (LAS float*)lds; LAS float* QL = PL + CXD_CPT * SF::CTX; LAS float* tb = QL + CXD_CPT * SF::CTX;
    for (int i = tid; i < CXD_CPT * SF::CTX; i += NTHREADS) { const int cp = c0 + i / SF::CTX, j = i % SF::CTX; const bool hasq = cp >= 1 && cp <= 63;
        PL[i] = bf2f(src[(size_t)cp * SF::CTX + j]); QL[i] = hasq ? bf2f(src[(size_t)(64 + cp) * SF::CTX + j]) : 0.f; }
    for (int i = tid; i < 2 * SF::CTX; i += NTHREADS) tb[i] = p.TABX[i];
    __syncthreads();
    for (int i = tid; i < CXD_CPT * SF::CTX; i += NTHREADS) { const int jp = i % SF::CTX, ci = i / SF::CTX, cp = c0 + ci; float acc = 0.f;
#pragma unroll 8
        for (int j = 0; j < SF::CTX; ++j) { const int m = (j * jp) & (SF::CTX - 1); acc += tb[2 * m] * PL[ci * SF::CTX + j] - tb[2 * m + 1] * QL[ci * SF::CTX + j]; }
        const bf16 o = f2bf(acc * sc); yb[(size_t)jp * SF::YCOLS + cp] = o;
        if (cp >= 1 && cp <= 63) yb[(size_t)((SF::CTX - jp) & (SF::CTX - 1)) * SF::YCOLS + SF::FGW - cp] = o; }
    __syncthreads();
}

constexpr int ATT_NLU = SF::B * SF::SKV * (SF::SEQ / 128), ATT_NCU = SF::B * SF::SKV * (SF::CTX / 128);
constexpr int MX_A = ATT_NLU, MX_F = MX_A + FFT_TASKS, MX_C = MX_F + ATT_NCU, MX_X = MX_C + CXD_TASKS, MX_G = MX_X + GLA_TASKS;
constexpr int CW_QUEUE = 5120;
constexpr int LDS_QW = LDS_BARW - 16;
__device__ __forceinline__ void f_mixed(const Params& p, const FParams& f, const GlaBufs& gb, int l, LAS unsigned char* lds) {
    const int tid = fresh_tid();
    fft_setup(p, lds);
    const WSet wnext = wsel(f, l + 1);
    const int ncv = l + 1 < SF::DEPTH ? CV_TASKS : 0; const int total = MX_G + ncv;
    unsigned* qh = p.ctl + CW_QUEUE + 64 * l; volatile LAS int* qw = (volatile LAS int*)(lds + LDS_QW);
    for (;;) {
        __syncthreads();
        if (tid == 0) *qw = (int)atomicAdd(qh, 1u);
        __syncthreads();
        const int t = *qw;
        if (t >= total) break;
        const int t2 = t - ncv;
        int au = -1; if (t < MX_A) au = t; else if (t >= MX_F + ncv && t2 < MX_C) au = ATT_NLU + (t2 - MX_F);
        if (au >= 0) attn_unit(p, l, lds, au);
        else if (t < MX_F) fft_task(p, lds, t - MX_A);
        else if (t < MX_F + ncv) convert_task(p, wnext, l + 1, t - MX_F, lds, 0);
        else if (t2 < MX_X) ctxdft_task(p, lds, t2 - MX_C);
        else gla_local_task(p, gb, lds, t2 - MX_X);
    }
}

__device__ __forceinline__ float wave_sum(float v) {
#pragma unroll
    for (int o = 1; o < 64; o <<= 1) v += __shfl_xor(v, o);
    return v;
}
__device__ __forceinline__ void f_mods(const Params& p, LAS unsigned char* lds) {
    const int tid = fresh_tid(); LAS float* act = (LAS float*)lds; LAS float* PS = (LAS float*)(lds + 20480);
    constexpr int R = SF::B + 1; static_assert(R == 5, "mods rows");
    for (int i = tid; i < R * SF::D; i += NTHREADS) { const int r = i / SF::D, k = i % SF::D; const float v = r < SF::B ? p.c[r * SF::D + k] : p.c_ctx[k]; act[i] = v / (1.0f + __expf(-v)); }
    __syncthreads();
    constexpr int NCH = SF::NMOD / 128;
    for (int u = fresh_bid(); u < SF::DEPTH * NCH; u += gridDim.x) {
        const int l = u / NCH, n0 = (u % NCH) * 128; const int q = tid & 31, kg = tid >> 5;
        f32x4 acc[R];
#pragma unroll
        for (int r = 0; r < R; ++r) acc[r] = (f32x4){0.f, 0.f, 0.f, 0.f};
        const float* w = p.w_ada + ((size_t)l * SF::D + kg * 64) * SF::NMOD + n0 + 4 * q;
#pragma unroll 4
        for (int k = 0; k < 64; ++k) { const f32x4 w4 = *(const f32x4*)(w + (size_t)k * SF::NMOD);
#pragma unroll
            for (int r = 0; r < R; ++r) acc[r] = acc[r] + w4 * act[r * SF::D + kg * 64 + k]; }
#pragma unroll
        for (int r = 0; r < R; ++r) *(LAS f32x4*)(PS + ((kg * 32 + q) * R + r) * 4) = acc[r];
        __syncthreads();
        for (int t2 = tid; t2 < 32 * R * 4; t2 += NTHREADS) { const int qq = t2 / (R * 4), ri = t2 % (R * 4), r = ri / 4, i = ri % 4; float s = 0.f;
#pragma unroll
            for (int g2 = 0; g2 < 16; ++g2) s += PS[((g2 * 32 + qq) * R + r) * 4 + i];
            const int n = n0 + 4 * qq + i; p.MODS[((size_t)l * R + r) * SF::NMOD + n] = s + p.b_ada[(size_t)l * SF::NMOD + n]; }
        __syncthreads();
    }
}
__device__ __forceinline__ void f_resnorm(const Params& p, int l, int mode, bool dry = false) {
    const int tid = fresh_tid(), lane = tid & 63, wave = tid >> 6; const int NGW = gridDim.x * NWAVES;
    for (int row = fresh_bid() * NWAVES + wave; row < SF::NTOK; row += NGW) {
        if (mode == 2 && row >= SF::NLAT) continue;
        const int mr = row < SF::NLAT ? row / SF::SEQ : SF::B;
        float* xr = p.X + (size_t)row * SF::D; f32x4 x[4]; float ss = 0.f;
        if (mode == 0) { const float* src = row < SF::NLAT ? p.x + (size_t)row * SF::D : p.ctx + (size_t)(row - SF::NLAT) * SF::D;
#pragma unroll
            for (int j = 0; j < 4; ++j) x[j] = *(const f32x4*)(src + 4 * lane + 256 * j); }
        else { const float* g2 = p.MODS + ((size_t)(l - 1) * (SF::B + 1) + mr) * SF::NMOD + 5 * SF::D; const bf16* ca = p.C2 + (size_t)row * 2 * SF::D; const bf16* cb = ca + SF::D;
#pragma unroll
            for (int j = 0; j < 4; ++j) { const int c0 = 4 * lane + 256 * j; const f32x4 xv = *(const f32x4*)(xr + c0), gv = *(const f32x4*)(g2 + c0); const u32x2 a = *(const u32x2*)(ca + c0), b = *(const u32x2*)(cb + c0);
                x[j] = xv + (dry ? gv * 0.0f : gv) * (f32x4){bflo(a.x) + bflo(b.x), bfhi(a.x) + bfhi(b.x), bflo(a.y) + bflo(b.y), bfhi(a.y) + bfhi(b.y)}; } }
#pragma unroll
        for (int j = 0; j < 4; ++j) { if (mode != 2) *(f32x4*)((dry ? p.OG + (size_t)row * SF::D : xr) + 4 * lane + 256 * j) = x[j]; ss += x[j][0] * x[j][0] + x[j][1] * x[j][1] + x[j][2] * x[j][2] + x[j][3] * x[j][3]; }
        const float rstd = 1.0f / sqrtf(wave_sum(ss) * (1.0f / SF::D) + SF::EPS);
        if (mode == 2) {
#pragma unroll
            for (int j = 0; j < 4; ++j) { const int c0 = 4 * lane + 256 * j; *(f32x4*)(p.out + (size_t)row * SF::D + c0) = x[j] * rstd * *(const f32x4*)(p.g_final + c0); } }
        else { const float* md = p.MODS + ((size_t)l * (SF::B + 1) + mr) * SF::NMOD; const float* g = p.g_mix + (size_t)l * SF::D;
#pragma unroll
            for (int j = 0; j < 4; ++j) { const int c0 = 4 * lane + 256 * j; const f32x4 y = x[j] * rstd * *(const f32x4*)(g + c0) * (*(const f32x4*)(md + SF::D + c0) + 1.0f) + *(const f32x4*)(md + c0);
                u32x2 w; w.x = pk2(y[0], y[1]); w.y = pk2(y[2], y[3]); *(u32x2*)(p.H + (size_t)row * SF::D + c0) = w; asm volatile("" ::: "memory"); } }
    }
}
__device__ __forceinline__ void f_norm2w(const Params& p, const FParams& f, int l, LAS unsigned char* lds, bool dry = false) {
    const int tid = fresh_tid(), lane = tid & 63, wave = tid >> 6; const int NGW = gridDim.x * NWAVES;
    constexpr int NR = SF::MG + SF::NE;
    LAS float* WT = (LAS float*)lds;
    { const float* wg = p.w_rg + (size_t)l * SF::D * SF::MG; const float* we = p.w_re + (size_t)l * SF::D * SF::NE;
      for (int i = tid; i < SF::D; i += NTHREADS) { const f32x4 v = *(const f32x4*)(wg + 4 * i); WT[0 * SF::D + i] = v[0]; WT[1 * SF::D + i] = v[1]; WT[2 * SF::D + i] = v[2]; WT[3 * SF::D + i] = v[3]; }
      for (int i = tid; i < SF::D * 4; i += NTHREADS) { const int k = i >> 2, n0 = 4 * (i & 3); const f32x4 v = *(const f32x4*)(we + 4 * i);
          WT[(4 + n0) * SF::D + k] = v[0]; WT[(5 + n0) * SF::D + k] = v[1]; WT[(6 + n0) * SF::D + k] = v[2]; WT[(7 + n0) * SF::D + k] = v[3]; } }
    __syncthreads();
    int* cnt = (int*)p.ctl + CW_CNT + 64 * (dry ? 4 + l : l); int* LIST = dry ? (int*)p.OG : f.LIST; float* WL = dry ? p.OG + (size_t)SF::NE * SF::NTOK : f.WL;
    constexpr int MAXENT = 2 * NWAVES * ((SF::NTOK + 256 * NWAVES - 1) / (256 * NWAVES));
    LAS int* lcnt = (LAS int*)(lds + 81920); LAS int* lbase = lcnt + 16; LAS int* ent_e = lcnt + 32; LAS int* ent_tk = ent_e + MAXENT; LAS int* ent_sl = ent_tk + MAXENT; LAS float* ent_w = (LAS float*)(ent_sl + MAXENT);
    if (tid < 16) lcnt[tid] = 0;
    for (int i = tid; i < MAXENT; i += NTHREADS) ent_e[i] = -1;
    __syncthreads();
    int iter = 0;
    for (int row = fresh_bid() * NWAVES + wave; row < SF::NTOK; row += NGW, ++iter) {
        const int mr = row < SF::NLAT ? row / SF::SEQ : SF::B; const float* xr = p.X + (size_t)row * SF::D;
        const float* md = p.MODS + ((size_t)l * (SF::B + 1) + mr) * SF::NMOD; const float* g = p.g_ffn + (size_t)l * SF::D;
        f32x4 x[4]; float ss = 0.f;
#pragma unroll
        for (int j = 0; j < 4; ++j) { x[j] = *(const f32x4*)(xr + 4 * lane + 256 * j); ss += x[j][0] * x[j][0] + x[j][1] * x[j][1] + x[j][2] * x[j][2] + x[j][3] * x[j][3]; }
        const float rstd = 1.0f / sqrtf(wave_sum(ss) * (1.0f / SF::D) + SF::EPS);
#pragma unroll
        for (int j = 0; j < 4; ++j) { const int c0 = 4 * lane + 256 * j; x[j] = x[j] * rstd * *(const f32x4*)(g + c0) * (*(const f32x4*)(md + 4 * SF::D + c0) + 1.0f) + *(const f32x4*)(md + 3 * SF::D + c0);
            u32x2 w; w.x = pk2(x[j][0], x[j][1]); w.y = pk2(x[j][2], x[j][3]); *(u32x2*)(p.H + (size_t)row * SF::D + c0) = w; asm volatile("" ::: "memory"); }
        float lg[NR];
#pragma unroll
        for (int n = 0; n < NR; ++n) { float a = 0.f;
#pragma unroll
            for (int j = 0; j < 4; ++j) { const f32x4 w4 = *(const LAS f32x4*)(WT + n * SF::D + 4 * lane + 256 * j); a += x[j][0] * w4[0] + x[j][1] * w4[1] + x[j][2] * w4[2] + x[j][3] * w4[3]; }
            lg[n] = wave_sum(a); }
        int gsel = 0; float gmax = lg[0];
#pragma unroll
        for (int n = 1; n < SF::MG; ++n) if (lg[n] > gmax) { gmax = lg[n]; gsel = n; }
        float gsum = 0.f;
#pragma unroll
        for (int n = 0; n < SF::MG; ++n) gsum += __expf(lg[n] - gmax);
        const float ggate = 1.0f / gsum;
        float ev[SF::MEG];
#pragma unroll
        for (int n = 0; n < SF::MEG; ++n) { ev[n] = lg[SF::MG + n];
#pragma unroll
            for (int g2 = 1; g2 < SF::MG; ++g2) if (g2 == gsel) ev[n] = lg[SF::MG + g2 * SF::MEG + n]; }
        int i1 = 0; float v1 = ev[0];
#pragma unroll
        for (int n = 1; n < SF::MEG; ++n) if (ev[n] > v1) { v1 = ev[n]; i1 = n; }
        int i2 = -1; float v2 = 0.f;
#pragma unroll
        for (int n = 0; n < SF::MEG; ++n) if (n != i1 && (i2 < 0 || ev[n] > v2)) { v2 = ev[n]; i2 = n; }
        const float e2 = __expf(v2 - v1);
        if (lane < 2) { const int e = gsel * SF::MEG + (lane == 0 ? i1 : i2); const float wgt = lane == 0 ? ggate / (1.0f + e2) : ggate * e2 / (1.0f + e2);
            const int idx = (iter * NWAVES + wave) * 2 + lane; if (idx < MAXENT) { ent_e[idx] = e; ent_tk[idx] = row * 2 + lane; ent_w[idx] = wgt; ent_sl[idx] = __hip_atomic_fetch_add(lcnt + e, 1, __ATOMIC_RELAXED, __HIP_MEMORY_SCOPE_WORKGROUP); } }
    }
    __syncthreads();
    if (tid < 16) { const int n = lcnt[tid]; lbase[tid] = n > 0 ? atomicAdd(cnt + tid, n) : 0; }
    __syncthreads();
    for (int i = tid; i < MAXENT; i += NTHREADS) { const int e = ent_e[i]; if (e >= 0) { const size_t o = (size_t)e * SF::NTOK + lbase[e] + ent_sl[i]; LIST[o] = ent_tk[i]; WL[o] = ent_w[i]; } }
}

#ifndef MK_PER_PHASE
#define MK_PER_PHASE 0
#endif
#ifndef F_GLA
#define F_GLA 1
#endif
#ifndef F_ATTN
#define F_ATTN 1
#endif
#ifndef F_NORM
#define F_NORM 1
#endif
#ifndef F_MODS
#define F_MODS 1
#endif
#ifndef PROBE_DUP
#define PROBE_DUP -1
#endif
#define DUP(k, body) PHASE({ body; if (PROBE_DUP == (k)) { body; } })

struct KArgs { Params p; FParams f; GlaBufs gb; int lo, hi; };

__global__ void __launch_bounds__(NTHREADS, 2) mega(KArgs a) {
    extern __shared__ __attribute__((aligned(16))) unsigned char lds_raw[];
    LAS unsigned char* lds = (LAS unsigned char*)lds_raw;
    const Params& p = a.p; const FParams& f = a.f; const GlaBufs& gb = a.gb;
    const int tid = threadIdx.x;
    const long gs = (long)gridDim.x * NTHREADS;
#define gt fresh_gt()
    const int lo = a.lo, hi = a.hi;
    if (tid < 4) ((LAS unsigned*)(lds + LDS_BARW))[tid] = 0u;
    __syncthreads();
    XcdBarrier bar; bar.bar = p.ctl; bar.x = 0; bar.st = (volatile LAS unsigned*)(lds + LDS_BARW);
    if (hi - lo > 1) bar = xcd_barrier_post(p.ctl, (volatile LAS unsigned*)(lds + LDS_BARW));
    int ph = 0;
#define PHASE(body) do { if (ph >= lo && ph < hi) { body; if (ph + 1 < hi) xcd_barrier(bar); } ++ph; } while (0)
    PHASE(nv_tables<SF>(p, gt, gs));
    PHASE({ f_mods(p, lds); __syncthreads(); f_convert_all(p, f.W[0], 0, lds); });
    PHASE(f_resnorm(p, 0, 0));
    for (int l = 0; l < SF::DEPTH; ++l) {
        DUP(1, f_inproj(p, f, l, lds));
        PHASE(f_mixed(p, f, gb, l, lds));
        DUP(5, f_gla_scan(gb));
        DUP(6, f_gla_out(p, gb, l, lds));
        DUP(7, f_merge(p, f, l, lds));
        PHASE({ f_out(p, f, l, lds); if (PROBE_DUP == 10) f_out(p, f, l, lds, p.OG); });
        PHASE({ f_norm2w(p, f, l, lds); if (PROBE_DUP == 11) { __syncthreads(); f_norm2w(p, f, l, lds, true); } });
        DUP(8, f_moe_up(p, f, l, lds));
        DUP(9, f_moe_down(p, f, l, lds));
        PHASE({ f_resnorm(p, l + 1, (l + 1 < SF::DEPTH) ? 1 : 2); if (PROBE_DUP == 12) f_resnorm(p, l + 1, (l + 1 < SF::DEPTH) ? 1 : 2, true); });
    }
#undef PHASE
#undef gt
}
constexpr int N_PHASES = 3 + SF::DEPTH * 10;

extern "C" void kernel_launch(void* const* d_in, const int* in_sizes, int n_in, void* d_out, int out_size, void* d_ws, size_t ws_size, hipStream_t stream) {
    static int grid = 0;
    if (grid == 0) {
        int dev = 0, cus = 0;
        if (hipGetDevice(&dev) != hipSuccess || hipDeviceGetAttribute(&cus, hipDeviceAttributeMultiprocessorCount, dev) != hipSuccess) { fprintf(stderr, "kernel_launch: device query failed\n"); grid = -1; return; }
        if (hipFuncSetAttribute((const void*)mega, hipFuncAttributeMaxDynamicSharedMemorySize, LDS_BYTES) != hipSuccess) { fprintf(stderr, "kernel_launch: hipFuncSetAttribute failed\n"); grid = -1; return; }
        int per_cu = 0;
        if (hipOccupancyMaxActiveBlocksPerMultiprocessor(&per_cu, (const void*)mega, NTHREADS, LDS_BYTES) != hipSuccess || per_cu < 1) { fprintf(stderr, "kernel_launch: occupancy query says %d\n", per_cu); }
        (void)hipGetLastError();
        grid = cus;
        if (grid > 256) grid = 256;
    }
    if (grid < 0) return;
    if (n_in != 24 || out_size != SF::NLAT * SF::D) { fprintf(stderr, "kernel_launch: unexpected shapes (n_in %d, out %d)\n", n_in, out_size); return; }
    KArgs a; memset(&a, 0, sizeof(a));
    Params& p = a.p; FParams& f = a.f; GlaBufs& gb = a.gb;
    const float* const* in = (const float* const*)d_in;
    p.x = in[0]; p.c = in[1]; p.ctx = in[2]; p.c_ctx = in[3]; p.w_ada = in[4]; p.b_ada = in[5]; p.g_mix = in[6]; p.g_ffn = in[7]; p.w_in = in[8]; p.w_dd = in[9]; p.w_du = in[10];
    p.b_dec = in[11]; p.g_gla = in[12]; p.sink = in[13]; p.w_pa = in[14]; p.w_pb = in[15]; p.w_pc = in[16]; p.w_out = in[17]; p.w_rg = in[18]; p.w_re = in[19]; p.w1 = in[20];
    p.w3 = in[21]; p.w2 = in[22]; p.g_final = in[23];
    p.out = (float*)d_out;
    size_t off = 0; unsigned char* ws = (unsigned char*)d_ws;
    auto take = [&](size_t bytes) { void* q = ws + off; off += (bytes + 255) & ~(size_t)255; return q; };
    const size_t NT = SF::NTOK, D = SF::D;
    constexpr size_t CTL_BYTES = 64 * 1024;
    p.ctl = (unsigned*)take(CTL_BYTES);
    p.X = (float*)take(NT * D * 4); p.MODS = (float*)take((size_t)SF::DEPTH * (SF::B + 1) * SF::NMOD * 4);
    p.TABL = (float*)take(2 * SF::SEQ * 4); p.TABX = (float*)take(2 * SF::CTX * 4); p.TABC = (float*)take(2 * SF::FGW * 4); p.ROPE = (float*)take(2 * SF::NPOS * SF::NFREQ * 4);
    p.H = (bf16*)take(NT * D * 2); p.PROJ = (bf16*)take(NT * SF::PCOLS * 2); p.LA = (float*)take(NT * 2 * SF::QKW * 4);
    p.MERGED = (bf16*)take(NT * D * 2);
    p.PQT = (bf16*)take((size_t)SF::B * SF::FG * SF::FGW * (SF::SEQ + SF::CTX) * 2); p.PQTC = p.PQT + (size_t)SF::B * SF::FG * SF::FGW * SF::SEQ;
    p.Y = (bf16*)take(NT * SF::YCOLS * 2); p.OG = (float*)take(2 * NT * SF::VW * 4);
    { unsigned char* q = (unsigned char*)p.PROJ; size_t o2 = 0; auto take2 = [&](size_t bytes) { void* r = q + o2; o2 += (bytes + 255) & ~(size_t)255; return r; };
      f.HID = (bf16*)take2((size_t)HID_ROWS * SF::DE * 2); p.C2 = (bf16*)take2(NT * 2 * D * 2);
      if (o2 > NT * SF::PCOLS * 2) { fprintf(stderr, "kernel_launch: MoE overlay too large\n"); return; } }
    f.MSCR = p.OG; gb.SLOC = p.OG;
    static_assert((size_t)256 * 16 * NTHREADS * 16 <= (size_t)2 * SF::NTOK * SF::VW * 4, "merge scratch must fit the OG region");
    static_assert((size_t)GLA_TASKS * 2 * SF::DV * SF::DK * 4 <= (size_t)2 * SF::NTOK * SF::VW * 4, "chunk states must fit the OG region");
    gb.DTOT = (float*)take((size_t)GLA_TASKS * 2 * SF::DK * 4); gb.SIN = (bf16*)take((size_t)GLA_TASKS * SF::DV * 128 * 2);
    for (int s = 0; s < 2; ++s) { WSet& W = f.W[s];
        W.WIN_T = (bf16*)take((size_t)WIN_ROWS * D * 2); W.WF_T = (bf16*)take((size_t)WF_ROWS * D * 2); W.WP_T = (bf16*)take(3 * D * SF::VW * 2); W.WOUT_T = (bf16*)take(D * D * 2);
        W.WUP_T = (bf16*)take((size_t)SF::NE * 2 * SF::DE * D * 2); W.WDN_T = (bf16*)take((size_t)SF::NE * D * SF::DE * 2); }
    static_assert(SF::VW == SF::FW && SF::VW == SF::SQW, "merge branches share K");
    f.LIST = (int*)take((size_t)SF::NE * NT * 4); f.WL = (float*)take((size_t)SF::NE * NT * 4);
#if !F_NORM
    p.TOPE = (int*)take(NT * 2 * 4); p.TOPW = (float*)take(NT * 2 * 4);
#endif
    if (off > ws_size) { fprintf(stderr, "kernel_launch: workspace too small: need %zu, have %zu\n", off, ws_size); return; }
    if (hipMemsetAsync(d_ws, 0, CTL_BYTES, stream) != hipSuccess) { fprintf(stderr, "kernel_launch: memset failed\n"); return; }
#if MK_PER_PHASE
    for (int i = 0; i < N_PHASES; ++i) { a.lo = i; a.hi = i + 1; hipLaunchKernelGGL(mega, dim3(grid), dim3(NTHREADS), LDS_BYTES, stream, a); }
#else
    a.lo = 0; a.hi = N_PHASES; hipLaunchKernelGGL(mega, dim3(grid), dim3(NTHREADS), LDS_BYTES, stream, a);
#endif
    const hipError_t le = hipPeekAtLastError();
    if (le != hipSuccess) fprintf(stderr, "kernel_launch: launch failed: %s\n", hipGetErrorName(le));
}
```

```cpp
#include <hip/hip_runtime.h>
#include <cstdio>
#include <cstdint>
#include <cstring>
#ifdef CPU_EMU
#include <cmath>
#include <cstdint>
#include <cstring>
#define DEVFN static inline
#else
#define DEVFN __device__ __forceinline__
#endif

typedef unsigned short bf16;
DEVFN float bf2f(bf16 v) { unsigned u = ((unsigned)v) << 16; float f; memcpy(&f, &u, 4); return f; }
DEVFN bf16 f2bf(float f) { unsigned u; memcpy(&u, &f, 4); u += 0x7fffu + ((u >> 16) & 1u); return (bf16)(u >> 16); }
DEVFN float sigmoidf_(float x) { return 1.0f / (1.0f + expf(-x)); }
DEVFN float siluf_(float x) { return x / (1.0f + expf(-x)); }
DEVFN float logsigmoidf_(float x) { return fminf(x, 0.0f) - log1pf(expf(-fabsf(x))); }

struct CfgFull { static constexpr int D = 1024, B = 4, SEQ = 4096, DEPTH = 4, GW = 64, CTX = 256, GH = 4, DK = 64, DV = 128, RANK = 16, FG = 4, FGW = 128,
                 SH = 8, SKV = 2, HD = 64, WIN = 128, MG = 4, MEG = 4, DE = 512; };
#ifndef SMALL_SEQ
#define SMALL_SEQ 256
#endif
struct CfgSmall { static constexpr int D = 64, B = 2, SEQ = SMALL_SEQ, DEPTH = 2, GW = 16, CTX = 64, GH = 2, DK = 8, DV = 16, RANK = 4, FG = 2, FGW = 16,
                  SH = 4, SKV = 2, HD = 8, WIN = 32, MG = 2, MEG = 4, DE = 32; };

template <class C> struct Sh : C {
    static constexpr int NLAT = C::B * C::SEQ, NCTX = C::B * C::CTX, NTOK = NLAT + NCTX;
    static constexpr int QKW = C::GH * C::DK, VW = C::GH * C::DV, FW = C::FG * C::FGW, SQW = C::SH * C::HD, SKW = C::SKV * C::HD, NE = C::MG * C::MEG, SG = C::SH / C::SKV;
    static constexpr int NMOD = 6 * C::D;
    static constexpr int L_KA = 0, L_VA = L_KA + QKW, L_KC = L_VA + VW, L_VC = L_KC + SKW, L_QA = L_VC + SKW, L_RA = L_QA + QKW, L_UB = L_RA + VW, L_QC = L_UB + FW, L_G = L_QC + SQW, INCOLS = L_G + 3 * C::D;
    static constexpr int P_KA = 0, P_VA = P_KA + QKW, P_KC = P_VA + VW, P_VC = P_KC + SKW, P_QA = P_VC + SKW, P_RA = P_QA + QKW, P_QC = P_RA + VW, P_G = P_QC + SQW, PCOLS = P_G + 3 * C::D;
    static constexpr int YCOLS = VW + FW + SQW;
    static constexpr int Y_A = 0, Y_B = VW, Y_C = VW + FW;
    static constexpr int NFREQ = C::HD / 4;
    static constexpr int NPOS = (C::GW > C::SEQ / C::GW) ? C::GW : C::SEQ / C::GW;
    static constexpr float EPS = 1e-6f;
};

template <class S> DEVFN int row_batch(int row) { return row < S::NLAT ? row / S::SEQ : (row - S::NLAT) / S::CTX; }
template <class S> DEVFN int row_modrow(int row) { return row < S::NLAT ? row / S::SEQ : S::B; }

struct Params {
    const float *x, *c, *ctx, *c_ctx, *w_ada, *b_ada, *g_mix, *g_ffn, *w_in, *w_dd, *w_du, *b_dec, *g_gla, *sink, *w_pa, *w_pb, *w_pc, *w_out, *w_rg, *w_re, *w1, *w3, *w2, *g_final;
    float* out;
    unsigned* ctl;
    float* X;
    float* MODS;
    float* TABL;
    float* TABX;
    float* TABC;
    float* ROPE;
    bf16* H;
    bf16* PROJ;
    float* LA;
    float* UB;
    float* D16;
    bf16* PQT;
    bf16* PQTC;
    bf16* Y;
    float* OG;
    bf16* MERGED;
    int* TOPE;
    float* TOPW;
    bf16* HIDN;
    bf16* C2;
};

template <class S> DEVFN void nv_tables(const Params& p, long gt, long gs) {
    const float TWO_PI = 6.283185307179586f;
    for (long i = gt; i < S::SEQ; i += gs) { double a = 6.283185307179586 * (double)i / S::SEQ; p.TABL[2 * i] = (float)cos(a); p.TABL[2 * i + 1] = (float)sin(a); }
    for (long i = gt; i < S::CTX; i += gs) { double a = 6.283185307179586 * (double)i / S::CTX; p.TABX[2 * i] = (float)cos(a); p.TABX[2 * i + 1] = (float)sin(a); }
    for (long i = gt; i < S::FGW; i += gs) { double a = 6.283185307179586 * (double)i / S::FGW; p.TABC[2 * i] = (float)cos(a); p.TABC[2 * i + 1] = (float)sin(a); }
    for (long i = gt; i < S::NPOS * S::NFREQ; i += gs) {
        int pos = (int)(i / S::NFREQ), f = (int)(i % S::NFREQ);
        float inv = powf(10000.0f, -(float)(2 * f) / (float)(S::HD / 2));
        float a = (float)pos * inv; p.ROPE[2 * i] = cosf(a); p.ROPE[2 * i + 1] = sinf(a);
    }
    (void)TWO_PI;
}

template <class S> DEVFN void nv_mods(const Params& p, long gt, long gs) {
    const long total = (long)S::DEPTH * (S::B + 1) * S::NMOD;
    for (long i = gt; i < total; i += gs) {
        int n = (int)(i % S::NMOD); int r = (int)((i / S::NMOD) % (S::B + 1)); int l = (int)(i / ((long)S::NMOD * (S::B + 1)));
        const float* cv = r < S::B ? p.c + (long)r * S::D : p.c_ctx;
        const float* w = p.w_ada + (long)l * S::D * S::NMOD + n;
        float acc = 0.f;
        for (int k = 0; k < S::D; ++k) acc += siluf_(cv[k]) * w[(long)k * S::NMOD];
        p.MODS[i] = acc + p.b_ada[(long)l * S::NMOD + n];
    }
}

template <class S> DEVFN void nv_resnorm(const Params& p, int l, int mode, long gt, long gs) {
    for (long row = gt; row < S::NTOK; row += gs) {
        const int mr = row_modrow<S>((int)row);
        float* xr = p.X + row * S::D;
        const float* src = nullptr;
        if (mode == 0) src = row < S::NLAT ? p.x + row * S::D : p.ctx + (row - S::NLAT) * S::D;
        const float* gate2 = (mode != 0) ? p.MODS + ((long)(l - 1) * (S::B + 1) + mr) * S::NMOD + 5 * S::D : nullptr;
        float ss = 0.f;
        for (int c = 0; c < S::D; ++c) {
            float v;
            if (mode == 0) v = src[c];
            else v = xr[c] + gate2[c] * (bf2f(p.C2[(row * 2) * S::D + c]) + bf2f(p.C2[(row * 2 + 1) * S::D + c]));
            xr[c] = v; ss += v * v;
        }
        const float rstd = 1.0f / sqrtf(ss / S::D + S::EPS);
        if (mode == 2) {
            if (row < S::NLAT) for (int c = 0; c < S::D; ++c) p.out[row * S::D + c] = xr[c] * rstd * p.g_final[c];
        } else {
            const float* md = p.MODS + ((long)l * (S::B + 1) + mr) * S::NMOD;
            const float* g = p.g_mix + (long)l * S::D;
            for (int c = 0; c < S::D; ++c) p.H[row * S::D + c] = f2bf(xr[c] * rstd * g[c] * (1.0f + md[S::D + c]) + md[c]);
        }
    }
}

template <class S> DEVFN float rope_apply(const Params& p, int s, int d, float own, float partner) {
    const int half = d / (S::HD / 2), i = d % (S::HD / 2), f = i % S::NFREQ; const bool second = i >= S::NFREQ;
    const int pos = half == 0 ? s / S::GW : s % S::GW;
    const float cs = p.ROPE[2 * (pos * S::NFREQ + f)], sn = p.ROPE[2 * (pos * S::NFREQ + f) + 1];
    return second ? partner * sn + own * cs : own * cs - partner * sn;
}

template <class S> DEVFN void nv_inproj(const Params& p, int l, long gt, long gs) {
    const long total = (long)S::NTOK * S::INCOLS;
    const float* W = p.w_in + (long)l * S::D * S::INCOLS;
    for (long i = gt; i < total; i += gs) {
        const int col = (int)(i % S::INCOLS); const long row = i / S::INCOLS;
        const bf16* h = p.H + row * S::D;
        const bool is_kc = col >= S::L_KC && col < S::L_VC, is_qc = col >= S::L_QC && col < S::L_G;
        int pcol = col;
        if (is_kc || is_qc) { const int base = is_kc ? S::L_KC : S::L_QC; const int d = (col - base) % S::HD; const int ii = d % (S::HD / 2);
            pcol = ii < S::NFREQ ? col + S::NFREQ : col - S::NFREQ; }
        float acc = 0.f, acc2 = 0.f;
        if (is_kc || is_qc) { for (int k = 0; k < S::D; ++k) { const float hv = bf2f(h[k]); acc += hv * W[(long)k * S::INCOLS + col]; acc2 += hv * W[(long)k * S::INCOLS + pcol]; } }
        else { for (int k = 0; k < S::D; ++k) acc += bf2f(h[k]) * W[(long)k * S::INCOLS + col]; }
        bf16* pr = p.PROJ + row * S::PCOLS;
        if (col < S::L_VA) pr[S::P_KA + col - S::L_KA] = f2bf(acc);
        else if (col < S::L_KC) pr[S::P_VA + col - S::L_VA] = f2bf(acc);
        else if (col < S::L_VC) { float v = acc; if (row < S::NLAT) v = rope_apply<S>(p, (int)(row % S::SEQ), (col - S::L_KC) % S::HD, acc, acc2); pr[S::P_KC + col - S::L_KC] = f2bf(v); }
        else if (col < S::L_QA) pr[S::P_VC + col - S::L_VC] = f2bf(acc);
        else if (col < S::L_RA) pr[S::P_QA + col - S::L_QA] = f2bf(acc * (1.0f / sqrtf((float)S::DK)));
        else if (col < S::L_UB) pr[S::P_RA + col - S::L_RA] = f2bf(acc);
        else if (col < S::L_QC) p.UB[row * S::FW + col - S::L_UB] = acc;
        else if (col < S::L_G) { float v = acc; if (row < S::NLAT) v = rope_apply<S>(p, (int)(row % S::SEQ), (col - S::L_QC) % S::HD, acc, acc2); pr[S::P_QC + col - S::L_QC] = f2bf(v); }
        else pr[S::P_G + col - S::L_G] = f2bf(sigmoidf_(acc));
    }
}

template <class S> DEVFN void nv_decay1(const Params& p, int l, long gt, long gs) {
    const long total = (long)S::NTOK * 2 * S::RANK;
    for (long i = gt; i < total; i += gs) {
        const int r = (int)(i % S::RANK), dir = (int)((i / S::RANK) % 2); const long row = i / (2 * S::RANK);
        const float* w = p.w_dd + ((long)(l * 2 + dir) * S::D) * S::RANK + r; const bf16* h = p.H + row * S::D;
        float acc = 0.f; for (int k = 0; k < S::D; ++k) acc += bf2f(h[k]) * w[(long)k * S::RANK];
        p.D16[i] = acc;
    }
}
template <class S> DEVFN void nv_decay2(const Params& p, int l, long gt, long gs) {
    const long total = (long)S::NTOK * 2 * S::QKW;
    for (long i = gt; i < total; i += gs) {
        const int n = (int)(i % S::QKW), dir = (int)((i / S::QKW) % 2); const long row = i / (2 * S::QKW);
        const float* w = p.w_du + ((long)(l * 2 + dir) * S::RANK) * S::QKW + n; const float* d = p.D16 + (row * 2 + dir) * S::RANK;
        float z = p.b_dec[(long)(l * 2 + dir) * S::QKW + n]; for (int r = 0; r < S::RANK; ++r) z += d[r] * w[(long)r * S::QKW];
        p.LA[i] = logsigmoidf_(z) * (1.0f / 16.0f);
    }
}

template <class S> DEVFN void nv_chdft(const Params& p, long gt, long gs) {
    const long total = (long)S::NTOK * S::FG * S::FGW * 2;
    const float sc = 1.0f / sqrtf((float)S::FGW);
    for (long i = gt; i < total; i += gs) {
        const int pq = (int)(i % 2), cp = (int)((i / 2) % S::FGW), g = (int)((i / (2 * S::FGW)) % S::FG); const long row = i / (2 * S::FGW * S::FG);
        const float* u = p.UB + row * S::FW + g * S::FGW; float acc = 0.f;
        for (int c = 0; c < S::FGW; ++c) acc += u[c] * p.TABC[2 * ((c * cp) % S::FGW) + pq];
        acc *= sc;
        if (row < S::NLAT) { const int b = (int)(row / S::SEQ), s = (int)(row % S::SEQ); p.PQT[((((long)b * S::FG + g) * S::FGW + cp) * 2 + pq) * S::SEQ + s] = f2bf(acc); }
        else { const int b = (int)((row - S::NLAT) / S::CTX), j = (int)((row - S::NLAT) % S::CTX); p.PQTC[((((long)b * S::FG + g) * S::FGW + cp) * 2 + pq) * S::CTX + j] = f2bf(acc); }
    }
}
template <class S> DEVFN void nv_seqdft(const Params& p, long gt, long gs) {
    { const long total = (long)S::B * S::FG * S::FGW * S::SEQ; const float sc = 1.0f / sqrtf((float)S::SEQ);
      for (long i = gt; i < total; i += gs) {
        const int lp = (int)(i % S::SEQ); const long bgc = i / S::SEQ; const int cp = (int)(bgc % S::FGW), g = (int)((bgc / S::FGW) % S::FG), b = (int)(bgc / ((long)S::FGW * S::FG));
        const bf16* P = p.PQT + (bgc * 2) * S::SEQ; const bf16* Q = P + S::SEQ; float acc = 0.f;
        for (int l = 0; l < S::SEQ; ++l) { const int m = (int)(((long)l * lp) % S::SEQ); acc += p.TABL[2 * m] * bf2f(P[l]) - p.TABL[2 * m + 1] * bf2f(Q[l]); }
        p.Y[((long)b * S::SEQ + lp) * S::YCOLS + S::Y_B + g * S::FGW + cp] = f2bf(acc * sc); } }
    { const long total = (long)S::B * S::FG * S::FGW * S::CTX; const float sc = 1.0f / sqrtf((float)S::CTX);
      for (long i = gt; i < total; i += gs) {
        const int lp = (int)(i % S::CTX); const long bgc = i / S::CTX; const int cp = (int)(bgc % S::FGW), g = (int)((bgc / S::FGW) % S::FG), b = (int)(bgc / ((long)S::FGW * S::FG));
        const bf16* P = p.PQTC + (bgc * 2) * S::CTX; const bf16* Q = P + S::CTX; float acc = 0.f;
        for (int l = 0; l < S::CTX; ++l) { const int m = (l * lp) % S::CTX; acc += p.TABX[2 * m] * bf2f(P[l]) - p.TABX[2 * m + 1] * bf2f(Q[l]); }
        p.Y[((long)S::NLAT + (long)b * S::CTX + lp) * S::YCOLS + S::Y_B + g * S::FGW + cp] = f2bf(acc * sc); } }
}

template <class S> DEVFN void nv_attn(const Params& p, int l, long gt, long gs) {
    const float scale = 1.0f / sqrtf((float)S::HD);
    const long total = (long)S::NTOK * S::SH;
    for (long i = gt; i < total; i += gs) {
        const int hq = (int)(i % S::SH); const long row = i / S::SH; const int hk = hq / S::SG; const int b = row_batch<S>((int)row);
        float q[S::HD], o[S::HD];
        _Pragma("unroll") for (int d = 0; d < S::HD; ++d) { q[d] = bf2f(p.PROJ[row * S::PCOLS + S::P_QC + hq * S::HD + d]) * scale; o[d] = 0.f; }
        float m = p.sink[l * S::SH + hq], lsum = 1.0f;
        const bool lat = row < S::NLAT; const int s = (int)(row % S::SEQ);
        const int nwin = lat ? 2 * S::WIN + 1 : 0;
        for (int t = 0; t < nwin + S::CTX; ++t) {
            long krow;
            if (t < nwin) { const int kp = s - S::WIN + t; if (kp < 0 || kp >= S::SEQ) continue; krow = (long)b * S::SEQ + kp; }
            else krow = (long)S::NLAT + (long)b * S::CTX + (t - nwin);
            const bf16* kr = p.PROJ + krow * S::PCOLS + S::P_KC + hk * S::HD; const bf16* vr = p.PROJ + krow * S::PCOLS + S::P_VC + hk * S::HD;
            float sc = 0.f; _Pragma("unroll") for (int d = 0; d < S::HD; ++d) sc += q[d] * bf2f(kr[d]);
            if (sc > m) { const float r = expf(m - sc); lsum *= r; _Pragma("unroll") for (int d = 0; d < S::HD; ++d) o[d] *= r; m = sc; }
            const float pe = expf(sc - m); lsum += pe;
            _Pragma("unroll") for (int d = 0; d < S::HD; ++d) o[d] += pe * bf2f(vr[d]);
        }
        const float inv = 1.0f / lsum;
        _Pragma("unroll") for (int d = 0; d < S::HD; ++d) p.Y[row * S::YCOLS + S::Y_C + hq * S::HD + d] = f2bf(o[d] * inv);
    }
}

template <class S> DEVFN void nv_gla_rec(const Params& p, long gt, long gs) {
    const long total = (long)S::B * S::GH * 2 * S::DV;
    for (long i = gt; i < total; i += gs) {
        const int v = (int)(i % S::DV), dir = (int)((i / S::DV) % 2), h = (int)((i / (2 * S::DV)) % S::GH), b = (int)(i / (2 * S::DV * S::GH));
        float St[S::DK]; _Pragma("unroll") for (int k = 0; k < S::DK; ++k) St[k] = 0.f;
        for (int t = 0; t < S::CTX + S::SEQ; ++t) {
            long row;
            if (t < S::CTX) row = (long)S::NLAT + (long)b * S::CTX + (dir == 0 ? t : S::CTX - 1 - t);
            else { const int u = t - S::CTX; row = (long)b * S::SEQ + (dir == 0 ? u : S::SEQ - 1 - u); }
            const bf16* pr = p.PROJ + row * S::PCOLS; const float* la = p.LA + row * 2 * S::QKW + dir * S::QKW + h * S::DK;
            const float vv = bf2f(pr[S::P_VA + h * S::DV + v]); float o = 0.f;
            _Pragma("unroll") for (int k = 0; k < S::DK; ++k) { St[k] = expf(la[k]) * St[k] + bf2f(pr[S::P_KA + h * S::DK + k]) * vv; o += bf2f(pr[S::P_QA + h * S::DK + k]) * St[k]; }
            p.OG[((long)dir * S::NTOK + row) * S::VW + h * S::DV + v] = o;
        }
    }
}
template <class S> DEVFN void nv_gla_out(const Params& p, int l, long gt, long gs) {
    const long total = (long)S::NTOK * S::GH;
    for (long i = gt; i < total; i += gs) {
        const int h = (int)(i % S::GH); const long row = i / S::GH;
        const float* o0 = p.OG + row * S::VW + h * S::DV; const float* o1 = o0 + (long)S::NTOK * S::VW;
        float ss = 0.f; for (int v = 0; v < S::DV; ++v) { const float o = o0[v] + o1[v]; ss += o * o; }
        const float rstd = 1.0f / sqrtf(ss / S::DV + S::EPS);
        for (int v = 0; v < S::DV; ++v) { const float o = (o0[v] + o1[v]) * rstd * p.g_gla[l * S::DV + v]; const float r = bf2f(p.PROJ[row * S::PCOLS + S::P_RA + h * S::DV + v]);
            p.Y[row * S::YCOLS + S::Y_A + h * S::DV + v] = f2bf(o * siluf_(r)); }
    }
}

template <class S> DEVFN void nv_merge(const Params& p, int l, long gt, long gs) {
    const long total = (long)S::NTOK * S::D;
    for (long i = gt; i < total; i += gs) {
        const int col = (int)(i % S::D); const long row = i / S::D; const bf16* y = p.Y + row * S::YCOLS; const bf16* g = p.PROJ + row * S::PCOLS + S::P_G;
        float a = 0.f, b = 0.f, c = 0.f;
        const float* wa = p.w_pa + (long)l * S::VW * S::D + col; const float* wb = p.w_pb + (long)l * S::FW * S::D + col; const float* wc = p.w_pc + (long)l * S::SQW * S::D + col;
        for (int k = 0; k < S::VW; ++k) a += bf2f(y[S::Y_A + k]) * wa[(long)k * S::D];
        for (int k = 0; k < S::FW; ++k) b += bf2f(y[S::Y_B + k]) * wb[(long)k * S::D];
        for (int k = 0; k < S::SQW; ++k) c += bf2f(y[S::Y_C + k]) * wc[(long)k * S::D];
        p.MERGED[i] = f2bf(bf2f(g[col]) * a + bf2f(g[S::D + col]) * b + bf2f(g[2 * S::D + col]) * c);
    }
}
template <class S> DEVFN void nv_out(const Params& p, int l, long gt, long gs) {
    const long total = (long)S::NTOK * S::D;
    for (long i = gt; i < total; i += gs) {
        const int col = (int)(i % S::D); const long row = i / S::D; const bf16* m = p.MERGED + row * S::D; const float* w = p.w_out + (long)l * S::D * S::D + col;
        float acc = 0.f; for (int k = 0; k < S::D; ++k) acc += bf2f(m[k]) * w[(long)k * S::D];
        const float g1 = p.MODS[((long)l * (S::B + 1) + row_modrow<S>((int)row)) * S::NMOD + 2 * S::D + col];
        p.X[i] += g1 * acc;
    }
}
template <class S> DEVFN void nv_norm2(const Params& p, int l, long gt, long gs) {
    for (long row = gt; row < S::NTOK; row += gs) {
        const float* xr = p.X + row * S::D; const float* md = p.MODS + ((long)l * (S::B + 1) + row_modrow<S>((int)row)) * S::NMOD; const float* g = p.g_ffn + (long)l * S::D;
        float ss = 0.f; for (int c = 0; c < S::D; ++c) ss += xr[c] * xr[c];
        const float rstd = 1.0f / sqrtf(ss / S::D + S::EPS);
        float gl[S::MG], el[S::NE]; _Pragma("unroll") for (int n = 0; n < S::MG; ++n) gl[n] = 0.f; _Pragma("unroll") for (int n = 0; n < S::NE; ++n) el[n] = 0.f;
        const float* wg = p.w_rg + (long)l * S::D * S::MG; const float* we = p.w_re + (long)l * S::D * S::NE;
        for (int c = 0; c < S::D; ++c) { const float h2 = xr[c] * rstd * g[c] * (1.0f + md[4 * S::D + c]) + md[3 * S::D + c]; p.H[row * S::D + c] = f2bf(h2);
            _Pragma("unroll") for (int n = 0; n < S::MG; ++n) gl[n] += h2 * wg[c * S::MG + n]; _Pragma("unroll") for (int n = 0; n < S::NE; ++n) el[n] += h2 * we[c * S::NE + n]; }
        int gsel = 0; float gmax = gl[0];
        _Pragma("unroll") for (int n = 1; n < S::MG; ++n) if (gl[n] > gmax) { gmax = gl[n]; gsel = n; }
        float gsum = 0.f; _Pragma("unroll") for (int n = 0; n < S::MG; ++n) gsum += expf(gl[n] - gmax);
        const float ggate = 1.0f / gsum;
        float ev[S::MEG];
        _Pragma("unroll") for (int n = 0; n < S::MEG; ++n) { ev[n] = el[n]; _Pragma("unroll") for (int g2 = 1; g2 < S::MG; ++g2) if (g2 == gsel) ev[n] = el[g2 * S::MEG + n]; }
        int i1 = 0; float v1 = ev[0];
        _Pragma("unroll") for (int n = 1; n < S::MEG; ++n) if (ev[n] > v1) { v1 = ev[n]; i1 = n; }
        int i2 = -1; float v2 = 0.f;
        _Pragma("unroll") for (int n = 0; n < S::MEG; ++n) if (n != i1 && (i2 < 0 || ev[n] > v2)) { v2 = ev[n]; i2 = n; }
        const float e2 = expf(v2 - v1);
        p.TOPE[row * 2] = gsel * S::MEG + i1; p.TOPE[row * 2 + 1] = gsel * S::MEG + i2;
        p.TOPW[row * 2] = ggate / (1.0f + e2); p.TOPW[row * 2 + 1] = ggate * e2 / (1.0f + e2);
    }
}
template <class S> DEVFN void nv_moe_up(const Params& p, int l, long gt, long gs) {
    const long total = (long)S::NTOK * 2 * S::DE;
    for (long i = gt; i < total; i += gs) {
        const int j = (int)(i % S::DE); const long rk = i / S::DE; const long row = rk / 2; const int e = p.TOPE[rk];
        const float* a = p.w1 + ((long)(l * S::NE + e) * S::D) * S::DE + j; const float* b = p.w3 + ((long)(l * S::NE + e) * S::D) * S::DE + j; const bf16* h = p.H + row * S::D;
        float u = 0.f, v = 0.f; for (int k = 0; k < S::D; ++k) { const float hv = bf2f(h[k]); u += hv * a[(long)k * S::DE]; v += hv * b[(long)k * S::DE]; }
        p.HIDN[i] = f2bf(siluf_(u) * v);
    }
}
template <class S> DEVFN void nv_moe_down(const Params& p, int l, long gt, long gs) {
    const long total = (long)S::NTOK * 2 * S::D;
    for (long i = gt; i < total; i += gs) {
        const int col = (int)(i % S::D); const long rk = i / S::D; const int e = p.TOPE[rk];
        const float* w = p.w2 + ((long)(l * S::NE + e) * S::DE) * S::D + col; const bf16* hd = p.HIDN + rk * S::DE;
        float acc = 0.f; for (int j = 0; j < S::DE; ++j) acc += bf2f(hd[j]) * w[(long)j * S::D];
        p.C2[i] = f2bf(acc * p.TOPW[rk]);
    }
}

#define XB_TMO      128
#define XB_XCNT(j)  (256  + 64 * (j))
#define XB_XSUB(j)  (1280 + 64 * (j))
#define XB_XGEN(j)  (2304 + 64 * (j))
#define XB_TOP      3328
#define XB_TOPGEN   3392
#define XCD_BAR_WORDS 3456
#define XB_SPIN_CAP (1u << 18)
#define LAS __attribute__((address_space(3)))

__device__ __forceinline__ unsigned xb_ld(unsigned* p)              { return __hip_atomic_load(p, __ATOMIC_RELAXED, __HIP_MEMORY_SCOPE_AGENT); }
__device__ __forceinline__ unsigned xb_add(unsigned* p, unsigned v) { return __hip_atomic_fetch_add(p, v, __ATOMIC_RELAXED, __HIP_MEMORY_SCOPE_AGENT); }
__device__ __forceinline__ unsigned xb_xcc_id() { return (unsigned)__builtin_amdgcn_s_getreg((3 << 11) | 20) & 0xFu; }
#define XB_SPIN(cond, bar) do { unsigned _sp = 0; while (cond) { __builtin_amdgcn_s_sleep(1); \
    if ((++_sp & 255u) == 0u) { if (xb_ld(&(bar)[XB_TMO])) break; if (_sp > XB_SPIN_CAP) { atomicAdd(&(bar)[XB_TMO], 1u); break; } } } } while (0)

struct XcdBarrier {
    unsigned* bar; unsigned x;
    volatile LAS unsigned* st;
};

__device__ __forceinline__ XcdBarrier xcd_barrier_post(unsigned* bar, volatile LAS unsigned* st) {
    XcdBarrier b; b.bar = bar; b.x = xb_xcc_id(); b.st = st;
    if (threadIdx.x == 0) (void)xb_add(&bar[XB_XCNT(b.x)], 1u);
    return b;
}
__device__ __forceinline__ void xcd_barrier_complete(unsigned* bar, unsigned x, unsigned& nloc, unsigned& nx) {
    const unsigned G = gridDim.x * gridDim.y * gridDim.z;
    unsigned sum, cnt, mine, sp = 0u;
    for (;;) {
        sum = 0u; cnt = 0u; mine = 0u;
#pragma unroll
        for (unsigned j = 0; j < 16; ++j) { const unsigned c = xb_ld(&bar[XB_XCNT(j)]); sum += c; cnt += (c > 0u) ? 1u : 0u; mine = (j == x) ? c : mine; }
        if (sum == G) break;
        __builtin_amdgcn_s_sleep(1);
        if ((++sp & 255u) == 0u) { if (xb_ld(&bar[XB_TMO])) break; if (sp > XB_SPIN_CAP) { atomicAdd(&bar[XB_TMO], 1u); break; } }
    }
    nloc = mine > 0u ? mine : 1u; nx = cnt > 0u ? cnt : 1u;
}

__device__ __forceinline__ void xcd_barrier(const XcdBarrier& b) {
    asm volatile("s_waitcnt vmcnt(0)" ::: "memory");
    __syncthreads();
    if (threadIdx.x == 0) {
        unsigned* bar = b.bar;
        __builtin_amdgcn_s_waitcnt(0);
        unsigned nloc = b.st[0], nx = b.st[1];
        if (nloc == 0u) { xcd_barrier_complete(bar, b.x, nloc, nx); b.st[0] = nloc; b.st[1] = nx; }
        const unsigned old = xb_add(&bar[XB_XSUB(b.x)], 1u);
        const unsigned gen = old / nloc;
        if (old + 1u == (gen + 1u) * nloc) {
            __builtin_amdgcn_fence(__ATOMIC_RELEASE, "agent");
            asm volatile("s_waitcnt vmcnt(0)" ::: "memory");
            const unsigned og = xb_add(&bar[XB_TOP], 1u);
            const unsigned tg = og / nx;
            if (og + 1u == (tg + 1u) * nx) xb_add(&bar[XB_TOPGEN], 1u);
            else XB_SPIN(xb_ld(&bar[XB_TOPGEN]) == tg, bar);
            __builtin_amdgcn_fence(__ATOMIC_ACQUIRE, "agent");
            xb_add(&bar[XB_XGEN(b.x)], 1u);
            asm volatile("s_waitcnt vmcnt(0)" ::: "memory");
        } else {
            XB_SPIN(xb_ld(&bar[XB_XGEN(b.x)]) == gen, bar);
            __builtin_amdgcn_fence(__ATOMIC_ACQUIRE, "agent");
            asm volatile("s_waitcnt vmcnt(0)" ::: "memory");
        }
    }
    __syncthreads();
}


namespace g8 {
#define G8_LAS __attribute__((address_space(3)))
typedef short bf16x8 __attribute__((ext_vector_type(8)));
typedef float f32x4 __attribute__((ext_vector_type(4)));
typedef float f32x2 __attribute__((ext_vector_type(2)));
typedef unsigned u32x4 __attribute__((ext_vector_type(4)));
typedef unsigned u32x2 __attribute__((ext_vector_type(2)));
constexpr int BM = 256, BK = 64, HALF = 128, HTB = HALF * BK * 2  , STAGE_BYTES = 8 * HTB, NXCD = 8, WGM = 8;

__device__ __forceinline__ int lds_byte(int r, int c) { const int st = (r >> 4) * 2 + (c >> 5), rr = r & 15, cc = c & 31, ob = rr * 64 + cc * 2; return st * 1024 + (ob ^ (((ob >> 9) & 1) << 5)); }
__device__ __forceinline__ void stage_rc(int b, int& R, int& C) { const int st = b / 1024, sb = b % 1024, swz = sb ^ (((sb >> 9) & 1) << 5); R = (st >> 1) * 16 + swz / 64; C = (st & 1) * 32 + (swz % 64) / 2; }
__device__ __forceinline__ int perm32(int rho) { const int n = rho >> 4, i = rho & 15; return 8 * (i >> 2) + 4 * n + (i & 3); }
__device__ __forceinline__ unsigned cvt_pk_bf16(float lo, float hi) { unsigned r; asm volatile("v_cvt_pk_bf16_f32 %0, %1, %2" : "=v"(r) : "v"(lo), "v"(hi)); return r; }

struct Unit { int pm, pn, e, t; };

__device__ __forceinline__ void tile_of(int wgid, int nM, int nN, int& pm, int& pn) {
    const int nwg = nM * nN; { const int q = nwg / NXCD, r = nwg % NXCD, xcd = wgid % NXCD, off = wgid / NXCD; wgid = (xcd < r ? xcd * (q + 1) : r * (q + 1) + (xcd - r) * q) + off; }
    const int nig = WGM * nN, gid = wgid / nig, fm = gid * WGM, gsz = (nM - fm) < WGM ? (nM - fm) : WGM;
    pm = fm + ((wgid % nig) % gsz); pn = (wgid % nig) / gsz;
}
struct DenseSched {
    const bf16* A; const bf16* Bt; int K, lda, ldb, nM, nN, G, c;
    static constexpr bool GATHER = false;
    __device__ __forceinline__ bool next(int i, Unit& u) const { const long L = (long)i * G + c; if (L >= (long)nM * nN) return false; tile_of((int)L, nM, nN, u.pm, u.pn); u.e = 0; u.t = 0; return true; }
    __device__ __forceinline__ const char* abase(const Unit& u) const { return (const char*)(A + (size_t)u.pm * BM * lda); }
    __device__ __forceinline__ const char* bbase(const Unit& u) const { return (const char*)(Bt + (size_t)u.pn * BM * ldb); }
    __device__ __forceinline__ unsigned arow(const Unit&, int r) const { return (unsigned)r * (unsigned)lda * 2u; }
};

template <class Epi, class Sched>
__device__ __forceinline__ void gemm_run(G8_LAS unsigned char* lds, const Sched& S, const Epi& E) {
    int tid = threadIdx.x; asm volatile("" : "+v"(tid));
    const int wid = __builtin_amdgcn_readfirstlane(tid >> 6), lane = tid & 63, wr = wid >> 2, wc = wid & 3, fr = lane & 15, fq = lane >> 4;
    const int K = S.K, nt = K / BK;
    int sR[2], sC[2]; unsigned voffB[2];
#pragma unroll
    for (int i = 0; i < 2; ++i) { int R, C; stage_rc(tid * 16 + i * 8192, R, C); sR[i] = R; sC[i] = C; const int Rb = Epi::PERM ? ((R & ~31) + perm32(R & 31)) : R;
        voffB[i] = (unsigned)(Rb * S.ldb + C) * 2u; }
    const size_t kstep = (size_t)(BK * 2);
    const size_t hstepB = (size_t)HALF * S.ldb * 2;
    const unsigned ldsw = (unsigned)wid * 1024u;
    const int aoff = lds_byte(wr * 64 + fr, fq * 8), boff = lds_byte(wc * 32 + fr, fq * 8);
#define G8_SA(b, h) (((b) * 2 + (h)) * HTB)
#define G8_SB(b, h) ((4 + (b) * 2 + (h)) * HTB)
#define G8_STAGE(bufoff, gbase, voff) do { _Pragma("unroll") for (int _i = 0; _i < 2; ++_i) \
        __builtin_amdgcn_global_load_lds((const unsigned*)((const char*)(gbase) + (voff)[_i]), (G8_LAS unsigned*)(lds + (bufoff) + ldsw + _i * 8192), 16, 0, 0); } while (0)
#define G8_LDA(dst, b, h) do { _Pragma("unroll") for (int m = 0; m < 4; ++m) _Pragma("unroll") for (int k = 0; k < 2; ++k) dst[m][k] = *(const G8_LAS bf16x8*)(lds + G8_SA(b, h) + aoff + m * 2048 + k * 1024); } while (0)
#define G8_LDB(dst, b, h) do { _Pragma("unroll") for (int n = 0; n < 2; ++n) _Pragma("unroll") for (int k = 0; k < 2; ++k) dst[n][k] = *(const G8_LAS bf16x8*)(lds + G8_SB(b, h) + boff + n * 2048 + k * 1024); } while (0)
#define G8_MMA(ai, bj, At, Bt) do { __builtin_amdgcn_s_setprio(1); _Pragma("unroll") for (int m = 0; m < 4; ++m) _Pragma("unroll") for (int n = 0; n < 2; ++n) _Pragma("unroll") for (int k = 0; k < 2; ++k) \
        acc[ai][bj][m][n] = __builtin_amdgcn_mfma_f32_16x16x32_bf16(Bt[n][k], At[m][k], acc[ai][bj][m][n], 0, 0, 0); __builtin_amdgcn_s_setprio(0); } while (0)
#define G8_WAIT_V(n) asm volatile("s_waitcnt vmcnt(" #n ")" ::: "memory")
#define G8_WAIT_L(n) asm volatile("s_waitcnt lgkmcnt(" #n ")" ::: "memory")
#define G8_BAR __builtin_amdgcn_s_barrier()
#define G8_SCHED __builtin_amdgcn_sched_barrier(0)
#define G8_AOFFS(dst, u) do { _Pragma("unroll") for (int _h = 0; _h < 2; ++_h) _Pragma("unroll") for (int _i = 0; _i < 2; ++_i) dst[_h][_i] = S.arow(u, _h * HALF + sR[_i]) + (unsigned)sC[_i] * 2u; } while (0)
    Unit cur, nxt; int ui = 0;
    if (!S.next(0, cur)) return;
    f32x4 acc[2][2][4][2];
#pragma unroll
    for (int a = 0; a < 2; ++a)
#pragma unroll
        for (int b = 0; b < 2; ++b)
#pragma unroll
            for (int m = 0; m < 4; ++m)
#pragma unroll
                for (int n = 0; n < 2; ++n) acc[a][b][m][n] = (f32x4){0.f, 0.f, 0.f, 0.f};
    bf16x8 At[4][2], B0[2][2], B1[2][2];
    unsigned ao[2][2], no[2][2];
    const char* cA = S.abase(cur); const char* cB = S.bbase(cur);
    G8_AOFFS(ao, cur);
    G8_STAGE(G8_SB(0, 0), cB, voffB); G8_STAGE(G8_SB(0, 1), cB + hstepB, voffB); G8_STAGE(G8_SA(0, 0), cA, ao[0]); G8_STAGE(G8_SA(0, 1), cA, ao[1]);
    if (wr == 1) G8_BAR;
    G8_WAIT_V(2); G8_BAR;
    G8_STAGE(G8_SB(1, 0), cB + kstep, voffB); G8_STAGE(G8_SA(1, 0), cA + kstep, ao[0]); G8_STAGE(G8_SB(1, 1), cB + hstepB + kstep, voffB);
    G8_WAIT_V(6); G8_BAR;
    for (;;) {
        const bool has_next = S.next(ui + 1, nxt);
        const char* nA = has_next ? S.abase(nxt) : cA; const char* nB = has_next ? S.bbase(nxt) : cB;
        if (has_next) { G8_AOFFS(no, nxt); } else {
#pragma unroll
            for (int h = 0; h < 2; ++h)
#pragma unroll
                for (int i = 0; i < 2; ++i) no[h][i] = ao[h][i]; }
        for (int t = 0; t < nt; t += 2) {
            const bool last = (t == nt - 2);
            const char* a1 = cA + (size_t)(t + 1) * kstep;
            const char* a2 = last ? nA : cA + (size_t)(t + 2) * kstep; const char* b2 = last ? nB : cB + (size_t)(t + 2) * kstep;
            const char* a3 = a2 + kstep; const char* b3 = b2 + kstep;
            unsigned o2[2][2];
#pragma unroll
            for (int h = 0; h < 2; ++h)
#pragma unroll
                for (int i = 0; i < 2; ++i) o2[h][i] = last ? no[h][i] : ao[h][i];
            G8_LDB(B0, 0, 0); G8_LDB(B1, 0, 1); G8_SCHED; G8_LDA(At, 0, 0); G8_STAGE(G8_SA(1, 1), a1, ao[1]);
            G8_WAIT_V(8); G8_WAIT_L(0); G8_BAR; G8_MMA(0, 0, At, B0); G8_MMA(0, 1, At, B1); G8_BAR; G8_SCHED;
            G8_LDA(At, 0, 1); G8_STAGE(G8_SB(0, 0), b2, voffB); G8_STAGE(G8_SB(0, 1), b2 + hstepB, voffB); G8_STAGE(G8_SA(0, 0), a2, o2[0]);
            G8_WAIT_V(8); G8_WAIT_L(0); G8_BAR; G8_MMA(1, 0, At, B0); G8_MMA(1, 1, At, B1); G8_BAR; G8_SCHED;
            G8_LDB(B0, 1, 0); G8_LDB(B1, 1, 1); G8_SCHED; G8_LDA(At, 1, 0); G8_STAGE(G8_SA(0, 1), a2, o2[1]);
            G8_WAIT_V(8); G8_WAIT_L(0); G8_BAR; G8_MMA(0, 0, At, B0); G8_MMA(0, 1, At, B1); G8_BAR; G8_SCHED;
            G8_LDA(At, 1, 1); G8_STAGE(G8_SB(1, 0), b3, voffB); G8_STAGE(G8_SB(1, 1), b3 + hstepB, voffB); G8_STAGE(G8_SA(1, 0), a3, o2[0]);
            G8_WAIT_V(8); G8_WAIT_L(0); G8_BAR; G8_MMA(1, 0, At, B0); G8_MMA(1, 1, At, B1); G8_BAR; G8_SCHED;
        }
        if (wr == 0) G8_BAR;
        E(acc, cur, wr, wc, fr, fq);
        if (!has_next) break;
#pragma unroll
        for (int a = 0; a < 2; ++a)
#pragma unroll
            for (int b = 0; b < 2; ++b)
#pragma unroll
                for (int m = 0; m < 4; ++m)
#pragma unroll
                    for (int n = 0; n < 2; ++n) acc[a][b][m][n] = (f32x4){0.f, 0.f, 0.f, 0.f};
        cur = nxt; cA = nA; cB = nB; ++ui;
#pragma unroll
        for (int h = 0; h < 2; ++h)
#pragma unroll
            for (int i = 0; i < 2; ++i) ao[h][i] = no[h][i];
        if (wr == 1) G8_BAR;
    }
    G8_WAIT_V(0);
    G8_BAR;
#undef G8_SA
#undef G8_SB
#undef G8_STAGE
#undef G8_LDA
#undef G8_LDB
#undef G8_MMA
#undef G8_WAIT_V
#undef G8_WAIT_L
#undef G8_BAR
#undef G8_SCHED
#undef G8_AOFFS
}
}

typedef Sh<CfgFull> SF;
#define GAS __attribute__((address_space(1)))
using g8::f32x4; using g8::f32x2; using g8::u32x4; using g8::u32x2; using g8::Unit;
#ifndef PROBE_DUP
#define PROBE_DUP -1
#endif
#ifndef PROBE_TIMER
#define PROBE_TIMER -1
#endif
#define LDS_TIMER (136 * 1024 - 48)
#define TIC(k) do { if (PROBE_TIMER == (k) && blockIdx.x == 0 && threadIdx.x == 0) { ((volatile LAS unsigned*)(lds + LDS_TIMER))[1] = (unsigned)__builtin_amdgcn_s_memrealtime(); } } while (0)
#define TOC(k) do { if (PROBE_TIMER == (k) && blockIdx.x == 0 && threadIdx.x == 0) { volatile LAS unsigned* _t = (volatile LAS unsigned*)(lds + LDS_TIMER); _t[0] += (unsigned)__builtin_amdgcn_s_memrealtime() - _t[1]; } } while (0)
constexpr int NTHREADS = 512, NWAVES = 8;
__device__ __forceinline__ int fresh_tid() { int t = threadIdx.x; asm volatile("" : "+v"(t)); return t; }
__device__ __forceinline__ int fresh_bid() { int b = blockIdx.x; asm volatile("" : "+s"(b)); return b; }
__device__ __forceinline__ long fresh_gt() { return (long)fresh_bid() * NTHREADS + fresh_tid(); }
constexpr int LDS_BYTES = 136 * 1024;
constexpr int LDS_BARW = LDS_BYTES - 16;
constexpr int CW_CNT = 4096;
constexpr int HID_ROWS = 2 * SF::NTOK + SF::NE * 256;

struct WSet { bf16 *WIN_T, *WF_T, *WP_T, *WOUT_T, *WUP_T, *WDN_T; };
struct FParams {
    WSet W[2];
    float* MSCR;
    int* LIST; float* WL;
    bf16* HID;
};
__device__ __forceinline__ WSet wsel(const FParams& f, int par) {
    WSet w = f.W[0]; const WSet& o = f.W[1];
    if (par & 1) { w.WIN_T = o.WIN_T; w.WF_T = o.WF_T; w.WP_T = o.WP_T; w.WOUT_T = o.WOUT_T; w.WUP_T = o.WUP_T; w.WDN_T = o.WDN_T; }
    return w; }
constexpr int WF_ROWS = SF::FG * SF::FGW;
constexpr int WIN_ROWS = SF::PCOLS + 2 * SF::QKW;

__device__ __forceinline__ unsigned pk2(float lo, float hi) { return g8::cvt_pk_bf16(lo, hi); }
__device__ __forceinline__ float bflo(unsigned w) { return __uint_as_float(w << 16); }
__device__ __forceinline__ float bfhi(unsigned w) { return __uint_as_float(w & 0xffff0000u); }
__device__ __forceinline__ float fast_sigmoid(float x) { return __builtin_amdgcn_rcpf(1.0f + __expf(-x)); }
__device__ __forceinline__ float fast_silu(float x) { return x * __builtin_amdgcn_rcpf(1.0f + __expf(-x)); }
__device__ __forceinline__ float fast_logsigmoid(float x) { return fminf(x, 0.0f) - __logf(1.0f + __expf(-fabsf(x))); }

__device__ __forceinline__ void cvt_item(const float* W, int ldw, int src_col0, bool perm, bf16* WT, int ldt, int dst_row0, int k0, LAS float* scr, int lane) {
    const int c4 = lane & 7, r8 = lane >> 3; f32x4 v[8];
#pragma unroll
    for (int i = 0; i < 8; ++i) v[i] = *(const f32x4*)(W + (size_t)(k0 + 8 * i + r8) * ldw + src_col0 + 4 * c4);
#pragma unroll
    for (int i = 0; i < 8; ++i) { LAS float* d = scr + (8 * i + r8) * 33 + 4 * c4; d[0] = v[i][0]; d[1] = v[i][1]; d[2] = v[i][2]; d[3] = v[i][3]; }
    asm volatile("s_waitcnt lgkmcnt(0)" ::: "memory");
    const int c = lane & 7;
#pragma unroll
    for (int jj = 0; jj < 4; ++jj) { const int n = (lane >> 3) + 8 * jj; const int sn = perm ? ((n & 1) ? (n >> 1) + 16 : (n >> 1)) : n; const LAS float* s = scr + (8 * c) * 33 + sn;
        u32x4 o; o.x = pk2(s[0 * 33], s[1 * 33]); o.y = pk2(s[2 * 33], s[3 * 33]); o.z = pk2(s[4 * 33], s[5 * 33]); o.w = pk2(s[6 * 33], s[7 * 33]);
        *(GAS u32x4*)(WT + (size_t)(dst_row0 + n) * ldt + k0 + 8 * c) = o; }
    asm volatile("s_waitcnt lgkmcnt(0)" ::: "memory");
}
constexpr int CV_G_IN = (SF::PCOLS / 256) * (SF::D / 512), CV_G_P = (SF::D / 256) * (SF::VW / 512), CV_G_O = (SF::D / 256) * (SF::D / 512);
constexpr int CV_G_UP = SF::NE * 2 * (SF::DE / 256) * (SF::D / 512), CV_G_DN = SF::NE * (SF::D / 256) * (SF::DE / 512);
constexpr int CV_ITEMT = CV_G_IN + 3 * CV_G_P + CV_G_O + CV_G_UP + CV_G_DN, CV_DEC = 32, CV_FOU = SF::FG * (SF::D / 32), CV_TASKS = CV_ITEMT + CV_DEC + CV_FOU;
__device__ __forceinline__ void convert_task(const Params& p, const WSet& W, int l, int task, LAS unsigned char* lds, int lds_off) {
    const int tid = fresh_tid(), lane = tid & 63, wave = tid >> 6;
    constexpr int D = SF::D;
    if (task < CV_ITEMT) {
        LAS float* scr = (LAS float*)(lds + lds_off + wave * 8704);
        const float* src; int ldw, scol, drow, ldt, kbase; bf16* dst; bool perm = false; int r = task;
        if (r < CV_G_IN) { const int kh = r % (D / 512), nb = r / (D / 512); const int pc = 256 * nb + 32 * wave;
            int lc; if (pc < SF::P_QC) { lc = pc; perm = (pc >= SF::P_KC && pc < SF::P_VC); } else if (pc < SF::P_G) { lc = pc - SF::P_QC + SF::L_QC; perm = true; } else lc = pc - SF::P_G + SF::L_G;
            src = p.w_in + (size_t)l * D * SF::INCOLS; ldw = SF::INCOLS; scol = lc; dst = W.WIN_T; ldt = D; drow = pc; kbase = 512 * kh; }
        else { r -= CV_G_IN;
        if (r < 3 * CV_G_P) { const int which = r / CV_G_P; r %= CV_G_P; const int nb = r;
            src = p.w_pa; if (which == 1) src = p.w_pb; if (which == 2) src = p.w_pc; src += (size_t)l * SF::VW * D; ldw = D; scol = 256 * nb + 32 * wave; dst = W.WP_T + (size_t)which * D * SF::VW; ldt = SF::VW; drow = scol; kbase = 0; }
        else { r -= 3 * CV_G_P;
        if (r < CV_G_O) { const int kh = r % (D / 512), nb = r / (D / 512);
            src = p.w_out + (size_t)l * D * D; ldw = D; scol = 256 * nb + 32 * wave; dst = W.WOUT_T; ldt = D; drow = scol; kbase = 512 * kh; }
        else { r -= CV_G_O;
        if (r < CV_G_UP) { const int kh = r % (D / 512); r /= (D / 512); const int nb = r % (SF::DE / 256); r /= (SF::DE / 256); const int half = r % 2, e = r / 2;
            src = p.w1; if (half == 1) src = p.w3; src += ((size_t)(l * SF::NE + e) * D) * SF::DE; ldw = SF::DE; scol = 256 * nb + 32 * wave;
            dst = W.WUP_T + (size_t)e * 2 * SF::DE * D; ldt = D; drow = (scol / 128) * 256 + half * 128 + (scol % 128); kbase = 512 * kh; }
        else { r -= CV_G_UP; const int nb = r % (D / 256), e = r / (D / 256);
            src = p.w2 + ((size_t)(l * SF::NE + e) * SF::DE) * D; ldw = D; scol = 256 * nb + 32 * wave; dst = W.WDN_T + (size_t)e * D * SF::DE; ldt = SF::DE; drow = scol; kbase = 0; } } } }
        for (int kb = 0; kb < 8; ++kb) cvt_item(src, ldw, scol, perm, dst, ldt, drow, kbase + 64 * kb, scr, lane);
    } else if (task < CV_ITEMT + CV_DEC) {
        static_assert(CV_DEC == 2 * (D / 64), "decay-fold tasks");
        const int tq = task - CV_ITEMT, dir = tq / (D / 64), k0 = (tq % (D / 64)) * 64;
        constexpr int DP = SF::RANK + 1;
        LAS float* dd = (LAS float*)(lds + lds_off); LAS float* du = dd + 64 * DP;
        __syncthreads();
        for (int i = tid; i < 64 * SF::RANK; i += NTHREADS) dd[(i / SF::RANK) * DP + (i % SF::RANK)] = p.w_dd[((size_t)(l * 2 + dir) * D + k0) * SF::RANK + i];
        for (int i = tid; i < SF::RANK * SF::QKW; i += NTHREADS) du[i] = p.w_du[(size_t)(l * 2 + dir) * SF::RANK * SF::QKW + i];
        __syncthreads();
        for (int i = tid; i < SF::QKW * 64; i += NTHREADS) { const int kk = i & 63, n = i >> 6; float acc = 0.f;
#pragma unroll
            for (int r = 0; r < SF::RANK; ++r) acc += dd[kk * DP + r] * du[r * SF::QKW + n];
            W.WIN_T[(size_t)(SF::PCOLS + dir * SF::QKW + n) * D + k0 + kk] = f2bf(acc); }
        __syncthreads();
    } else {
        const int tq = task - CV_ITEMT - CV_DEC, g = tq / (D / 32), k0 = (tq % (D / 32)) * 32; const float sc = 1.0f / sqrtf((float)SF::FGW);
        constexpr int WP = SF::FGW + 1;
        LAS float* wl = (LAS float*)(lds + lds_off); LAS float* tb = wl + 32 * WP;
        __syncthreads();
        for (int i = tid; i < 32 * SF::FGW; i += NTHREADS) wl[(i / SF::FGW) * WP + (i % SF::FGW)] = p.w_in[(size_t)l * D * SF::INCOLS + (size_t)(k0 + i / SF::FGW) * SF::INCOLS + SF::L_UB + g * SF::FGW + (i % SF::FGW)];
        for (int i = tid; i < 2 * SF::FGW; i += NTHREADS) tb[i] = p.TABC[i];
        __syncthreads();
        for (int i = tid; i < SF::FGW * 32; i += NTHREADS) { const int kk = i & 31, r = i >> 5; const int pq = r > SF::FGW / 2 ? 1 : 0, cp = pq ? r - SF::FGW / 2 : r; float acc = 0.f;
#pragma unroll 8
            for (int c = 0; c < SF::FGW; ++c) acc += wl[kk * WP + c] * tb[2 * ((c * cp) & (SF::FGW - 1)) + pq];
            W.WF_T[(size_t)(g * SF::FGW + r) * D + k0 + kk] = f2bf(acc * sc); }
        __syncthreads();
    }
}
__device__ __forceinline__ void f_convert_all(const Params& p, const WSet& W, int l, LAS unsigned char* lds) {
    for (int t = fresh_bid(); t < CV_TASKS; t += gridDim.x) convert_task(p, W, l, t, lds, 0);
}
struct EpiInproj {
    static constexpr bool PERM = true;
    bf16* PROJ; float* LA; const float* bdec; const float* ROPE;
    __device__ __forceinline__ void operator()(const f32x4 (&acc)[2][2][4][2], const Unit& u, int wr, int wc, int fr, int fq) const {
        const int tile = u.pn; const int row0 = u.pm * 256 + wr * 64 + fr; const int cw = wc * 32 + 8 * fq;
        constexpr int T_DEC = SF::PCOLS / 256;
        if (tile >= T_DEC) {
#pragma unroll
            for (int bj = 0; bj < 2; ++bj) { const int col = (tile - T_DEC) * 256 + bj * 128 + cw;
                const f32x4 b0 = *(const f32x4*)(bdec + col), b1 = *(const f32x4*)(bdec + col + 4);
#pragma unroll
                for (int ai = 0; ai < 2; ++ai)
#pragma unroll
                    for (int m = 0; m < 4; ++m) { const int row = row0 + ai * 128 + m * 16; f32x4 v0 = acc[ai][bj][m][0] + b0, v1 = acc[ai][bj][m][1] + b1;
#pragma unroll
                        for (int j = 0; j < 4; ++j) { v0[j] = fast_logsigmoid(v0[j]) * 0.0625f; v1[j] = fast_logsigmoid(v1[j]) * 0.0625f; }
                        float* d = LA + (size_t)row * (2 * SF::QKW) + col; *(f32x4*)d = v0; *(f32x4*)(d + 4) = v1; } }
            return;
        }
        const bool latent = u.pm < SF::NLAT / 256;
#pragma unroll
        for (int bj = 0; bj < 2; ++bj) {
            const int colt = tile * 256 + bj * 128;
            int mode = 0;
            if (colt >= SF::P_KC && colt < SF::P_VC) mode = latent ? 1 : 0;
            else if (colt >= SF::P_QA && colt < SF::P_RA) mode = 2;
            else if (colt >= SF::P_QC && colt < SF::P_G) mode = latent ? 1 : 0;
            else if (colt >= SF::P_G) mode = 3;
#pragma unroll
            for (int ai = 0; ai < 2; ++ai)
#pragma unroll
                for (int m = 0; m < 4; ++m) { const int row = row0 + ai * 128 + m * 16; f32x4 v0 = acc[ai][bj][m][0], v1 = acc[ai][bj][m][1];
                    if (mode == 1) { const int s = row & (SF::SEQ - 1); const int pos = (wc & 1) ? (s & (SF::GW - 1)) : (s / SF::GW);
                        const float* rp = ROPE + (size_t)(pos * SF::NFREQ + 4 * fq) * 2; const f32x4 r0 = *(const f32x4*)rp, r1 = *(const f32x4*)(rp + 4);
                        v0 = (f32x4){v0[0] * r0[0] - v0[1] * r0[1], v0[0] * r0[1] + v0[1] * r0[0], v0[2] * r0[2] - v0[3] * r0[3], v0[2] * r0[3] + v0[3] * r0[2]};
                        v1 = (f32x4){v1[0] * r1[0] - v1[1] * r1[1], v1[0] * r1[1] + v1[1] * r1[0], v1[2] * r1[2] - v1[3] * r1[3], v1[2] * r1[3] + v1[3] * r1[2]}; }
                    else if (mode == 2) { v0 = v0 * 0.125f; v1 = v1 * 0.125f; }
                    else if (mode == 3) {
#pragma unroll
                        for (int j = 0; j < 4; ++j) { v0[j] = fast_sigmoid(v0[j]); v1[j] = fast_sigmoid(v1[j]); } }
                    u32x4 w; w.x = pk2(v0[0], v0[1]); w.y = pk2(v0[2], v0[3]); w.z = pk2(v1[0], v1[1]); w.w = pk2(v1[2], v1[3]);
                    *(u32x4*)(PROJ + (size_t)row * SF::PCOLS + colt + cw) = w; }
        }
    }
};
struct EpiFourT {
    static constexpr bool PERM = true;
    bf16* PQT;
    __device__ __forceinline__ void operator()(const f32x4 (&acc)[2][2][4][2], const Unit& u, int wr, int wc, int fr, int fq) const {
        const bool latent = u.pn < SF::NLAT / 256; const int b = latent ? u.pn / (SF::SEQ / 256) : u.pn - SF::NLAT / 256;
        const int L = latent ? SF::SEQ : SF::CTX; bf16* base = PQT + (latent ? (size_t)0 : (size_t)SF::B * SF::FG * SF::FGW * SF::SEQ); const int t0 = latent ? (u.pn % (SF::SEQ / 256)) * 256 : 0;
#pragma unroll
        for (int ai = 0; ai < 2; ++ai) { const int g = 2 * u.pm + ai;
#pragma unroll
            for (int m = 0; m < 4; ++m) { const int r = wr * 64 + m * 16 + fr;
                bf16* rowp = base + ((size_t)(b * SF::FG + g) * SF::FGW + r) * L + t0 + wc * 32 + 8 * fq;
#pragma unroll
                for (int bj = 0; bj < 2; ++bj) { const f32x4 v0 = acc[ai][bj][m][0], v1 = acc[ai][bj][m][1];
                    u32x4 w; w.x = pk2(v0[0], v0[1]); w.y = pk2(v0[2], v0[3]); w.z = pk2(v1[0], v1[1]); w.w = pk2(v1[2], v1[3]);
                    *(u32x4*)(rowp + bj * 128) = w; } } }
    }
};
struct InprojSched {
    const bf16* H; const bf16* WIN; const bf16* WF; int K, lda, ldb, G, c;
    static constexpr bool GATHER = false;
    static constexpr int nM1 = SF::NTOK / 256, nN1 = WIN_ROWS / 256, NU1 = nM1 * nN1, nM2 = WF_ROWS / 256, nN2 = SF::NTOK / 256, NU2 = nM2 * nN2;
    __device__ __forceinline__ bool next(int i, Unit& u) const { const long L = (long)i * G + c; if (L >= NU1 + NU2) return false;
        if (L < NU1) { g8::tile_of((int)L, nM1, nN1, u.pm, u.pn); u.e = 0; } else { g8::tile_of((int)L - NU1, nM2, nN2, u.pm, u.pn); u.e = 1; } u.t = 0; return true; }
    __device__ __forceinline__ const char* abase(const Unit& u) const { const bf16* a = H; if (u.e) a = WF; return (const char*)(a + (size_t)u.pm * 256 * lda); }
    __device__ __forceinline__ const char* bbase(const Unit& u) const { const bf16* b = WIN; if (u.e) b = H; return (const char*)(b + (size_t)u.pn * 256 * ldb); }
    __device__ __forceinline__ unsigned arow(const Unit&, int r) const { return (unsigned)r * (unsigned)lda * 2u; }
};
struct EpiInprojAll {
    static constexpr bool PERM = true;
    EpiInproj e1; EpiFourT e2;
    __device__ __forceinline__ void operator()(const f32x4 (&acc)[2][2][4][2], const Unit& u, int wr, int wc, int fr, int fq) const { if (u.e == 0) e1(acc, u, wr, wc, fr, fq); else e2(acc, u, wr, wc, fr, fq); }
};
struct MergeSched {
    const bf16* Y; const bf16* WP; int K, lda, ldb, nM, nN, G, c;
    static constexpr bool GATHER = false;
    __device__ __forceinline__ bool next(int i, Unit& u) const { const int ti = i / 3; const long L = (long)ti * G + c; if (L >= (long)nM * nN) return false; g8::tile_of((int)L, nM, nN, u.pm, u.pn); u.e = i % 3; u.t = 0; return true; }
    __device__ __forceinline__ const char* abase(const Unit& u) const { return (const char*)(Y + (size_t)u.pm * 256 * lda + u.e * SF::VW); }
    __device__ __forceinline__ const char* bbase(const Unit& u) const { return (const char*)(WP + (size_t)u.e * SF::D * SF::VW + (size_t)u.pn * 256 * ldb); }
    __device__ __forceinline__ unsigned arow(const Unit&, int r) const { return (unsigned)r * (unsigned)lda * 2u; }
};
struct EpiMerge {
    static constexpr bool PERM = true;
    const bf16* PROJ; bf16* MERGED; float* scr;
    __device__ __forceinline__ void operator()(const f32x4 (&acc)[2][2][4][2], const Unit& u, int wr, int wc, int fr, int fq) const {
        const int br = u.e; const int row0 = u.pm * 256 + wr * 64 + fr; const int col0 = u.pn * 256 + wc * 32 + 8 * fq;
        u32x4* sp = (u32x4*)scr + fresh_tid();
        if (br != 0) asm volatile("s_waitcnt vmcnt(0)" ::: "memory");
#pragma unroll
        for (int ai = 0; ai < 2; ++ai)
#pragma unroll
            for (int mp = 0; mp < 2; ++mp) {
                u32x4 gw[2][2], sw[2][2];
#pragma unroll
                for (int mm = 0; mm < 2; ++mm)
#pragma unroll
                    for (int bj = 0; bj < 2; ++bj) { const int m = 2 * mp + mm; const int row = row0 + ai * 128 + m * 16;
                        gw[mm][bj] = *(const u32x4*)(PROJ + (size_t)row * SF::PCOLS + SF::P_G + br * SF::D + col0 + bj * 128);
                        if (br != 0) sw[mm][bj] = sp[(size_t)(((ai * 4 + m) * 2 + bj)) * NTHREADS]; }
#pragma unroll
                for (int mm = 0; mm < 2; ++mm)
#pragma unroll
                    for (int bj = 0; bj < 2; ++bj) { const int m = 2 * mp + mm; const int row = row0 + ai * 128 + m * 16; const u32x4 g = gw[mm][bj];
                        f32x4 v0 = acc[ai][bj][m][0] * (f32x4){bflo(g.x), bfhi(g.x), bflo(g.y), bfhi(g.y)}, v1 = acc[ai][bj][m][1] * (f32x4){bflo(g.z), bfhi(g.z), bflo(g.w), bfhi(g.w)};
                        if (br != 0) { const u32x4 s = sw[mm][bj]; v0 = v0 + (f32x4){bflo(s.x), bfhi(s.x), bflo(s.y), bfhi(s.y)}; v1 = v1 + (f32x4){bflo(s.z), bfhi(s.z), bflo(s.w), bfhi(s.w)}; }
                        u32x4 w; w.x = pk2(v0[0], v0[1]); w.y = pk2(v0[2], v0[3]); w.z = pk2(v1[0], v1[1]); w.w = pk2(v1[2], v1[3]);
                        if (br != 2) sp[(size_t)(((ai * 4 + m) * 2 + bj)) * NTHREADS] = w;
                        else *(u32x4*)(MERGED + (size_t)row * SF::D + col0 + bj * 128) = w; }
                asm volatile("" ::: "memory"); }
    }
};
struct EpiOut {
    static constexpr bool PERM = false;
    float* X; const float* mods_l;
    __device__ __forceinline__ void operator()(const f32x4 (&acc)[2][2][4][2], const Unit& u, int wr, int wc, int fr, int fq) const {
        const int mr = u.pm < SF::NLAT / 256 ? u.pm / (SF::SEQ / 256) : SF::B; const float* g1 = mods_l + (size_t)mr * SF::NMOD + 2 * SF::D;
        const int row0 = u.pm * 256 + wr * 64 + fr, col0 = u.pn * 256 + wc * 32 + 4 * fq;
        f32x4 gv[2][2];
#pragma unroll
        for (int bj = 0; bj < 2; ++bj)
#pragma unroll
            for (int n = 0; n < 2; ++n) gv[bj][n] = *(const f32x4*)(g1 + col0 + bj * 128 + n * 16);
#pragma unroll
        for (int ai = 0; ai < 2; ++ai)
#pragma unroll
            for (int m = 0; m < 4; ++m) { float* rowp = X + (size_t)(row0 + ai * 128 + m * 16) * SF::D + col0;
#pragma unroll
                for (int bj = 0; bj < 2; ++bj)
#pragma unroll
                    for (int n = 0; n < 2; ++n) { f32x4* d = (f32x4*)(rowp + bj * 128 + n * 16); *d = *d + gv[bj][n] * acc[ai][bj][m][n]; } }
    }
};
struct MoeSched {
    const bf16* A; const bf16* Bt; const int* cnt; const int* list; int K, lda, ldb, G, c; bool up;
    static constexpr bool GATHER = true;
    __device__ __forceinline__ bool next(int i, Unit& u) const {
        const long L = (long)i * G + c; const int q = (int)(L >> 2); u.pn = (int)(L & 3); int tb = 0; bool found = false; u.e = 0; u.t = 0; u.pm = 0;
        for (int e = 0; e < SF::NE; ++e) { const int ntl = (cnt[e] + 255) >> 8; if (!found && q < tb + ntl) { u.e = e; u.t = q - tb; u.pm = q; found = true; } tb += ntl; }
        return found;
    }
    __device__ __forceinline__ const char* abase(const Unit& u) const { return up ? (const char*)A : (const char*)(A + (size_t)u.pm * 256 * lda); }
    __device__ __forceinline__ const char* bbase(const Unit& u) const { return (const char*)(Bt + ((size_t)u.e * 1024 + (size_t)u.pn * 256) * ldb); }
    __device__ __forceinline__ unsigned arow(const Unit& u, int r) const {
        if (!up) return (unsigned)r * (unsigned)lda * 2u;
        const int slot = u.t * 256 + r; const int tok = slot < cnt[u.e] ? (list[(size_t)u.e * SF::NTOK + slot] >> 1) : 0; return (unsigned)tok * (unsigned)lda * 2u; }
};
struct EpiMoeUp {
    static constexpr bool PERM = true;
    bf16* HID;
    __device__ __forceinline__ void operator()(const f32x4 (&acc)[2][2][4][2], const Unit& u, int wr, int wc, int fr, int fq) const {
        const int row0 = u.pm * 256 + wr * 64 + fr, col0 = u.pn * 128 + wc * 32 + 8 * fq;
#pragma unroll
        for (int ai = 0; ai < 2; ++ai)
#pragma unroll
            for (int m = 0; m < 4; ++m) { f32x4 a0 = acc[ai][0][m][0], a1 = acc[ai][0][m][1]; const f32x4 b0 = acc[ai][1][m][0], b1 = acc[ai][1][m][1];
#pragma unroll
                for (int j = 0; j < 4; ++j) { a0[j] = fast_silu(a0[j]) * b0[j]; a1[j] = fast_silu(a1[j]) * b1[j]; }
                u32x4 w; w.x = pk2(a0[0], a0[1]); w.y = pk2(a0[2], a0[3]); w.z = pk2(a1[0], a1[1]); w.w = pk2(a1[2], a1[3]);
                *(u32x4*)(HID + (size_t)(row0 + ai * 128 + m * 16) * SF::DE + col0) = w; }
    }
};
struct EpiMoeDown {
    static constexpr bool PERM = true;
    bf16* C2; const int* cnt; const int* list; const float* wl;
    __device__ __forceinline__ void operator()(const f32x4 (&acc)[2][2][4][2], const Unit& u, int wr, int wc, int fr, int fq) const {
        const int n_e = cnt[u.e]; const int col0 = u.pn * 256 + wc * 32 + 8 * fq;
#pragma unroll
        for (int ai = 0; ai < 2; ++ai)
#pragma unroll
            for (int m = 0; m < 4; ++m) { const int slot = u.t * 256 + ai * 128 + wr * 64 + m * 16 + fr;
                if (slot < n_e) { const int tk = list[(size_t)u.e * SF::NTOK + slot]; const float w8 = wl[(size_t)u.e * SF::NTOK + slot];
#pragma unroll
                    for (int bj = 0; bj < 2; ++bj) { const f32x4 v0 = acc[ai][bj][m][0] * w8, v1 = acc[ai][bj][m][1] * w8;
                        u32x4 w; w.x = pk2(v0[0], v0[1]); w.y = pk2(v0[2], v0[3]); w.z = pk2(v1[0], v1[1]); w.w = pk2(v1[2], v1[3]);
                        *(u32x4*)(C2 + (size_t)tk * SF::D + col0 + bj * 128) = w; } } }
    }
};

__device__ __forceinline__ void f_inproj(const Params& p, const FParams& f, int l, LAS unsigned char* lds) {
    const WSet W = wsel(f, l);
    InprojSched S{p.H, W.WIN_T, W.WF_T, SF::D, SF::D, SF::D, (int)gridDim.x, fresh_bid()};
    EpiInprojAll E{EpiInproj{p.PROJ, p.LA, p.b_dec + (size_t)l * 2 * SF::QKW, p.ROPE}, EpiFourT{p.PQT}};
    g8::gemm_run(lds, S, E);
}
__device__ __forceinline__ void f_merge(const Params& p, const FParams& f, int l, LAS unsigned char* lds) {
    MergeSched S{p.Y, wsel(f, l).WP_T, SF::VW, SF::YCOLS, SF::VW, SF::NTOK / 256, SF::D / 256, (int)gridDim.x, fresh_bid()};
    EpiMerge E{p.PROJ, p.MERGED, f.MSCR + (size_t)fresh_bid() * 16 * NTHREADS * 4};
    g8::gemm_run(lds, S, E);
}
__device__ __forceinline__ void f_out(const Params& p, const FParams& f, int l, LAS unsigned char* lds, float* Xdst = nullptr) {
    g8::DenseSched S{p.MERGED, wsel(f, l).WOUT_T, SF::D, SF::D, SF::D, SF::NTOK / 256, SF::D / 256, (int)gridDim.x, fresh_bid()};
    EpiOut E{Xdst ? Xdst : p.X, p.MODS + (size_t)l * (SF::B + 1) * SF::NMOD};
    g8::gemm_run(lds, S, E);
}
__device__ __forceinline__ void f_norm2(const Params& p, const FParams& f, int l) {
    const long gt = fresh_gt(), gs = (long)gridDim.x * NTHREADS;
    nv_norm2<SF>(p, l, gt, gs);
    int* cnt = (int*)p.ctl + CW_CNT + 64 * l;
    for (long row = gt; row < SF::NTOK; row += gs) {
#pragma unroll
        for (int k = 0; k < 2; ++k) { const int e = p.TOPE[row * 2 + k]; const int slot = atomicAdd(cnt + e, 1);
            f.LIST[(size_t)e * SF::NTOK + slot] = (int)row * 2 + k; f.WL[(size_t)e * SF::NTOK + slot] = p.TOPW[row * 2 + k]; }
    }
}
__device__ __forceinline__ void f_moe_up(const Params& p, const FParams& f, int l, LAS unsigned char* lds) {
    MoeSched S{p.H, wsel(f, l).WUP_T, (const int*)p.ctl + CW_CNT + 64 * l, f.LIST, SF::D, SF::D, SF::D, (int)gridDim.x, fresh_bid(), true};
    EpiMoeUp E{f.HID};
    g8::gemm_run(lds, S, E);
}
__device__ __forceinline__ void f_moe_down(const Params& p, const FParams& f, int l, LAS unsigned char* lds) {
    MoeSched S{f.HID, wsel(f, l).WDN_T, (const int*)p.ctl + CW_CNT + 64 * l, f.LIST, SF::DE, SF::DE, SF::DE, (int)gridDim.x, fresh_bid(), false};
    EpiMoeDown E{p.C2, (const int*)p.ctl + CW_CNT + 64 * l, f.LIST, f.WL};
    g8::gemm_run(lds, S, E);
}

typedef float f32x16 __attribute__((ext_vector_type(16)));
typedef __bf16 bf16x2_t __attribute__((ext_vector_type(2)));
using g8::bf16x8;
__device__ __forceinline__ unsigned pkc(float a, float b) { f32x2 v = {a, b}; return __builtin_bit_cast(unsigned, __builtin_convertvector(v, bf16x2_t)); }
__device__ __forceinline__ bf16x8 lfrag(const LAS bf16* base, int pitch, int row0, int k0, int lane) { return *(const LAS bf16x8*)(base + (row0 + (lane & 15)) * pitch + k0 + 8 * (lane >> 4)); }
#define MFMA16(a, b, c) __builtin_amdgcn_mfma_f32_16x16x32_bf16((a), (b), (c), 0, 0, 0)
#define MFMA32(a, b, c) __builtin_amdgcn_mfma_f32_32x32x16_bf16((a), (b), (c), 0, 0, 0)

constexpr int GLA_NBLK = (SF::CTX + SF::SEQ) / 64;
constexpr int GLA_CB = SF::CTX / 64;
constexpr int GLA_TASKS = SF::B * SF::GH * GLA_NBLK;
constexpr int GP_K = 72, GP_C = 136;
constexpr int GP_CU = 65, CUM_H = 64 * GP_CU;
constexpr int GL_CUM = 0, GL_TOT = 33280, GL_QC = 37376, GL_KF = 54784, GL_KB = 64000, GL_VT = 73216, GL_ST = 91648, GL_P = 126464, GL_END = 135680;
static_assert(GL_END <= LDS_BARW, "GLA LDS map");
struct GlaBufs { float* SLOC; float* DTOT; bf16* SIN; };

__device__ __forceinline__ int gla_row0(int b, int blk) { return blk < GLA_CB ? SF::NLAT + b * SF::CTX + 64 * blk : b * SF::SEQ + 64 * (blk - GLA_CB); }
__device__ __forceinline__ void gla_cum(const Params& p, LAS unsigned char* lds, int row0, int h, int tid, int off_tot = GL_TOT) {
    LAS float* CUM = (LAS float*)(lds + GL_CUM); LAS float* TOT = (LAS float*)(lds + off_tot);
    const int kk = tid & 63, seg = tid >> 6;
    float c[8], d[8];
    const float* la = p.LA + (size_t)(row0 + 8 * seg) * (2 * SF::QKW) + h * SF::DK + kk;
#pragma unroll
    for (int j = 0; j < 8; ++j) { c[j] = la[(size_t)j * (2 * SF::QKW)]; d[j] = la[(size_t)j * (2 * SF::QKW) + SF::QKW]; }
#pragma unroll
    for (int j = 1; j < 8; ++j) c[j] += c[j - 1];
#pragma unroll
    for (int j = 6; j >= 0; --j) d[j] += d[j + 1];
    TOT[seg * 64 + kk] = c[7]; TOT[512 + seg * 64 + kk] = d[0];
    __syncthreads();
    float of = 0.f, ob = 0.f;
#pragma unroll
    for (int s = 0; s < 8; ++s) { const float a = TOT[s * 64 + kk], b = TOT[512 + s * 64 + kk]; of += (s < seg) ? a : 0.f; ob += (s > seg) ? b : 0.f; }
#pragma unroll
    for (int j = 0; j < 8; ++j) { CUM[(8 * seg + j) * GP_CU + kk] = c[j] + of; CUM[CUM_H + (8 * seg + j) * GP_CU + kk] = d[j] + ob; }
    __syncthreads();
}
__device__ __forceinline__ void gla_vt(const Params& p, LAS unsigned char* lds, int row0, int h, int tid, int off_vt = GL_VT) {
    LAS bf16* VT = (LAS bf16*)(lds + off_vt);
#pragma unroll
    for (int it = 0; it < 2; ++it) { const int s = tid & 63, ch = 2 * (tid >> 6) + it;
        const u32x4 v = *(const u32x4*)(p.PROJ + (size_t)(row0 + s) * SF::PCOLS + SF::P_VA + h * SF::DV + 8 * ch);
        LAS bf16* d = VT + (8 * ch) * GP_K + s;
        d[0 * GP_K] = (bf16)(v.x & 0xffffu); d[1 * GP_K] = (bf16)(v.x >> 16); d[2 * GP_K] = (bf16)(v.y & 0xffffu); d[3 * GP_K] = (bf16)(v.y >> 16);
        d[4 * GP_K] = (bf16)(v.z & 0xffffu); d[5 * GP_K] = (bf16)(v.z >> 16); d[6 * GP_K] = (bf16)(v.w & 0xffffu); d[7 * GP_K] = (bf16)(v.w >> 16); }
}
constexpr int LC_TOT = 33280, LC_KF = 37376, LC_KB = 46592, LC_VT = 55808, LC_END = 74240;
__device__ __forceinline__ void gla_local_task(const Params& p, const GlaBufs& gb, LAS unsigned char* lds, int task) {
    const int tid = fresh_tid(), lane = tid & 63, wave = tid >> 6;
    LAS float* CUM = (LAS float*)(lds + GL_CUM); LAS bf16* KDF = (LAS bf16*)(lds + LC_KF); LAS bf16* KDB = (LAS bf16*)(lds + LC_KB); LAS bf16* VT = (LAS bf16*)(lds + LC_VT);
    {
        const int blk = task % GLA_NBLK, bh = task / GLA_NBLK, h = bh % SF::GH, b = bh / SF::GH; const int row0 = gla_row0(b, blk);
        gla_cum(p, lds, row0, h, tid, LC_TOT);
        { const int t = tid & 63, kk0 = 8 * (tid >> 6);
          const u32x4 kv = *(const u32x4*)(p.PROJ + (size_t)(row0 + t) * SF::PCOLS + SF::P_KA + h * SF::DK + kk0);
          const unsigned kw[4] = {kv.x, kv.y, kv.z, kv.w};
#pragma unroll
          for (int j = 0; j < 8; ++j) { const float kf = (j & 1) ? bfhi(kw[j >> 1]) : bflo(kw[j >> 1]); const int kk = kk0 + j;
              const float ef = __expf(CUM[63 * GP_CU + kk] - CUM[t * GP_CU + kk]), eb = __expf(CUM[CUM_H + kk] - CUM[CUM_H + t * GP_CU + kk]);
              KDF[kk * GP_K + t] = f2bf(kf * ef); KDB[kk * GP_K + t] = f2bf(kf * eb); }
          if (tid < 128) { const int dir = tid >> 6, kk = tid & 63; gb.DTOT[((size_t)(bh * 2 + dir) * GLA_NBLK + blk) * 64 + kk] = __expf(dir ? CUM[CUM_H + kk] : CUM[63 * GP_CU + kk]); } }
        gla_vt(p, lds, row0, h, tid, LC_VT);
        __syncthreads();
        { bf16x8 a[2];
#pragma unroll
          for (int ks = 0; ks < 2; ++ks) a[ks] = lfrag(VT, GP_K, 16 * wave, 32 * ks, lane);
#pragma unroll
          for (int dir = 0; dir < 2; ++dir) { const LAS bf16* KD = dir ? KDB : KDF; float* out = gb.SLOC + ((size_t)(bh * 2 + dir) * GLA_NBLK + blk) * (SF::DV * SF::DK);
#pragma unroll
              for (int j = 0; j < 4; ++j) { f32x4 acc = {0.f, 0.f, 0.f, 0.f};
#pragma unroll
                  for (int ks = 0; ks < 2; ++ks) acc = MFMA16(a[ks], lfrag(KD, GP_K, 16 * j, 32 * ks, lane), acc);
#pragma unroll
                  for (int r = 0; r < 4; ++r) out[(16 * wave + 4 * (lane >> 4) + r) * SF::DK + 16 * j + (lane & 15)] = acc[r]; } } }
        __syncthreads();
    }
}
__device__ __forceinline__ void f_gla_scan(const GlaBufs& gb) {
    const long gs = (long)gridDim.x * NTHREADS;
    for (long e = fresh_gt(); e < (long)SF::B * SF::GH * 2 * SF::DV * SF::DK; e += gs) {
        const int kk = (int)(e & 63), vv = (int)((e >> 6) & 127), dir = (int)((e >> 13) & 1), bh = (int)(e >> 14);
        const float* dt = gb.DTOT + ((size_t)(bh * 2 + dir) * GLA_NBLK) * 64 + kk; const float* sl = gb.SLOC + ((size_t)(bh * 2 + dir) * GLA_NBLK) * (SF::DV * SF::DK) + vv * SF::DK + kk;
        bf16* so = gb.SIN + ((size_t)bh * GLA_NBLK) * (SF::DV * 128) + vv * 128 + dir * 64 + kk;
        float S = 0.f;
        for (int g = 0; g < GLA_NBLK / 4; ++g) {
            float dv[4], sv[4]; int bk[4];
#pragma unroll
            for (int u = 0; u < 4; ++u) { const int step = 4 * g + u; bk[u] = dir == 0 ? step : (step < GLA_CB ? GLA_CB - 1 - step : GLA_NBLK + GLA_CB - 1 - step);
                dv[u] = dt[(size_t)bk[u] * 64]; sv[u] = sl[(size_t)bk[u] * (SF::DV * SF::DK)]; }
#pragma unroll
            for (int u = 0; u < 4; ++u) { so[(size_t)bk[u] * (SF::DV * 128)] = f2bf(S); S = dv[u] * S + sv[u]; }
        }
    }
}
__device__ __forceinline__ void f_gla_out(const Params& p, const GlaBufs& gb, int l, LAS unsigned char* lds) {
    const int tid = fresh_tid(), lane = tid & 63, wave = tid >> 6;
    LAS float* CUM = (LAS float*)(lds + GL_CUM); LAS bf16* QC = (LAS bf16*)(lds + GL_QC); LAS bf16* KF = (LAS bf16*)(lds + GL_KF); LAS bf16* KB = (LAS bf16*)(lds + GL_KB);
    LAS bf16* VT = (LAS bf16*)(lds + GL_VT); LAS bf16* ST = (LAS bf16*)(lds + GL_ST); LAS bf16* P = (LAS bf16*)(lds + GL_P); LAS float* O = (LAS float*)(lds + GL_CUM);
    for (int task = fresh_bid(); task < GLA_TASKS; task += gridDim.x) {
        const int blk = task % GLA_NBLK, bh = task / GLA_NBLK, h = bh % SF::GH, b = bh / SF::GH; const int row0 = gla_row0(b, blk);
        gla_cum(p, lds, row0, h, tid);
        { const int t = tid >> 3, kk0 = 8 * (tid & 7); const bf16* pr = p.PROJ + (size_t)(row0 + t) * SF::PCOLS;
          const u32x4 qv = *(const u32x4*)(pr + SF::P_QA + h * SF::DK + kk0), kv = *(const u32x4*)(pr + SF::P_KA + h * SF::DK + kk0);
          const unsigned qw[4] = {qv.x, qv.y, qv.z, qv.w}, kw[4] = {kv.x, kv.y, kv.z, kv.w};
          float qf[8], qb[8], kf[8], kb[8];
#pragma unroll
          for (int j = 0; j < 8; ++j) { const float q = (j & 1) ? bfhi(qw[j >> 1]) : bflo(qw[j >> 1]), k = (j & 1) ? bfhi(kw[j >> 1]) : bflo(kw[j >> 1]);
              const float cf = CUM[t * GP_CU + kk0 + j], cb = CUM[CUM_H + t * GP_CU + kk0 + j];
              qf[j] = q * __expf(cf); qb[j] = q * __expf(cb); kf[j] = k * __expf(-cf); kb[j] = k * __expf(-cb); }
          u32x4 w; w.x = pkc(qf[0], qf[1]); w.y = pkc(qf[2], qf[3]); w.z = pkc(qf[4], qf[5]); w.w = pkc(qf[6], qf[7]); *(LAS u32x4*)(QC + t * GP_C + kk0) = w;
          w.x = pkc(qb[0], qb[1]); w.y = pkc(qb[2], qb[3]); w.z = pkc(qb[4], qb[5]); w.w = pkc(qb[6], qb[7]); *(LAS u32x4*)(QC + t * GP_C + 64 + kk0) = w;
          w.x = pkc(kf[0], kf[1]); w.y = pkc(kf[2], kf[3]); w.z = pkc(kf[4], kf[5]); w.w = pkc(kf[6], kf[7]); *(LAS u32x4*)(KF + t * GP_K + kk0) = w;
          w.x = pkc(kb[0], kb[1]); w.y = pkc(kb[2], kb[3]); w.z = pkc(kb[4], kb[5]); w.w = pkc(kb[6], kb[7]); *(LAS u32x4*)(KB + t * GP_K + kk0) = w; }
        gla_vt(p, lds, row0, h, tid);
        { const bf16* sin = gb.SIN + (size_t)task * (SF::DV * 128);
#pragma unroll
          for (int it = 0; it < 4; ++it) { const int i = tid + it * NTHREADS, vv = i >> 4, ch = i & 15; *(LAS u32x4*)(ST + vv * GP_C + 8 * ch) = *(const u32x4*)(sin + vv * 128 + 8 * ch); } }
        __syncthreads();
        { const int si = wave & 3;
#pragma unroll
          for (int tt = 0; tt < 2; ++tt) { const int ti = (wave >> 2) * 2 + tt; f32x4 af = {0.f, 0.f, 0.f, 0.f}, ab = {0.f, 0.f, 0.f, 0.f};
#pragma unroll
              for (int ks = 0; ks < 2; ++ks) { af = MFMA16(lfrag(KF, GP_K, 16 * si, 32 * ks, lane), lfrag(QC, GP_C, 16 * ti, 32 * ks, lane), af);
                  ab = MFMA16(lfrag(KB, GP_K, 16 * si, 32 * ks, lane), lfrag(QC, GP_C, 16 * ti, 64 + 32 * ks, lane), ab); }
              const int t = 16 * ti + (lane & 15), s0 = 16 * si + 4 * (lane >> 4); float v[4];
#pragma unroll
              for (int r = 0; r < 4; ++r) { const int s = s0 + r; v[r] = (s <= t ? af[r] : 0.f) + (s >= t ? ab[r] : 0.f); }
              u32x2 w; w.x = pkc(v[0], v[1]); w.y = pkc(v[2], v[3]); *(LAS u32x2*)(P + t * GP_K + s0) = w; } }
        __syncthreads();
        { const int ti = wave & 3; bf16x8 aq[4], ap[2]; f32x4 acc[4];
#pragma unroll
          for (int ks = 0; ks < 4; ++ks) aq[ks] = lfrag(QC, GP_C, 16 * ti, 32 * ks, lane);
#pragma unroll
          for (int ks = 0; ks < 2; ++ks) ap[ks] = lfrag(P, GP_K, 16 * ti, 32 * ks, lane);
#pragma unroll
          for (int j = 0; j < 4; ++j) { const int vt = (wave >> 2) * 4 + j; acc[j] = (f32x4){0.f, 0.f, 0.f, 0.f};
#pragma unroll
              for (int ks = 0; ks < 4; ++ks) acc[j] = MFMA16(aq[ks], lfrag(ST, GP_C, 16 * vt, 32 * ks, lane), acc[j]);
#pragma unroll
              for (int ks = 0; ks < 2; ++ks) acc[j] = MFMA16(ap[ks], lfrag(VT, GP_K, 16 * vt, 32 * ks, lane), acc[j]); }
#pragma unroll
          for (int j = 0; j < 4; ++j) { const int vt = (wave >> 2) * 4 + j;
#pragma unroll
              for (int r = 0; r < 4; ++r) O[(16 * ti + 4 * (lane >> 4) + r) * 129 + 16 * vt + (lane & 15)] = acc[j][r]; } }
        __syncthreads();
        { const int t = tid >> 3, vv0 = 16 * (tid & 7); float o[16]; float ss = 0.f;
#pragma unroll
          for (int j = 0; j < 16; ++j) { o[j] = O[t * 129 + vv0 + j]; ss += o[j] * o[j]; }
          ss += __shfl_xor(ss, 1); ss += __shfl_xor(ss, 2); ss += __shfl_xor(ss, 4);
          const float rstd = 1.0f / sqrtf(ss * (1.0f / SF::DV) + SF::EPS);
          const bf16* rp = p.PROJ + (size_t)(row0 + t) * SF::PCOLS + SF::P_RA + h * SF::DV + vv0; const u32x4 r0 = *(const u32x4*)rp, r1 = *(const u32x4*)(rp + 8);
          const unsigned rw[8] = {r0.x, r0.y, r0.z, r0.w, r1.x, r1.y, r1.z, r1.w}; const float* gg = p.g_gla + l * SF::DV + vv0; float y[16];
#pragma unroll
          for (int j = 0; j < 16; ++j) { const float r = (j & 1) ? bfhi(rw[j >> 1]) : bflo(rw[j >> 1]); y[j] = o[j] * rstd * gg[j] * fast_silu(r); }
          u32x4 w0, w1; w0.x = pkc(y[0], y[1]); w0.y = pkc(y[2], y[3]); w0.z = pkc(y[4], y[5]); w0.w = pkc(y[6], y[7]); w1.x = pkc(y[8], y[9]); w1.y = pkc(y[10], y[11]); w1.z = pkc(y[12], y[13]); w1.w = pkc(y[14], y[15]);
          bf16* yp = p.Y + (size_t)(row0 + t) * SF::YCOLS + SF::Y_A + h * SF::DV + vv0; *(u32x4*)yp = w0; *(u32x4*)(yp + 8) = w1; }
        __syncthreads();
    }
}

constexpr int AT_KS = 0, AT_VT = 18432, AT_END = 18432 + 64 * GP_C * 2;
__device__ __forceinline__ void attn_unit(const Params& p, int l, LAS unsigned char* lds, int u) {
    const int tid = fresh_tid(), lane = tid & 63, wave = __builtin_amdgcn_readfirstlane(tid >> 6), g = wave >> 1, qh = wave & 1, hl = lane >> 5, c = lane & 31;
    LAS bf16* KS = (LAS bf16*)(lds + AT_KS); LAS bf16* VT = (LAS bf16*)(lds + AT_VT);
    constexpr float LOG2E = 1.4426950408889634f; constexpr float SC = 0.125f * LOG2E;
    constexpr int NQB = SF::SEQ / 128, NLU = SF::B * SF::SKV * NQB;
    {
        const bool lat = u < NLU; int b, hk, qb;
        if (lat) { qb = u % NQB; hk = (u / NQB) % SF::SKV; b = u / (NQB * SF::SKV); } else { const int v = u - NLU; qb = v % (SF::CTX / 128); hk = (v / (SF::CTX / 128)) % SF::SKV; b = v / ((SF::CTX / 128) * SF::SKV); }
        const int qrow0 = (lat ? b * SF::SEQ : SF::NLAT + b * SF::CTX) + qb * 128 + 64 * qh; const int hq = hk * SF::SG + g;
        bf16x8 qf[2][4];
#pragma unroll
        for (int qs = 0; qs < 2; ++qs)
#pragma unroll
            for (int ks = 0; ks < 4; ++ks) qf[qs][ks] = *(const bf16x8*)(p.PROJ + (size_t)(qrow0 + 32 * qs + c) * SF::PCOLS + SF::P_QC + hq * SF::HD + 16 * ks + 8 * hl);
        float m[2], ls[2]; f32x16 O[2][2];
#pragma unroll
        for (int qs = 0; qs < 2; ++qs) { m[qs] = p.sink[l * SF::SH + hq] * LOG2E; ls[qs] = hl == 0 ? 1.0f : 0.0f;
#pragma unroll
            for (int dt = 0; dt < 2; ++dt)
#pragma unroll
                for (int r = 0; r < 16; ++r) O[dt][qs][r] = 0.f; }
        const int nkb = lat ? 5 : 2;
        u32x4 kreg[2], vreg[2];
#define AT_KROW0(kb) ((kb) < 2 ? SF::NLAT + b * SF::CTX + 128 * (kb) : b * SF::SEQ + (qb + (kb) - 3) * 128)
#define AT_FETCH(kb) do { _Pragma("unroll") for (int it = 0; it < 2; ++it) { const int i = tid + it * NTHREADS, key = i >> 3, ch = i & 7; const int keyv = lane + 64 * it; \
            kreg[it] = *(const u32x4*)(p.PROJ + (size_t)(AT_KROW0(kb) + key) * SF::PCOLS + hk * SF::HD + 8 * ch + SF::P_KC); \
            vreg[it] = *(const u32x4*)(p.PROJ + (size_t)(AT_KROW0(kb) + keyv) * SF::PCOLS + hk * SF::HD + 8 * wave + SF::P_VC); } } while (0)
        AT_FETCH(0);
        for (int kbi = 0; kbi < nkb; ++kbi) {
            if ((kbi == 2 && qb == 0) || (kbi == 4 && qb == NQB - 1)) continue;
            __syncthreads();
#pragma unroll
            for (int it = 0; it < 2; ++it) { const int i = tid + it * NTHREADS, key = i >> 3, ch = i & 7;
                *(LAS u32x4*)(KS + key * GP_K + 8 * ch) = kreg[it];
                const u32x4 v = vreg[it]; LAS bf16* d = VT + (8 * wave) * GP_C + lane + 64 * it;
                d[0 * GP_C] = (bf16)(v.x & 0xffffu); d[1 * GP_C] = (bf16)(v.x >> 16); d[2 * GP_C] = (bf16)(v.y & 0xffffu); d[3 * GP_C] = (bf16)(v.y >> 16);
                d[4 * GP_C] = (bf16)(v.z & 0xffffu); d[5 * GP_C] = (bf16)(v.z >> 16); d[6 * GP_C] = (bf16)(v.w & 0xffffu); d[7 * GP_C] = (bf16)(v.w >> 16); }
            __syncthreads();
            { int nb = kbi + 1; if (nb == 2 && qb == 0) nb = 3; if (nb == 4 && qb == NQB - 1) nb = 5; if (nb < nkb) AT_FETCH(nb); }
            for (int kt = 0; kt < 4; ++kt) {
                bf16x8 ka[4], va[2][2];
#pragma unroll
                for (int ks = 0; ks < 4; ++ks) ka[ks] = *(const LAS bf16x8*)(KS + (32 * kt + c) * GP_K + 16 * ks + 8 * hl);
#pragma unroll
                for (int dt = 0; dt < 2; ++dt)
#pragma unroll
                    for (int s = 0; s < 2; ++s) { const LAS bf16* vp = VT + (32 * dt + c) * GP_C + 32 * kt + 16 * s + 4 * hl;
                        const u32x2 v0 = *(const LAS u32x2*)vp, v1 = *(const LAS u32x2*)(vp + 8); u32x4 w; w.x = v0.x; w.y = v0.y; w.z = v1.x; w.w = v1.y; va[dt][s] = __builtin_bit_cast(bf16x8, w); }
                int mode[2];
#pragma unroll
                for (int qs = 0; qs < 2; ++qs) { const int rel = 32 * kt - (64 * qh + 32 * qs); mode[qs] = 0;
                    if (kbi == 2) mode[qs] = rel < 0 ? 2 : (rel == 0 ? 1 : 0); if (kbi == 4) mode[qs] = rel > 0 ? 2 : (rel == 0 ? 1 : 0); }
                if (mode[0] == 2 && mode[1] == 2) continue;
                f32x16 S[2];
#pragma unroll
                for (int qs = 0; qs < 2; ++qs)
#pragma unroll
                    for (int r = 0; r < 16; ++r) S[qs][r] = 0.f;
#pragma unroll
                for (int ks = 0; ks < 4; ++ks) { S[0] = MFMA32(ka[ks], qf[0][ks], S[0]); S[1] = MFMA32(ka[ks], qf[1][ks], S[1]); }
                float mx[2];
#pragma unroll
                for (int qs = 0; qs < 2; ++qs) { mx[qs] = m[qs];
                    if (mode[qs] != 0) {
#pragma unroll
                        for (int r = 0; r < 16; ++r) { const int rr = (r & 3) + 8 * (r >> 2) + 4 * hl; const bool bad = mode[qs] == 2 || (kbi == 2 ? (rr < c) : (rr > c)); const float x = bad ? -1e30f : S[qs][r] * SC; S[qs][r] = x; mx[qs] = fmaxf(mx[qs], x); } }
                    else {
#pragma unroll
                        for (int r = 0; r < 16; ++r) { const float x = S[qs][r] * SC; S[qs][r] = x; mx[qs] = fmaxf(mx[qs], x); } }
                    auto rr = __builtin_amdgcn_permlane32_swap(__float_as_uint(mx[qs]), __float_as_uint(mx[qs]), false, false); mx[qs] = fmaxf(__uint_as_float(rr[0]), __uint_as_float(rr[1])); }
                if (__any(mx[0] > m[0] || mx[1] > m[1])) {
#pragma unroll
                    for (int qs = 0; qs < 2; ++qs) { const float alpha = __builtin_amdgcn_exp2f(m[qs] - mx[qs]); m[qs] = mx[qs]; ls[qs] *= alpha;
#pragma unroll
                        for (int dt = 0; dt < 2; ++dt)
#pragma unroll
                            for (int r = 0; r < 16; ++r) O[dt][qs][r] *= alpha; } }
                bf16x8 pf[2][2];
#pragma unroll
                for (int qs = 0; qs < 2; ++qs) { float rs = 0.f;
#pragma unroll
                    for (int r = 0; r < 16; ++r) { const float pv = __builtin_amdgcn_exp2f(S[qs][r] - mx[qs]); S[qs][r] = pv; rs += pv; }
                    ls[qs] += rs;
#pragma unroll
                    for (int s = 0; s < 2; ++s) { u32x4 w; w.x = pkc(S[qs][8 * s], S[qs][8 * s + 1]); w.y = pkc(S[qs][8 * s + 2], S[qs][8 * s + 3]); w.z = pkc(S[qs][8 * s + 4], S[qs][8 * s + 5]); w.w = pkc(S[qs][8 * s + 6], S[qs][8 * s + 7]);
                        pf[qs][s] = __builtin_bit_cast(bf16x8, w); } }
#pragma unroll
                for (int dt = 0; dt < 2; ++dt)
#pragma unroll
                    for (int s = 0; s < 2; ++s) { O[dt][0] = MFMA32(va[dt][s], pf[0][s], O[dt][0]); O[dt][1] = MFMA32(va[dt][s], pf[1][s], O[dt][1]); }
            }
        }
#undef AT_FETCH
#undef AT_KROW0
#pragma unroll
        for (int qs = 0; qs < 2; ++qs) { float lt = ls[qs];
            { auto rr = __builtin_amdgcn_permlane32_swap(__float_as_uint(lt), __float_as_uint(lt), false, false); lt = __uint_as_float(rr[0]) + __uint_as_float(rr[1]); }
            const float inv = 1.0f / lt; bf16* yp = p.Y + (size_t)(qrow0 + 32 * qs + c) * SF::YCOLS + SF::Y_C + hq * SF::HD;
#pragma unroll
            for (int dt = 0; dt < 2; ++dt)
#pragma unroll
                for (int gq = 0; gq < 4; ++gq) { u32x2 w; w.x = pkc(O[dt][qs][4 * gq] * inv, O[dt][qs][4 * gq + 1] * inv); w.y = pkc(O[dt][qs][4 * gq + 2] * inv, O[dt][qs][4 * gq + 3] * inv);
                    *(u32x2*)(yp + 32 * dt + 8 * gq + 4 * hl) = w; } }
    }
}

constexpr int FF_OP = SF::SEQ + 2 * 64;
constexpr int FF_ZT = 0, FF_G = 17408, FF_OUT = 34816, FF_WEND = FF_OUT + 4 * FF_OP * 2, FF_M1 = 86016, FF_M2 = 120832, FF_END = 138240;
static_assert(FF_END <= LDS_BARW - 16 && LC_END <= FF_M1 && FF_WEND <= FF_M1, "mixed-phase LDS map");
constexpr int FFT_TPG = 17, FFT_TASKS = SF::B * SF::FG * FFT_TPG;
__device__ __forceinline__ void fft_setup(const Params& p, LAS unsigned char* lds) {
    const int tid = fresh_tid(); LAS bf16* M1 = (LAS bf16*)(lds + FF_M1); LAS bf16* M2 = (LAS bf16*)(lds + FF_M2);
    for (int i = tid; i < 128 * 128; i += NTHREADS) { const int row = i >> 7, col = i & 127, rp = row >> 6, v = row & 63, ri = col >> 6, a = col & 63; const int m = ((a * v) & 63) * (SF::SEQ / 64);
        const float cs = p.TABL[2 * m], sn = p.TABL[2 * m + 1]; const float val = rp == 0 ? (ri == 0 ? cs : -sn) : (ri == 0 ? -sn : -cs); M1[row * GP_C + col] = f2bf(val); }
    for (int i = tid; i < 64 * 128; i += NTHREADS) { const int u = i >> 7, col = i & 127, ri = col >> 6, bp = col & 63; const int m = ((bp * u) & 63) * (SF::SEQ / 64);
        M2[u * GP_C + col] = f2bf((ri == 0 ? p.TABL[2 * m] : p.TABL[2 * m + 1]) * (1.0f / 64.0f)); }
}
__device__ __forceinline__ void fft_task(const Params& p, LAS unsigned char* lds, int task) {
    const int tid = fresh_tid(), lane = tid & 63, wave = __builtin_amdgcn_readfirstlane(tid >> 6);
    LAS bf16* ZT = (LAS bf16*)(lds + FF_ZT); LAS bf16* G = (LAS bf16*)(lds + FF_G); LAS bf16* OUT = (LAS bf16*)(lds + FF_OUT);
    const LAS bf16* M1 = (const LAS bf16*)(lds + FF_M1); const LAS bf16* M2 = (const LAS bf16*)(lds + FF_M2);
    const int bg = task / FFT_TPG, tt = task % FFT_TPG, b = bg / SF::FG, g = bg % SF::FG;
    const int ncol = tt < 16 ? 4 : 1, c0 = tt < 16 ? 4 * tt : 64;
    const bf16* src = p.PQT + (size_t)bg * SF::FGW * SF::SEQ;
    for (int cc = 0; cc < ncol; ++cc) {
        const int cp = c0 + cc; const bool hasq = cp >= 1 && cp <= 63;
#pragma unroll
        for (int pq = 0; pq < 2; ++pq) { const int a = lane, bp0 = 8 * wave, l0 = 64 * a + bp0;
            u32x4 v = {0u, 0u, 0u, 0u}; if (pq == 0) v = *(const u32x4*)(src + (size_t)cp * SF::SEQ + l0); else if (hasq) v = *(const u32x4*)(src + (size_t)(64 + cp) * SF::SEQ + l0);
            LAS bf16* d = ZT + bp0 * GP_C + pq * 64 + a;
            d[0 * GP_C] = (bf16)(v.x & 0xffffu); d[1 * GP_C] = (bf16)(v.x >> 16); d[2 * GP_C] = (bf16)(v.y & 0xffffu); d[3 * GP_C] = (bf16)(v.y >> 16);
            d[4 * GP_C] = (bf16)(v.z & 0xffffu); d[5 * GP_C] = (bf16)(v.z >> 16); d[6 * GP_C] = (bf16)(v.w & 0xffffu); d[7 * GP_C] = (bf16)(v.w >> 16); }
        __syncthreads();
        { const int i = wave & 3; bf16x8 za[4];
#pragma unroll
          for (int ks = 0; ks < 4; ++ks) za[ks] = lfrag(ZT, GP_C, 16 * i, 32 * ks, lane);
#pragma unroll
          for (int jj = 0; jj < 2; ++jj) { const int j = 2 * (wave >> 2) + jj; f32x4 ar = {0.f, 0.f, 0.f, 0.f}, ai = {0.f, 0.f, 0.f, 0.f};
#pragma unroll
              for (int ks = 0; ks < 4; ++ks) { ar = MFMA16(za[ks], lfrag(M1, GP_C, 16 * j, 32 * ks, lane), ar); ai = MFMA16(za[ks], lfrag(M1, GP_C, 64 + 16 * j, 32 * ks, lane), ai); }
              const int v = 16 * j + (lane & 15), bp0 = 16 * i + 4 * (lane >> 4); float tr[4], ti[4];
#pragma unroll
              for (int r = 0; r < 4; ++r) { const f32x2 w = *(const f32x2*)(p.TABL + 2 * ((bp0 + r) * v)); tr[r] = ar[r] * w[0] + ai[r] * w[1]; ti[r] = ai[r] * w[0] - ar[r] * w[1]; }
              u32x2 w; w.x = pkc(tr[0], tr[1]); w.y = pkc(tr[2], tr[3]); *(LAS u32x2*)(G + v * GP_C + bp0) = w;
              w.x = pkc(ti[0], ti[1]); w.y = pkc(ti[2], ti[3]); *(LAS u32x2*)(G + v * GP_C + 64 + bp0) = w; } }
        __syncthreads();
        { const int i = wave & 3; bf16x8 ga[4];
#pragma unroll
          for (int ks = 0; ks < 4; ++ks) ga[ks] = lfrag(G, GP_C, 16 * i, 32 * ks, lane);
#pragma unroll
          for (int jj = 0; jj < 2; ++jj) { const int j = 2 * (wave >> 2) + jj; f32x4 acc = {0.f, 0.f, 0.f, 0.f};
#pragma unroll
              for (int ks = 0; ks < 4; ++ks) acc = MFMA16(ga[ks], lfrag(M2, GP_C, 16 * j, 32 * ks, lane), acc);
              const int u = 16 * j + (lane & 15), v0 = 16 * i + 4 * (lane >> 4);
#pragma unroll
              for (int r = 0; r < 4; ++r) OUT[cc * FF_OP + 66 * u + v0 + r] = f2bf(acc[r]); } }
    }
    __syncthreads();
    bf16* yb = p.Y + (size_t)b * SF::SEQ * SF::YCOLS + SF::Y_B + g * SF::FGW;
    for (int lp = tid; lp < SF::SEQ; lp += NTHREADS) { const int oi = lp + 2 * (lp >> 6); const int lm = (SF::SEQ - lp) & (SF::SEQ - 1);
        const bf16 o0 = OUT[oi];
        if (ncol == 4) { const bf16 o1 = OUT[FF_OP + oi], o2 = OUT[2 * FF_OP + oi], o3 = OUT[3 * FF_OP + oi];
            u32x2 o; o.x = (unsigned)o0 | ((unsigned)o1 << 16); o.y = (unsigned)o2 | ((unsigned)o3 << 16); *(u32x2*)(yb + (size_t)lp * SF::YCOLS + c0) = o;
            bf16* ym = yb + (size_t)lm * SF::YCOLS + SF::FGW - c0;
            if (c0 != 0) ym[0] = o0;
            ym[-1] = o1; ym[-2] = o2; ym[-3] = o3; }
        else yb[(size_t)lp * SF::YCOLS + c0] = o0; }
    __syncthreads();
}
constexpr int CXD_CPT = 13, CXD_TPG = 5, CXD_TASKS = SF::B * SF::FG * CXD_TPG;
__device__ __forceinline__ void ctxdft_task(const Params& p, LAS unsigned char* lds, int task) {
    const int tid = fresh_tid(); const int bg = task / CXD_TPG, c0 = (task % CXD_TPG) * CXD_CPT, b = bg / SF::FG, g = bg % SF::FG; const float sc = 1.0f / sqrtf((float)SF::CTX);
    const bf16* src = p.PQTC + (size_t)bg * SF::FGW * SF::CTX; bf16* yb = p.Y + ((size_t)SF::NLAT + (size_t)b * SF::CTX) * SF::YCOLS + SF::Y_B + g * SF::FGW;
    LAS float* PL = (LAS float*)lds; LAS float* QL = PL + CXD_CPT * SF::CTX; LAS float* tb = QL + CXD_CPT * SF::CTX;
    for (int i = tid; i < CXD_CPT * SF::CTX; i += NTHREADS) { const int cp = c0 + i / SF::CTX, j = i % SF::CTX; const bool hasq = cp >= 1 && cp <= 63;
        PL[i] = bf2f(src[(size_t)cp * SF::CTX + j]); QL[i] = hasq ? bf2f(src[(size_t)(64 + cp) * SF::CTX + j]) : 0.f; }
    for (int i = tid; i < 2 * SF::CTX; i += NTHREADS) tb[i] = p.TABX[i];
    __syncthreads();
    for (int i = tid; i < CXD_CPT * SF::CTX; i += NTHREADS) { const int jp = i % SF::CTX, ci = i / SF::CTX, cp = c0 + ci; float acc = 0.f;
#pragma unroll 8
        for (int j = 0; j < SF::CTX; ++j) { const int m = (j * jp) & (SF::CTX - 1); acc += tb[2 * m] * PL[ci * SF::CTX + j] - tb[2 * m + 1] * QL[ci * SF::CTX + j]; }
        const bf16 o = f2bf(acc * sc); yb[(size_t)jp * SF::YCOLS + cp] = o;
        if (cp >= 1 && cp <= 63) yb[(size_t)((SF::CTX - jp) & (SF::CTX - 1)) * SF::YCOLS + SF::FGW - cp] = o; }
    __syncthreads();
}

constexpr int ATT_NLU = SF::B * SF::SKV * (SF::SEQ / 128), ATT_NCU = SF::B * SF::SKV * (SF::CTX / 128);
constexpr int MX_A = ATT_NLU, MX_F = MX_A + FFT_TASKS, MX_C = MX_F + ATT_NCU, MX_X = MX_C + CXD_TASKS, MX_G = MX_X + GLA_TASKS;
constexpr int CW_QUEUE = 5120;
constexpr int LDS_QW = LDS_BARW - 16;
constexpr int CW_CVQ = 6144;
__device__ __forceinline__ void cvt_drain(const Params& p, const FParams& f, int l, LAS unsigned char* lds) {
    if (l + 1 >= SF::DEPTH) return;
    const int tid = fresh_tid(); const WSet wnext = wsel(f, l + 1);
    unsigned* qh = p.ctl + CW_CVQ + 64 * l; volatile LAS int* qw = (volatile LAS int*)(lds + LDS_QW);
    for (;;) {
        __syncthreads();
        if (tid == 0) *qw = (int)atomicAdd(qh, 1u);
        __syncthreads();
        const int t = *qw;
        if (t >= CV_TASKS) break;
        convert_task(p, wnext, l + 1, t, lds, 0);
    }
}
__device__ __forceinline__ void f_mixed(const Params& p, const FParams& f, const GlaBufs& gb, int l, LAS unsigned char* lds) {
    const int tid = fresh_tid();
    TIC(5); fft_setup(p, lds); TOC(5);
    const WSet wnext = wsel(f, l + 1);
    const int ncv = l + 1 < SF::DEPTH ? CV_TASKS : 0; const int total = MX_G + ncv; const int cvs = ncv > 0 ? total / ncv : 1;
    unsigned* qh = p.ctl + CW_QUEUE + 64 * l; volatile LAS int* qw = (volatile LAS int*)(lds + LDS_QW); int ncvdone = 0;
    for (;;) {
        TIC(4);
        __syncthreads();
        if (tid == 0) *qw = (int)atomicAdd(qh, 1u);
        __syncthreads();
        const int t = *qw;
        TOC(4);
        if (t >= total) break;
        const bool iscv = ncv > 0 && (t % cvs == 0) && (t / cvs < ncv); const int ncb = ncv > 0 ? min(ncv, (t + cvs - 1) / cvs) : 0; const int t2 = t - ncb;
        int au = -1; if (!iscv) { if (t2 < MX_A) au = t2; else if (t2 >= MX_F && t2 < MX_C) au = ATT_NLU + (t2 - MX_F); }
        if (iscv) { TIC(2); if (ncvdone == 0) TIC(7); convert_task(p, wnext, l + 1, t / cvs, lds, 0); TOC(2); if (ncvdone == 0) TOC(7); ++ncvdone; }
        else if (au >= 0) { TIC(0); attn_unit(p, l, lds, au); TOC(0); }
        else if (t2 < MX_F) { TIC(1); fft_task(p, lds, t2 - MX_A); TOC(1); }
        else if (t2 < MX_X) { TIC(6); ctxdft_task(p, lds, t2 - MX_C); TOC(6); }
        else { TIC(3); gla_local_task(p, gb, lds, t2 - MX_X); TOC(3); }
    }
}

__device__ __forceinline__ float wave_sum(float v) {
#pragma unroll
    for (int o = 1; o < 64; o <<= 1) v += __shfl_xor(v, o);
    return v;
}
__device__ __forceinline__ void f_mods(const Params& p, LAS unsigned char* lds) {
    const int tid = fresh_tid(); LAS float* act = (LAS float*)lds; LAS float* PS = (LAS float*)(lds + 20480);
    constexpr int R = SF::B + 1; static_assert(R == 5, "mods rows");
    for (int i = tid; i < R * SF::D; i += NTHREADS) { const int r = i / SF::D, k = i % SF::D; const float v = r < SF::B ? p.c[r * SF::D + k] : p.c_ctx[k]; act[i] = v / (1.0f + __expf(-v)); }
    __syncthreads();
    constexpr int NCH = SF::NMOD / 128;
    for (int u = fresh_bid(); u < SF::DEPTH * NCH; u += gridDim.x) {
        const int l = u / NCH, n0 = (u % NCH) * 128; const int q = tid & 31, kg = tid >> 5;
        f32x4 acc[R];
#pragma unroll
        for (int r = 0; r < R; ++r) acc[r] = (f32x4){0.f, 0.f, 0.f, 0.f};
        const float* w = p.w_ada + ((size_t)l * SF::D + kg * 64) * SF::NMOD + n0 + 4 * q;
#pragma unroll 16
        for (int k = 0; k < 64; ++k) { const f32x4 w4 = *(const f32x4*)(w + (size_t)k * SF::NMOD);
#pragma unroll
            for (int r = 0; r < R; ++r) acc[r] = acc[r] + w4 * act[r * SF::D + kg * 64 + k]; }
#pragma unroll
        for (int r = 0; r < R; ++r) *(LAS f32x4*)(PS + ((kg * 32 + q) * R + r) * 4) = acc[r];
        __syncthreads();
        for (int t2 = tid; t2 < 32 * R * 4; t2 += NTHREADS) { const int qq = t2 / (R * 4), ri = t2 % (R * 4), r = ri / 4, i = ri % 4; float s = 0.f;
#pragma unroll
            for (int g2 = 0; g2 < 16; ++g2) s += PS[((g2 * 32 + qq) * R + r) * 4 + i];
            const int n = n0 + 4 * qq + i; p.MODS[((size_t)l * R + r) * SF::NMOD + n] = s + p.b_ada[(size_t)l * SF::NMOD + n]; }
        __syncthreads();
    }
}
__device__ __forceinline__ void f_resnorm(const Params& p, int l, int mode, bool dry = false) {
    const int tid = fresh_tid(), lane = tid & 63, wave = tid >> 6; const int NGW = gridDim.x * NWAVES;
    for (int row = fresh_bid() * NWAVES + wave; row < SF::NTOK; row += NGW) {
        if (mode == 2 && row >= SF::NLAT) continue;
        const int mr = row < SF::NLAT ? row / SF::SEQ : SF::B;
        float* xr = p.X + (size_t)row * SF::D; f32x4 x[4]; float ss = 0.f;
        if (mode == 0) { const float* src = row < SF::NLAT ? p.x + (size_t)row * SF::D : p.ctx + (size_t)(row - SF::NLAT) * SF::D;
#pragma unroll
            for (int j = 0; j < 4; ++j) x[j] = *(const f32x4*)(src + 4 * lane + 256 * j); }
        else { const float* g2 = p.MODS + ((size_t)(l - 1) * (SF::B + 1) + mr) * SF::NMOD + 5 * SF::D; const bf16* ca = p.C2 + (size_t)row * 2 * SF::D; const bf16* cb = ca + SF::D;
#pragma unroll
            for (int j = 0; j < 4; ++j) { const int c0 = 4 * lane + 256 * j; const f32x4 xv = *(const f32x4*)(xr + c0), gv = *(const f32x4*)(g2 + c0); const u32x2 a = *(const u32x2*)(ca + c0), b = *(const u32x2*)(cb + c0);
                x[j] = xv + (dry ? gv * 0.0f : gv) * (f32x4){bflo(a.x) + bflo(b.x), bfhi(a.x) + bfhi(b.x), bflo(a.y) + bflo(b.y), bfhi(a.y) + bfhi(b.y)}; } }
#pragma unroll
        for (int j = 0; j < 4; ++j) { if (mode != 2) *(f32x4*)((dry ? p.OG + (size_t)row * SF::D : xr) + 4 * lane + 256 * j) = x[j]; ss += x[j][0] * x[j][0] + x[j][1] * x[j][1] + x[j][2] * x[j][2] + x[j][3] * x[j][3]; }
        const float rstd = 1.0f / sqrtf(wave_sum(ss) * (1.0f / SF::D) + SF::EPS);
        if (mode == 2) {
#pragma unroll
            for (int j = 0; j < 4; ++j) { const int c0 = 4 * lane + 256 * j; *(f32x4*)(p.out + (size_t)row * SF::D + c0) = x[j] * rstd * *(const f32x4*)(p.g_final + c0); } }
        else { const float* md = p.MODS + ((size_t)l * (SF::B + 1) + mr) * SF::NMOD; const float* g = p.g_mix + (size_t)l * SF::D;
#pragma unroll
            for (int j = 0; j < 4; ++j) { const int c0 = 4 * lane + 256 * j; const f32x4 y = x[j] * rstd * *(const f32x4*)(g + c0) * (*(const f32x4*)(md + SF::D + c0) + 1.0f) + *(const f32x4*)(md + c0);
                u32x2 w; w.x = pk2(y[0], y[1]); w.y = pk2(y[2], y[3]); *(u32x2*)(p.H + (size_t)row * SF::D + c0) = w; asm volatile("" ::: "memory"); } }
    }
}
__device__ __forceinline__ void f_norm2w(const Params& p, const FParams& f, int l, LAS unsigned char* lds, bool dry = false) {
    const int tid = fresh_tid(), lane = tid & 63, wave = tid >> 6; const int NGW = gridDim.x * NWAVES;
    constexpr int NR = SF::MG + SF::NE;
    LAS float* WT = (LAS float*)lds;
    { const float* wg = p.w_rg + (size_t)l * SF::D * SF::MG; const float* we = p.w_re + (size_t)l * SF::D * SF::NE;
      for (int i = tid; i < SF::D; i += NTHREADS) { const f32x4 v = *(const f32x4*)(wg + 4 * i); WT[0 * SF::D + i] = v[0]; WT[1 * SF::D + i] = v[1]; WT[2 * SF::D + i] = v[2]; WT[3 * SF::D + i] = v[3]; }
      for (int i = tid; i < SF::D * 4; i += NTHREADS) { const int k = i >> 2, n0 = 4 * (i & 3); const f32x4 v = *(const f32x4*)(we + 4 * i);
          WT[(4 + n0) * SF::D + k] = v[0]; WT[(5 + n0) * SF::D + k] = v[1]; WT[(6 + n0) * SF::D + k] = v[2]; WT[(7 + n0) * SF::D + k] = v[3]; } }
    __syncthreads();
    int* cnt = (int*)p.ctl + CW_CNT + 64 * (dry ? 4 + l : l); int* LIST = dry ? (int*)p.OG : f.LIST; float* WL = dry ? p.OG + (size_t)SF::NE * SF::NTOK : f.WL;
    constexpr int MAXENT = 2 * NWAVES * ((SF::NTOK + 256 * NWAVES - 1) / (256 * NWAVES));
    LAS int* lcnt = (LAS int*)(lds + 81920); LAS int* lbase = lcnt + 16; LAS int* ent_e = lcnt + 32; LAS int* ent_tk = ent_e + MAXENT; LAS int* ent_sl = ent_tk + MAXENT; LAS float* ent_w = (LAS float*)(ent_sl + MAXENT);
    if (tid < 16) lcnt[tid] = 0;
    for (int i = tid; i < MAXENT; i += NTHREADS) ent_e[i] = -1;
    __syncthreads();
    int iter = 0;
    const int nrows = l + 1 < SF::DEPTH ? SF::NTOK : SF::NLAT;
    for (int row = fresh_bid() * NWAVES + wave; row < nrows; row += NGW, ++iter) {
        const int mr = row < SF::NLAT ? row / SF::SEQ : SF::B; const float* xr = p.X + (size_t)row * SF::D;
        const float* md = p.MODS + ((size_t)l * (SF::B + 1) + mr) * SF::NMOD; const float* g = p.g_ffn + (size_t)l * SF::D;
        f32x4 x[4]; float ss = 0.f;
#pragma unroll
        for (int j = 0; j < 4; ++j) { x[j] = *(const f32x4*)(xr + 4 * lane + 256 * j); ss += x[j][0] * x[j][0] + x[j][1] * x[j][1] + x[j][2] * x[j][2] + x[j][3] * x[j][3]; }
        const float rstd = 1.0f / sqrtf(wave_sum(ss) * (1.0f / SF::D) + SF::EPS);
#pragma unroll
        for (int j = 0; j < 4; ++j) { const int c0 = 4 * lane + 256 * j; x[j] = x[j] * rstd * *(const f32x4*)(g + c0) * (*(const f32x4*)(md + 4 * SF::D + c0) + 1.0f) + *(const f32x4*)(md + 3 * SF::D + c0);
            u32x2 w; w.x = pk2(x[j][0], x[j][1]); w.y = pk2(x[j][2], x[j][3]); *(u32x2*)(p.H + (size_t)row * SF::D + c0) = w; asm volatile("" ::: "memory"); }
        float lg[NR];
#pragma unroll
        for (int n = 0; n < NR; ++n) { float a = 0.f;
#pragma unroll
            for (int j = 0; j < 4; ++j) { const f32x4 w4 = *(const LAS f32x4*)(WT + n * SF::D + 4 * lane + 256 * j); a += x[j][0] * w4[0] + x[j][1] * w4[1] + x[j][2] * w4[2] + x[j][3] * w4[3]; }
            lg[n] = wave_sum(a); }
        int gsel = 0; float gmax = lg[0];
#pragma unroll
        for (int n = 1; n < SF::MG; ++n) if (lg[n] > gmax) { gmax = lg[n]; gsel = n; }
        float gsum = 0.f;
#pragma unroll
        for (int n = 0; n < SF::MG; ++n) gsum += __expf(lg[n] - gmax);
        const float ggate = 1.0f / gsum;
        float ev[SF::MEG];
#pragma unroll
        for (int n = 0; n < SF::MEG; ++n) { ev[n] = lg[SF::MG + n];
#pragma unroll
            for (int g2 = 1; g2 < SF::MG; ++g2) if (g2 == gsel) ev[n] = lg[SF::MG + g2 * SF::MEG + n]; }
        int i1 = 0; float v1 = ev[0];
#pragma unroll
        for (int n = 1; n < SF::MEG; ++n) if (ev[n] > v1) { v1 = ev[n]; i1 = n; }
        int i2 = -1; float v2 = 0.f;
#pragma unroll
        for (int n = 0; n < SF::MEG; ++n) if (n != i1 && (i2 < 0 || ev[n] > v2)) { v2 = ev[n]; i2 = n; }
        const float e2 = __expf(v2 - v1);
        if (lane < 2) { const int e = gsel * SF::MEG + (lane == 0 ? i1 : i2); const float wgt = lane == 0 ? ggate / (1.0f + e2) : ggate * e2 / (1.0f + e2);
            const int idx = (iter * NWAVES + wave) * 2 + lane; if (idx < MAXENT) { ent_e[idx] = e; ent_tk[idx] = row * 2 + lane; ent_w[idx] = wgt; ent_sl[idx] = __hip_atomic_fetch_add(lcnt + e, 1, __ATOMIC_RELAXED, __HIP_MEMORY_SCOPE_WORKGROUP); } }
    }
    __syncthreads();
    if (tid < 16) { const int n = lcnt[tid]; lbase[tid] = n > 0 ? atomicAdd(cnt + tid, n) : 0; }
    __syncthreads();
    for (int i = tid; i < MAXENT; i += NTHREADS) { const int e = ent_e[i]; if (e >= 0) { const size_t o = (size_t)e * SF::NTOK + lbase[e] + ent_sl[i]; LIST[o] = ent_tk[i]; WL[o] = ent_w[i]; } }
}

template <int K>
__device__ __forceinline__ void mini16(const bf16* A, int lda, const bf16* Bt, int ldb, f32x4 (&acc)[2], int lane, int wave) {
    const bf16* ap = A + (size_t)(lane & 15) * lda + 8 * (lane >> 4);
    const bf16* bp = Bt + (size_t)(32 * wave + (lane & 15)) * ldb + 8 * (lane >> 4);
#pragma unroll 8
    for (int ks = 0; ks < K / 32; ++ks) {
        const bf16x8 a = *(const bf16x8*)(ap + 32 * ks), b0 = *(const bf16x8*)(bp + 32 * ks), b1 = *(const bf16x8*)(bp + (size_t)16 * ldb + 32 * ks);
        acc[0] = MFMA16(a, b0, acc[0]); acc[1] = MFMA16(a, b1, acc[1]);
    }
}
__device__ __forceinline__ void f_merge2(const Params& p, const FParams& f, int l, LAS unsigned char* lds) {
    const WSet W = wsel(f, l); const int bid = fresh_bid();
    { MergeSched S{p.Y, W.WP_T, SF::VW, SF::YCOLS, SF::VW, SF::NLAT / 256, SF::D / 256, (int)gridDim.x, bid};
      EpiMerge E{p.PROJ, p.MERGED, f.MSCR + (size_t)bid * 16 * NTHREADS * 4};
      g8::gemm_run(lds, S, E); }
    if (l + 1 < SF::DEPTH) {
        const int tid = fresh_tid(), lane = tid & 63, wave = tid >> 6;
        for (int L = bid; L < (SF::NLAT / 256) * (SF::D / 256); L += gridDim.x) {
            int pm, pn; g8::tile_of(L, SF::NLAT / 256, SF::D / 256, pm, pn);
            const int row0 = SF::NLAT + 16 * pm, col0 = 256 * pn + 32 * wave;
            f32x4 tot[2] = {{0.f, 0.f, 0.f, 0.f}, {0.f, 0.f, 0.f, 0.f}};
#pragma unroll
            for (int br = 0; br < 3; ++br) { f32x4 acc[2] = {{0.f, 0.f, 0.f, 0.f}, {0.f, 0.f, 0.f, 0.f}};
                mini16<SF::VW>(p.Y + (size_t)row0 * SF::YCOLS + br * SF::VW, SF::YCOLS, W.WP_T + (size_t)br * SF::D * SF::VW + (size_t)(256 * pn) * SF::VW, SF::VW, acc, lane, wave);
#pragma unroll
                for (int j = 0; j < 2; ++j)
#pragma unroll
                    for (int r = 0; r < 4; ++r) { const int row = row0 + 4 * (lane >> 4) + r, col = col0 + 16 * j + (lane & 15);
                        tot[j][r] += bf2f(p.PROJ[(size_t)row * SF::PCOLS + SF::P_G + br * SF::D + col]) * acc[j][r]; } }
#pragma unroll
            for (int j = 0; j < 2; ++j)
#pragma unroll
                for (int r = 0; r < 4; ++r) { const int row = row0 + 4 * (lane >> 4) + r, col = col0 + 16 * j + (lane & 15); p.MERGED[(size_t)row * SF::D + col] = f2bf(tot[j][r]); }
        }
    }
}
__device__ __forceinline__ void f_out2(const Params& p, const FParams& f, int l, LAS unsigned char* lds) {
    const WSet W = wsel(f, l); const int bid = fresh_bid();
    { g8::DenseSched S{p.MERGED, W.WOUT_T, SF::D, SF::D, SF::D, SF::NLAT / 256, SF::D / 256, (int)gridDim.x, bid};
      EpiOut E{p.X, p.MODS + (size_t)l * (SF::B + 1) * SF::NMOD};
      g8::gemm_run(lds, S, E); }
    if (l + 1 < SF::DEPTH) {
        const int tid = fresh_tid(), lane = tid & 63, wave = tid >> 6;
        const float* g1 = p.MODS + ((size_t)l * (SF::B + 1) + SF::B) * SF::NMOD + 2 * SF::D;
        for (int L = bid; L < (SF::NLAT / 256) * (SF::D / 256); L += gridDim.x) {
            int pm, pn; g8::tile_of(L, SF::NLAT / 256, SF::D / 256, pm, pn);
            const int row0 = SF::NLAT + 16 * pm, col0 = 256 * pn + 32 * wave;
            f32x4 acc[2] = {{0.f, 0.f, 0.f, 0.f}, {0.f, 0.f, 0.f, 0.f}};
            mini16<SF::D>(p.MERGED + (size_t)row0 * SF::D, SF::D, W.WOUT_T + (size_t)(256 * pn) * SF::D, SF::D, acc, lane, wave);
#pragma unroll
            for (int j = 0; j < 2; ++j)
#pragma unroll
                for (int r = 0; r < 4; ++r) { const int row = row0 + 4 * (lane >> 4) + r, col = col0 + 16 * j + (lane & 15); p.X[(size_t)row * SF::D + col] += g1[col] * acc[j][r]; }
        }
    }
}

#ifndef MK_PER_PHASE
#define MK_PER_PHASE 0
#endif
#ifndef F_GLA
#define F_GLA 1
#endif
#ifndef F_ATTN
#define F_ATTN 1
#endif
#ifndef F_NORM
#define F_NORM 1
#endif
#ifndef F_MODS
#define F_MODS 1
#endif
#define DUP(k, body) PHASE({ body; if (PROBE_DUP == (k)) { body; } })

struct KArgs { Params p; FParams f; GlaBufs gb; int lo, hi; };

__global__ void __launch_bounds__(NTHREADS, 2) mega(KArgs a) {
    extern __shared__ __attribute__((aligned(16))) unsigned char lds_raw[];
    LAS unsigned char* lds = (LAS unsigned char*)lds_raw;
    const Params& p = a.p; const FParams& f = a.f; const GlaBufs& gb = a.gb;
    const int tid = threadIdx.x;
    const long gs = (long)gridDim.x * NTHREADS;
#define gt fresh_gt()
    const int lo = a.lo, hi = a.hi;
    if (tid < 4) ((LAS unsigned*)(lds + LDS_BARW))[tid] = 0u;
    if (tid < 2) ((LAS unsigned*)(lds + LDS_TIMER))[tid] = 0u;
    __syncthreads();
    XcdBarrier bar; bar.bar = p.ctl; bar.x = 0; bar.st = (volatile LAS unsigned*)(lds + LDS_BARW);
    if (hi - lo > 1) bar = xcd_barrier_post(p.ctl, (volatile LAS unsigned*)(lds + LDS_BARW));
    int ph = 0;
#define PHASE(body) do { if (ph >= lo && ph < hi) { const int _pid = ph < 3 ? 30 + ph : 40 + (ph - 3) % 10; if (PROBE_TIMER == _pid) TIC(PROBE_TIMER); body; if (ph + 1 < hi) xcd_barrier(bar); if (PROBE_TIMER == _pid) TOC(PROBE_TIMER); } ++ph; } while (0)
    PHASE(nv_tables<SF>(p, gt, gs));
    PHASE({ f_mods(p, lds); __syncthreads(); f_convert_all(p, f.W[0], 0, lds); });
    PHASE(f_resnorm(p, 0, 0));
    for (int l = 0; l < SF::DEPTH; ++l) {
        PHASE(f_inproj(p, f, l, lds));
        PHASE(f_mixed(p, f, gb, l, lds));
        DUP(5, f_gla_scan(gb));
        DUP(6, f_gla_out(p, gb, l, lds));
        PHASE(f_merge2(p, f, l, lds));
        PHASE(f_out2(p, f, l, lds));
        PHASE({ f_norm2w(p, f, l, lds); if (PROBE_DUP == 11) { __syncthreads(); f_norm2w(p, f, l, lds, true); } });
        PHASE(f_moe_up(p, f, l, lds));
        PHASE(f_moe_down(p, f, l, lds));
        if (PROBE_DUP == 30) { for (int xb = 0; xb < 10; ++xb) xcd_barrier(bar); }
        PHASE({ f_resnorm(p, l + 1, (l + 1 < SF::DEPTH) ? 1 : 2); if (PROBE_DUP == 12) f_resnorm(p, l + 1, (l + 1 < SF::DEPTH) ? 1 : 2, true); });
    }
#undef PHASE
#undef gt
    if (PROBE_TIMER >= 0 && blockIdx.x == 0 && tid == 0) { const unsigned ticks = ((volatile LAS unsigned*)(lds + LDS_TIMER))[0]; const unsigned long long t0 = __builtin_amdgcn_s_memrealtime();
        while (__builtin_amdgcn_s_memrealtime() - t0 < 16ull * ticks) __builtin_amdgcn_s_sleep(8); }
}
constexpr int N_PHASES = 3 + SF::DEPTH * 10;

extern "C" void kernel_launch(void* const* d_in, const int* in_sizes, int n_in, void* d_out, int out_size, void* d_ws, size_t ws_size, hipStream_t stream) {
    static int grid = 0;
    if (grid == 0) {
        int dev = 0, cus = 0;
        if (hipGetDevice(&dev) != hipSuccess || hipDeviceGetAttribute(&cus, hipDeviceAttributeMultiprocessorCount, dev) != hipSuccess) { fprintf(stderr, "kernel_launch: device query failed\n"); grid = -1; return; }
        if (hipFuncSetAttribute((const void*)mega, hipFuncAttributeMaxDynamicSharedMemorySize, LDS_BYTES) != hipSuccess) { fprintf(stderr, "kernel_launch: hipFuncSetAttribute failed\n"); grid = -1; return; }
        int per_cu = 0;
        if (hipOccupancyMaxActiveBlocksPerMultiprocessor(&per_cu, (const void*)mega, NTHREADS, LDS_BYTES) != hipSuccess || per_cu < 1) { fprintf(stderr, "kernel_launch: occupancy query says %d\n", per_cu); }
        (void)hipGetLastError();
        grid = cus;
        if (grid > 256) grid = 256;
    }
    if (grid < 0) return;
    if (n_in != 24 || out_size != SF::NLAT * SF::D) { fprintf(stderr, "kernel_launch: unexpected shapes (n_in %d, out %d)\n", n_in, out_size); return; }
    KArgs a; memset(&a, 0, sizeof(a));
    Params& p = a.p; FParams& f = a.f; GlaBufs& gb = a.gb;
    const float* const* in = (const float* const*)d_in;
    p.x = in[0]; p.c = in[1]; p.ctx = in[2]; p.c_ctx = in[3]; p.w_ada = in[4]; p.b_ada = in[5]; p.g_mix = in[6]; p.g_ffn = in[7]; p.w_in = in[8]; p.w_dd = in[9]; p.w_du = in[10];
    p.b_dec = in[11]; p.g_gla = in[12]; p.sink = in[13]; p.w_pa = in[14]; p.w_pb = in[15]; p.w_pc = in[16]; p.w_out = in[17]; p.w_rg = in[18]; p.w_re = in[19]; p.w1 = in[20];
    p.w3 = in[21]; p.w2 = in[22]; p.g_final = in[23];
    p.out = (float*)d_out;
    size_t off = 0; unsigned char* ws = (unsigned char*)d_ws;
    auto take = [&](size_t bytes) { void* q = ws + off; off += (bytes + 255) & ~(size_t)255; return q; };
    const size_t NT = SF::NTOK, D = SF::D;
    constexpr size_t CTL_BYTES = 64 * 1024;
    p.ctl = (unsigned*)take(CTL_BYTES);
    p.X = (float*)take(NT * D * 4); p.MODS = (float*)take((size_t)SF::DEPTH * (SF::B + 1) * SF::NMOD * 4);
    p.TABL = (float*)take(2 * SF::SEQ * 4); p.TABX = (float*)take(2 * SF::CTX * 4); p.TABC = (float*)take(2 * SF::FGW * 4); p.ROPE = (float*)take(2 * SF::NPOS * SF::NFREQ * 4);
    p.H = (bf16*)take(NT * D * 2); p.PROJ = (bf16*)take(NT * SF::PCOLS * 2); p.LA = (float*)take(NT * 2 * SF::QKW * 4);
    p.MERGED = (bf16*)take(NT * D * 2);
    p.PQT = (bf16*)take((size_t)SF::B * SF::FG * SF::FGW * (SF::SEQ + SF::CTX) * 2); p.PQTC = p.PQT + (size_t)SF::B * SF::FG * SF::FGW * SF::SEQ;
    p.Y = (bf16*)take(NT * SF::YCOLS * 2); p.OG = (float*)take(2 * NT * SF::VW * 4);
    { unsigned char* q = (unsigned char*)p.PROJ; size_t o2 = 0; auto take2 = [&](size_t bytes) { void* r = q + o2; o2 += (bytes + 255) & ~(size_t)255; return r; };
      f.HID = (bf16*)take2((size_t)HID_ROWS * SF::DE * 2); p.C2 = (bf16*)take2(NT * 2 * D * 2);
      if (o2 > NT * SF::PCOLS * 2) { fprintf(stderr, "kernel_launch: MoE overlay too large\n"); return; } }
    f.MSCR = p.OG; gb.SLOC = p.OG;
    static_assert((size_t)256 * 16 * NTHREADS * 16 <= (size_t)2 * SF::NTOK * SF::VW * 4, "merge scratch must fit the OG region");
    static_assert((size_t)GLA_TASKS * 2 * SF::DV * SF::DK * 4 <= (size_t)2 * SF::NTOK * SF::VW * 4, "chunk states must fit the OG region");
    gb.DTOT = (float*)take((size_t)GLA_TASKS * 2 * SF::DK * 4); gb.SIN = (bf16*)take((size_t)GLA_TASKS * SF::DV * 128 * 2);
    for (int s = 0; s < 2; ++s) { WSet& W = f.W[s];
        W.WIN_T = (bf16*)take((size_t)WIN_ROWS * D * 2); W.WF_T = (bf16*)take((size_t)WF_ROWS * D * 2); W.WP_T = (bf16*)take(3 * D * SF::VW * 2); W.WOUT_T = (bf16*)take(D * D * 2);
        W.WUP_T = (bf16*)take((size_t)SF::NE * 2 * SF::DE * D * 2); W.WDN_T = (bf16*)take((size_t)SF::NE * D * SF::DE * 2); }
    static_assert(SF::VW == SF::FW && SF::VW == SF::SQW, "merge branches share K");
    f.LIST = (int*)take((size_t)SF::NE * NT * 4); f.WL = (float*)take((size_t)SF::NE * NT * 4);
#if !F_NORM
    p.TOPE = (int*)take(NT * 2 * 4); p.TOPW = (float*)take(NT * 2 * 4);
#endif
    if (off > ws_size) { fprintf(stderr, "kernel_launch: workspace too small: need %zu, have %zu\n", off, ws_size); return; }
    if (hipMemsetAsync(d_ws, 0, CTL_BYTES, stream) != hipSuccess) { fprintf(stderr, "kernel_launch: memset failed\n"); return; }
#if MK_PER_PHASE
    for (int i = 0; i < N_PHASES; ++i) { a.lo = i; a.hi = i + 1; hipLaunchKernelGGL(mega, dim3(grid), dim3(NTHREADS), LDS_BYTES, stream, a); }
#else
    a.lo = 0; a.hi = N_PHASES; hipLaunchKernelGGL(mega, dim3(grid), dim3(NTHREADS), LDS_BYTES, stream, a);
#endif
    const hipError_t le = hipPeekAtLastError();
    if (le != hipSuccess) fprintf(stderr, "kernel_launch: launch failed: %s\n", hipGetErrorName(le));
}
```
